# Optimizing an MI355X kernel written in HIP

```python
import math
import jax, jax.numpy as jnp
from jax import lax
import numpy as np

D_MODEL = 1024
BATCH = 4
SEQ = 4096
DEPTH = 2

CTX_LEN = 256
GRID_W = 64
EPS = 1e-6
N_MOD = 6

N_MIXERS = 4
GROUP_WIDTH = D_MODEL // N_MIXERS
MIX_WIDTH = N_MIXERS * GROUP_WIDTH

SSD_HEAD_DIM = 64
SSD_HEADS = GROUP_WIDTH // SSD_HEAD_DIM
SSD_GROUPS = 2
SSD_STATE = 128
SSD_CONV = 4
SSD_CHUNK = 128
SSD_CONV_CH = GROUP_WIDTH + 2 * SSD_GROUPS * SSD_STATE
SSD_IN = GROUP_WIDTH + SSD_CONV_CH + 2 * SSD_HEADS

LRU_WIDTH = GROUP_WIDTH
LRU_BLOCKS = 4
LRU_BLOCK_W = LRU_WIDTH // LRU_BLOCKS
LRU_CONV = 4
LRU_C = 8.0
LRU_IN = 2 * LRU_WIDTH

ATTN_HEAD_DIM = 64
ATTN_Q_HEADS = GROUP_WIDTH // ATTN_HEAD_DIM
ATTN_KV_HEADS = 2
ATTN_GQA = ATTN_Q_HEADS // ATTN_KV_HEADS
ATTN_IN = (ATTN_Q_HEADS + 2 * ATTN_KV_HEADS) * ATTN_HEAD_DIM
Q_BLOCK = 128
WINDOW = 128
ROPE_THETA = 10000.0
ROPE_AXIS_DIM = ATTN_HEAD_DIM // 2

IN_COLS = SSD_IN + LRU_IN + 2 * ATTN_IN
IN_SPLITS = (SSD_IN, SSD_IN + LRU_IN, SSD_IN + LRU_IN + ATTN_IN)
FFN_HIDDEN = 4 * D_MODEL

kernel_name = 'hybrid_ssd_rglru_gqa_swa_dit_block'

F32 = jnp.float32


def rms_norm(x, g):
    xf = x.astype(F32)
    y = xf * lax.rsqrt(jnp.mean(xf * xf, axis=-1, keepdims=True) + EPS)
    return (y * g.astype(F32)).astype(x.dtype)


def modulate(h, shift, scale):
    return h * (1.0 + scale) + shift


def conv_centred(x, w, b):
    k = w.shape[0]
    y = lax.conv_general_dilated(x, w[:, None, :].astype(x.dtype), window_strides=(1,),
                                 padding=[(k // 2, k - 1 - k // 2)],
                                 dimension_numbers=('NWC', 'WIO', 'NWC'),
                                 feature_group_count=x.shape[-1])
    return y + b.astype(x.dtype)


def rope_2d_tables(length):
    rows = length // GRID_W
    row = jnp.repeat(jnp.arange(rows, dtype=F32), GRID_W)
    col = jnp.tile(jnp.arange(GRID_W, dtype=F32), rows)
    inv = ROPE_THETA ** (-jnp.arange(0, ROPE_AXIS_DIM, 2, dtype=F32) / ROPE_AXIS_DIM)
    ang = jnp.stack([row, col], axis=-1)[:, :, None] * inv
    return jnp.cos(ang), jnp.sin(ang)


def apply_rope_2d(x, cos, sin):
    bsz, length, h, d = x.shape
    xr = x.astype(F32).reshape(bsz, length, h, 2, 2, ROPE_AXIS_DIM // 2)
    x1, x2 = xr[..., 0, :], xr[..., 1, :]
    cs, sn = cos[None, :, None], sin[None, :, None]
    out = jnp.stack([x1 * cs - x2 * sn, x2 * cs + x1 * sn], axis=-2)
    return out.reshape(bsz, length, h, d).astype(x.dtype)


def ssd_chunked(x, dt, a, bm, cm, h0):
    bsz, length, h, p = x.shape
    nc = length // SSD_CHUNK
    shp = (bsz, nc, SSD_CHUNK)
    xc = x.astype(F32).reshape(shp + (h, p))
    bc = bm.astype(F32).reshape(shp + (h, SSD_STATE))
    cc = cm.astype(F32).reshape(shp + (h, SSD_STATE))
    dtc = dt.reshape(shp + (h,))
    a_cum = jnp.cumsum(dtc * a, axis=2)
    seg = a_cum[:, :, :, None, :] - a_cum[:, :, None, :, :]
    tri = jnp.tril(jnp.ones((SSD_CHUNK, SSD_CHUNK), dtype=bool))
    decay = jnp.exp(jnp.where(tri[None, None, :, :, None], seg, -jnp.inf))
    scores = jnp.einsum('bcihn,bcjhn->bcijh', cc, bc) * decay
    y_diag = jnp.einsum('bcijh,bcjhp->bcihp', scores * dtc[:, :, None, :, :], xc)
    w_end = jnp.exp(a_cum[:, :, -1:, :] - a_cum) * dtc
    states = jnp.einsum('bcjh,bcjhn,bcjhp->bchpn', w_end, bc, xc)
    chunk_decay = jnp.exp(a_cum[:, :, -1, :])

    def step(hs, inp):
        s, dcy = inp
        return hs * dcy[:, :, None, None] + s, hs

    h_last, h_start = lax.scan(step, h0, (jnp.moveaxis(states, 1, 0), jnp.moveaxis(chunk_decay, 1, 0)))
    h_start = jnp.moveaxis(h_start, 0, 1)
    y_off = jnp.einsum('bcihn,bchpn->bcihp', cc, h_start) * jnp.exp(a_cum)[..., None]
    return (y_diag + y_off).reshape(bsz, length, h, p), h_last


def _ssd_inputs(p, conv_w, conv_b, dt_bias):
    bsz, length, _ = p.shape
    z, xbc, dt = jnp.split(p, [GROUP_WIDTH, GROUP_WIDTH + SSD_CONV_CH], axis=-1)
    xbc = jax.nn.silu(conv_centred(xbc, conv_w, conv_b))
    xs, bm, cm = jnp.split(xbc, [GROUP_WIDTH, GROUP_WIDTH + SSD_GROUPS * SSD_STATE], axis=-1)
    rep = SSD_HEADS // SSD_GROUPS
    xs = xs.reshape(bsz, length, SSD_HEADS, SSD_HEAD_DIM)
    bm = jnp.repeat(bm.reshape(bsz, length, SSD_GROUPS, SSD_STATE), rep, axis=2)
    cm = jnp.repeat(cm.reshape(bsz, length, SSD_GROUPS, SSD_STATE), rep, axis=2)
    dt = jax.nn.softplus(dt.astype(F32).reshape(bsz, length, 2, SSD_HEADS) + dt_bias.astype(F32))
    return z, xs, bm, cm, dt


def _ssd_bidir(xs, bm, cm, dt, a, h0_f, h0_b):
    y_f, s_f = ssd_chunked(xs, dt[:, :, 0], a[0], bm, cm, h0_f)
    y_b, s_b = ssd_chunked(xs[:, ::-1], dt[:, ::-1, 1], a[1], bm[:, ::-1], cm[:, ::-1], h0_b)
    return y_f + y_b[:, ::-1], s_f, s_b


def _ssd_out(y, xs, z, d_skip, norm_g):
    y = y + d_skip.astype(F32)[:, None] * xs.astype(F32)
    y = y.reshape(z.shape).astype(z.dtype)
    return rms_norm(y * jax.nn.silu(z), norm_g)


def ssd_mixer(pl, pc, conv_w, conv_b, a_log, dt_bias, d_skip, norm_g, need_ctx):
    a = -jnp.exp(a_log.astype(F32))
    zl, xl, bl, cl, dtl = _ssd_inputs(pl, conv_w, conv_b, dt_bias)
    zc, xc, bc, cc, dtc = _ssd_inputs(pc, conv_w, conv_b, dt_bias)
    h0 = jnp.zeros((pc.shape[0], SSD_HEADS, SSD_HEAD_DIM, SSD_STATE), F32)
    yc, s_f, s_b = _ssd_bidir(xc, bc, cc, dtc, a, h0, h0)
    yl, _, _ = _ssd_bidir(xl, bl, cl, dtl, a, s_f, s_b)
    out_l = _ssd_out(yl, xl, zl, d_skip, norm_g)
    out_c = _ssd_out(yc, xc, zc, d_skip, norm_g) if need_ctx else None
    return out_l, out_c


def _linear_combine(left, right):
    a_l, b_l = left
    a_r, b_r = right
    return a_l * a_r, a_r * b_l + b_r


def _rglru_dir(x, lam, w_a, b_a, w_i, b_i, h0):
    bsz, length, _ = x.shape
    xf = x.astype(F32)
    xb = xf.reshape(bsz, length, LRU_BLOCKS, LRU_BLOCK_W)
    r = jax.nn.sigmoid(jnp.einsum('blki,kij->blkj', xb, w_a.astype(F32)).reshape(bsz, length, LRU_WIDTH) + b_a.astype(F32))
    ig = jax.nn.sigmoid(jnp.einsum('blki,kij->blkj', xb, w_i.astype(F32)).reshape(bsz, length, LRU_WIDTH) + b_i.astype(F32))
    log_a = -LRU_C * r * jax.nn.softplus(-lam.astype(F32))
    a = jnp.exp(log_a)
    b = jnp.sqrt(-jnp.expm1(2.0 * log_a)) * (ig * xf)
    b = b.at[:, 0].add(a[:, 0] * h0)
    _, h = lax.associative_scan(_linear_combine, (a, b), axis=1)
    return h, h[:, -1]


def rglru_mixer(pl, pc, conv_w, conv_b, lam, w_a, b_a, w_i, b_i, need_ctx):
    gl, xl = jnp.split(pl, 2, axis=-1)
    gc, xc = jnp.split(pc, 2, axis=-1)
    xl = conv_centred(xl, conv_w, conv_b)
    xc = conv_centred(xc, conv_w, conv_b)
    h0 = jnp.zeros((pc.shape[0], LRU_WIDTH), F32)
    hc_f, s_f = _rglru_dir(xc, lam[0], w_a[0], b_a[0], w_i[0], b_i[0], h0)
    hc_b, s_b = _rglru_dir(xc[:, ::-1], lam[1], w_a[1], b_a[1], w_i[1], b_i[1], h0)
    hl_f, _ = _rglru_dir(xl, lam[0], w_a[0], b_a[0], w_i[0], b_i[0], s_f)
    hl_b, _ = _rglru_dir(xl[:, ::-1], lam[1], w_a[1], b_a[1], w_i[1], b_i[1], s_b)
    out_l = (hl_f + hl_b[:, ::-1]).astype(pl.dtype) * jax.nn.gelu(gl)
    out_c = (hc_f + hc_b[:, ::-1]).astype(pc.dtype) * jax.nn.gelu(gc) if need_ctx else None
    return out_l, out_c


def attn_heads(p, q_norm, k_norm, rope):
    bsz, length, _ = p.shape
    q, k, v = jnp.split(p, [ATTN_Q_HEADS * ATTN_HEAD_DIM, (ATTN_Q_HEADS + ATTN_KV_HEADS) * ATTN_HEAD_DIM], axis=-1)
    q = rms_norm(q.reshape(bsz, length, ATTN_Q_HEADS, ATTN_HEAD_DIM), q_norm)
    k = rms_norm(k.reshape(bsz, length, ATTN_KV_HEADS, ATTN_HEAD_DIM), k_norm)
    v = v.reshape(bsz, length, ATTN_KV_HEADS, ATTN_HEAD_DIM)
    if rope is not None:
        q = apply_rope_2d(q, rope[0], rope[1])
        k = apply_rope_2d(k, rope[0], rope[1])
    return q.reshape(bsz, length, ATTN_KV_HEADS, ATTN_GQA, ATTN_HEAD_DIM), k, v


def global_attention(q, k, v, kc, vc):
    bsz, length = q.shape[:2]
    nb = length // Q_BLOCK
    scale = ATTN_HEAD_DIM ** -0.5
    k_all = jnp.concatenate([k, kc], axis=1)
    v_all = jnp.concatenate([v, vc], axis=1)
    qb = jnp.moveaxis(q.reshape(bsz, nb, Q_BLOCK, ATTN_KV_HEADS, ATTN_GQA, ATTN_HEAD_DIM), 1, 0)

    def block(qblk):
        s = jnp.einsum('bqhgd,bkhd->bhgqk', qblk, k_all).astype(F32) * scale
        pr = jax.nn.softmax(s, axis=-1).astype(v_all.dtype)
        return jnp.einsum('bhgqk,bkhd->bqhgd', pr, v_all)

    o = lax.map(block, qb)
    return jnp.moveaxis(o, 0, 1).reshape(bsz, length, ATTN_Q_HEADS * ATTN_HEAD_DIM)


def context_attention(qc, kc, vc, sink):
    bsz, lc = qc.shape[:2]
    s = jnp.einsum('bqhgd,bkhd->bhgqk', qc, kc).astype(F32) * ATTN_HEAD_DIM ** -0.5
    if sink is not None:
        s_sink = jnp.broadcast_to(sink.astype(F32).reshape(1, ATTN_KV_HEADS, ATTN_GQA, 1, 1), s.shape[:-1] + (1,))
        s = jnp.concatenate([s, s_sink], axis=-1)
    pr = jax.nn.softmax(s, axis=-1)[..., :lc].astype(vc.dtype)
    o = jnp.einsum('bhgqk,bkhd->bqhgd', pr, vc)
    return o.reshape(bsz, lc, ATTN_Q_HEADS * ATTN_HEAD_DIM)


def window_attention(q, k, v, kc, vc, sink):
    bsz, length = q.shape[:2]
    nb = length // WINDOW
    scale = ATTN_HEAD_DIM ** -0.5
    pad = ((0, 0), (WINDOW, WINDOW), (0, 0), (0, 0))
    kp = jnp.pad(k, pad).reshape(bsz, nb + 2, WINDOW, ATTN_KV_HEADS, ATTN_HEAD_DIM)
    vp = jnp.pad(v, pad).reshape(bsz, nb + 2, WINDOW, ATTN_KV_HEADS, ATTN_HEAD_DIM)
    kw = jnp.concatenate([kp[:, :-2], kp[:, 1:-1], kp[:, 2:]], axis=2)
    vw = jnp.concatenate([vp[:, :-2], vp[:, 1:-1], vp[:, 2:]], axis=2)
    qb = q.reshape(bsz, nb, WINDOW, ATTN_KV_HEADS, ATTN_GQA, ATTN_HEAD_DIM)
    s_band = jnp.einsum('bnqhgd,bnkhd->bnhgqk', qb, kw).astype(F32) * scale
    qi = jnp.arange(WINDOW)[:, None]
    kj = jnp.arange(3 * WINDOW)[None, :]
    kpos = jnp.arange(nb)[:, None, None] * WINDOW + kj[None] - WINDOW
    mask = (jnp.abs(kj - WINDOW - qi) <= WINDOW)[None] & (kpos >= 0) & (kpos < length)
    s_band = jnp.where(mask[None, :, None, None], s_band, -jnp.inf)
    s_ctx = jnp.einsum('bnqhgd,bkhd->bnhgqk', qb, kc).astype(F32) * scale
    s_sink = jnp.broadcast_to(sink.astype(F32).reshape(1, 1, ATTN_KV_HEADS, ATTN_GQA, 1, 1), s_band.shape[:-1] + (1,))
    pr = jax.nn.softmax(jnp.concatenate([s_band, s_ctx, s_sink], axis=-1), axis=-1).astype(v.dtype)
    nk = 3 * WINDOW
    o = (jnp.einsum('bnhgqk,bnkhd->bnqhgd', pr[..., :nk], vw)
         + jnp.einsum('bnhgqk,bkhd->bnqhgd', pr[..., nk:nk + kc.shape[1]], vc))
    return o.reshape(bsz, length, ATTN_Q_HEADS * ATTN_HEAD_DIM)


def squared_relu_mlp(h, w1, w2):
    return jnp.square(jax.nn.relu(h @ w1)) @ w2


def setup_inputs(seed: int = 0) -> dict:
    key = jax.random.key(seed)
    ks = iter(jax.random.split(key, 40))

    def nrm(shape, scale):
        return jax.random.normal(next(ks), shape, F32) * scale

    L = DEPTH
    x = nrm((BATCH, SEQ, D_MODEL), 1.0)
    c = nrm((BATCH, D_MODEL), 1.0)
    ctx = nrm((BATCH, CTX_LEN, D_MODEL), 1.0)
    c_ctx = nrm((D_MODEL,), 1.0)
    w_mod = nrm((L, D_MODEL, N_MOD * D_MODEL), 0.02)
    b_mod = nrm((L, N_MOD * D_MODEL), 0.02)
    g_mix = 1.0 + nrm((L, D_MODEL), 0.02)
    w_in = nrm((L, D_MODEL, IN_COLS), D_MODEL ** -0.5)
    ssd_conv_w = nrm((L, SSD_CONV, SSD_CONV_CH), SSD_CONV ** -0.5)
    ssd_conv_b = nrm((L, SSD_CONV_CH), 0.02)
    ssd_a_log = jnp.log(jax.random.uniform(next(ks), (L, 2, SSD_HEADS), F32, 1.0, 16.0))
    dt0 = jnp.exp(jax.random.uniform(next(ks), (L, 2, SSD_HEADS), F32, math.log(1e-3), math.log(1e-1)))
    ssd_dt_bias = dt0 + jnp.log(-jnp.expm1(-dt0))
    ssd_d = 1.0 + nrm((L, SSD_HEADS), 0.02)
    ssd_norm_g = 1.0 + nrm((L, GROUP_WIDTH), 0.02)
    lru_conv_w = nrm((L, LRU_CONV, LRU_WIDTH), LRU_CONV ** -0.5)
    lru_conv_b = nrm((L, LRU_WIDTH), 0.02)
    a0 = jax.random.uniform(next(ks), (L, 2, LRU_WIDTH), F32, 0.9, 0.999)
    s0 = a0 ** (1.0 / LRU_C)
    lru_lambda = jnp.log(s0) - jnp.log1p(-s0)
    lru_w_a = nrm((L, 2, LRU_BLOCKS, LRU_BLOCK_W, LRU_BLOCK_W), LRU_BLOCK_W ** -0.5)
    lru_b_a = nrm((L, 2, LRU_WIDTH), 0.02)
    lru_w_i = nrm((L, 2, LRU_BLOCKS, LRU_BLOCK_W, LRU_BLOCK_W), LRU_BLOCK_W ** -0.5)
    lru_b_i = nrm((L, 2, LRU_WIDTH), 0.02)
    gqa_q_norm = 1.0 + nrm((L, ATTN_HEAD_DIM), 0.02)
    gqa_k_norm = 1.0 + nrm((L, ATTN_HEAD_DIM), 0.02)
    swa_q_norm = 1.0 + nrm((L, ATTN_HEAD_DIM), 0.02)
    swa_k_norm = 1.0 + nrm((L, ATTN_HEAD_DIM), 0.02)
    swa_sink = nrm((L, ATTN_Q_HEADS), 0.5)
    w_out = nrm((L, MIX_WIDTH, D_MODEL), MIX_WIDTH ** -0.5)
    g_ffn = 1.0 + nrm((L, D_MODEL), 0.02)
    w_ffn1 = nrm((L, D_MODEL, FFN_HIDDEN), D_MODEL ** -0.5)
    w_ffn2 = nrm((L, FFN_HIDDEN, D_MODEL), FFN_HIDDEN ** -0.5)
    return {'x': x, 'c': c, 'ctx': ctx, 'c_ctx': c_ctx, 'w_mod': w_mod, 'b_mod': b_mod,
            'g_mix': g_mix, 'w_in': w_in, 'ssd_conv_w': ssd_conv_w, 'ssd_conv_b': ssd_conv_b,
            'ssd_a_log': ssd_a_log, 'ssd_dt_bias': ssd_dt_bias, 'ssd_d': ssd_d, 'ssd_norm_g': ssd_norm_g,
            'lru_conv_w': lru_conv_w, 'lru_conv_b': lru_conv_b, 'lru_lambda': lru_lambda,
            'lru_w_a': lru_w_a, 'lru_b_a': lru_b_a, 'lru_w_i': lru_w_i, 'lru_b_i': lru_b_i,
            'gqa_q_norm': gqa_q_norm, 'gqa_k_norm': gqa_k_norm, 'swa_q_norm': swa_q_norm,
            'swa_k_norm': swa_k_norm, 'swa_sink': swa_sink, 'w_out': w_out, 'g_ffn': g_ffn,
            'w_ffn1': w_ffn1, 'w_ffn2': w_ffn2}


def reference(x, c, ctx, c_ctx, w_mod, b_mod, g_mix, w_in, ssd_conv_w, ssd_conv_b, ssd_a_log,
              ssd_dt_bias, ssd_d, ssd_norm_g, lru_conv_w, lru_conv_b, lru_lambda, lru_w_a, lru_b_a,
              lru_w_i, lru_b_i, gqa_q_norm, gqa_k_norm, swa_q_norm, swa_k_norm, swa_sink, w_out,
              g_ffn, w_ffn1, w_ffn2):
    rope = rope_2d_tables(x.shape[1])
    for l in range(DEPTH):
        need_ctx = l < DEPTH - 1
        m_lat = (jax.nn.silu(c) @ w_mod[l] + b_mod[l])[:, None, :]
        m_ctx = (jax.nn.silu(c_ctx) @ w_mod[l] + b_mod[l])[None, None, :]
        sh1, sc1, ga1, sh2, sc2, ga2 = jnp.split(m_lat, N_MOD, axis=-1)
        csh1, csc1, cga1, csh2, csc2, cga2 = jnp.split(m_ctx, N_MOD, axis=-1)

        pl = modulate(rms_norm(x, g_mix[l]), sh1, sc1) @ w_in[l]
        pc = modulate(rms_norm(ctx, g_mix[l]), csh1, csc1) @ w_in[l]
        pl_a, pl_b, pl_c, pl_d = jnp.split(pl, IN_SPLITS, axis=-1)
        pc_a, pc_b, pc_c, pc_d = jnp.split(pc, IN_SPLITS, axis=-1)

        ya_l, ya_c = ssd_mixer(pl_a, pc_a, ssd_conv_w[l], ssd_conv_b[l], ssd_a_log[l],
                               ssd_dt_bias[l], ssd_d[l], ssd_norm_g[l], need_ctx)
        yb_l, yb_c = rglru_mixer(pl_b, pc_b, lru_conv_w[l], lru_conv_b[l], lru_lambda[l],
                                 lru_w_a[l], lru_b_a[l], lru_w_i[l], lru_b_i[l], need_ctx)
        qcl, kcl, vcl = attn_heads(pl_c, gqa_q_norm[l], gqa_k_norm[l], rope)
        qcc, kcc, vcc = attn_heads(pc_c, gqa_q_norm[l], gqa_k_norm[l], None)
        yc_l = global_attention(qcl, kcl, vcl, kcc, vcc)
        qdl, kdl, vdl = attn_heads(pl_d, swa_q_norm[l], swa_k_norm[l], rope)
        qdc, kdc, vdc = attn_heads(pc_d, swa_q_norm[l], swa_k_norm[l], None)
        yd_l = window_attention(qdl, kdl, vdl, kdc, vdc, swa_sink[l])

        x = x + ga1 * (jnp.concatenate([ya_l, yb_l, yc_l, yd_l], axis=-1) @ w_out[l])
        x = x + ga2 * squared_relu_mlp(modulate(rms_norm(x, g_ffn[l]), sh2, sc2), w_ffn1[l], w_ffn2[l])

        if need_ctx:
            yc_c = context_attention(qcc, kcc, vcc, None)
            yd_c = context_attention(qdc, kdc, vdc, swa_sink[l])
            ctx = ctx + cga1 * (jnp.concatenate([ya_c, yb_c, yc_c, yd_c], axis=-1) @ w_out[l])
            ctx = ctx + cga2 * squared_relu_mlp(modulate(rms_norm(ctx, g_ffn[l]), csh2, csc2), w_ffn1[l], w_ffn2[l])
    return x
```

```cpp
#ifndef CPU_EMU
#include <hip/hip_runtime.h>
#include <hip/hip_cooperative_groups.h>
#include <cstdio>
namespace cg = cooperative_groups;
#define DEV __device__ __forceinline__
#define DEVM __device__ __forceinline__
#else
#define DEV static inline
#define DEVM inline
#endif
#include <stdint.h>
#include <stddef.h>
#include <math.h>
#include <string.h>

#ifndef CFG_BATCH
#define CFG_BATCH 4
#endif
#ifndef CFG_SEQ
#define CFG_SEQ 4096
#endif
constexpr int NB = CFG_BATCH, SEQ = CFG_SEQ, CTX = 256, DM = 1024, SB = CTX + SEQ, MT = NB * SB;
constexpr int NPL = 2560, FF = 4096, NMOD = 6144, NL = 2, GRIDW = 64;
constexpr float EPS = 1e-6f;
constexpr int PL_Z = 0, PL_XBC = 256, PL_LG = 1024, PL_LX = 1280, PL_C = 1536, PL_D = 2048;
constexpr int MIX_A = 0, MIX_B = 256, MIX_C = 512, MIX_D = 768;
constexpr size_t MiB = 1u << 20;
constexpr size_t WS_CTL = 0, WS_MOD = 1 * MiB, WS_WDT = WS_MOD + 256 * 1024, WS_WIN = 2 * MiB, WS_WOUT = 7 * MiB, WS_WF1 = 9 * MiB, WS_WF2 = 17 * MiB, WS_XRC = 25 * MiB, WS_DTP = 29 * MiB;
constexpr size_t WS_XN = 30 * MiB;
constexpr size_t WS_B = 64 * MiB;
constexpr size_t WS_H = WS_B, WS_PL = WS_B, WS_XBC = 149 * MiB, WS_T0 = 175 * MiB, WS_T1 = 192 * MiB, WS_T2 = 209 * MiB, WS_T3 = 226 * MiB, WS_END = 256 * MiB;
constexpr size_t WS_XLC = WS_T0, WS_LHF = WS_T1, WS_LA = WS_T2, WS_LB = WS_T3;
static_assert((size_t)MT * NPL * 2 <= WS_XBC - WS_PL && (size_t)MT * 768 * 2 <= WS_XLC - WS_XBC && (size_t)MT * 256 * 4 <= 17 * MiB && (size_t)MT * FF * 2 <= WS_END - WS_H && (size_t)MT * DM * 2 <= WS_B - WS_XN, "ws map");
static_assert((size_t)NB * CTX * DM * 4 <= WS_DTP - WS_XRC && (size_t)MT * 8 * 4 <= WS_XN - WS_DTP && (size_t)NL * (NB + 1) * NMOD * 4 <= 256 * 1024, "ws map 2");

struct Params {
    const float *x, *c, *ctx, *c_ctx, *w_mod, *b_mod, *g_mix, *w_in, *ssd_conv_w, *ssd_conv_b, *ssd_a_log, *ssd_dt_bias, *ssd_d, *ssd_norm_g, *lru_conv_w, *lru_conv_b, *lru_lambda,
        *lru_w_a, *lru_b_a, *lru_w_i, *lru_b_i, *gqa_q_norm, *gqa_k_norm, *swa_q_norm, *swa_k_norm, *swa_sink, *w_out, *g_ffn, *w_ffn1, *w_ffn2;
    float* out; unsigned char* ws;
};
typedef uint16_t bf16_t;
struct U4 { uint32_t x, y, z, w; };
struct U2 { uint32_t x, y; };

DEV float u2f(uint32_t u) { float f; memcpy(&f, &u, 4); return f; }
DEV uint32_t f2u(float f) { uint32_t u; memcpy(&u, &f, 4); return u; }
DEV float bf2f(bf16_t h) { return u2f((uint32_t)h << 16); }
DEV bf16_t f2bf(float f) { uint32_t u = f2u(f); return (bf16_t)((u + 0x7fffu + ((u >> 16) & 1u)) >> 16); }
DEV float bflo(uint32_t w) { return u2f(w << 16); }
DEV float bfhi(uint32_t w) { return u2f(w & 0xffff0000u); }
DEV float silu_f(float x) { return x / (1.f + expf(-x)); }
DEV float sigmoid_f(float x) { return 1.f / (1.f + expf(-x)); }
DEV float softplus_f(float x) { return fmaxf(x, 0.f) + log1pf(expf(-fabsf(x))); }
DEV float gelu_tanh_f(float x) { return 0.5f * x * (1.f + tanhf(0.7978845608028654f * (x + 0.044715f * x * x * x))); }

DEV float* resid_row(const Params& P, int r) { const int b = r / SB, s = r % SB; return s < CTX ? (float*)(P.ws + WS_XRC) + ((size_t)b * CTX + s) * DM : P.out + ((size_t)b * SEQ + (s - CTX)) * DM; }
DEV const float* xin_row(const Params& P, int l, int r) { const int b = r / SB, s = r % SB; if (l == 0) return s < CTX ? P.ctx + ((size_t)b * CTX + s) * DM : P.x + ((size_t)b * SEQ + (s - CTX)) * DM; return resid_row(P, r); }
DEV const float* mod_row(const Params& P, int l, int r) { const int b = r / SB, s = r % SB; const int bm = s < CTX ? NB : b; return (const float*)(P.ws + WS_MOD) + ((size_t)l * (NB + 1) + bm) * NMOD; }
DEV int scan_pos(int dir, int step) { return dir == 0 ? step : (step < CTX ? CTX - 1 - step : SB - 1 - (step - CTX)); }

DEV void st_mod(const Params& P, long it) {
    const int n = (int)(it % NMOD); const int rb = (int)(it / NMOD); const int bm = rb % (NB + 1), l = rb / (NB + 1);
    const float* cv = bm < NB ? P.c + (size_t)bm * DM : P.c_ctx;
    float acc = P.b_mod[(size_t)l * NMOD + n];
    for (int k = 0; k < DM; ++k) acc += silu_f(cv[k]) * P.w_mod[((size_t)l * DM + k) * NMOD + n];
    ((float*)(P.ws + WS_MOD))[it] = acc;
}
constexpr long WC_R0 = (long)NPL * DM, WC_R1 = WC_R0 + 8 * DM, WC_R2 = WC_R1 + (long)DM * DM, WC_R3 = WC_R2 + (long)FF * DM, WC_R4 = WC_R3 + (long)DM * FF;
DEV void st_wconv(const Params& P, long it, int l) {
    if (it < WC_R0) { const int n = (int)(it / DM), k = (int)(it % DM); const int no = n < 1024 ? n : n + 8; ((bf16_t*)(P.ws + WS_WIN))[it] = f2bf(P.w_in[((size_t)l * DM + k) * 2568 + no]); return; }
    if (it < WC_R1) { const long i = it - WC_R0; const int j = (int)(i / DM), k = (int)(i % DM); ((float*)(P.ws + WS_WDT))[i] = P.w_in[((size_t)l * DM + k) * 2568 + 1024 + j]; return; }
    if (it < WC_R2) { const long i = it - WC_R1; const int n = (int)(i / DM), k = (int)(i % DM); ((bf16_t*)(P.ws + WS_WOUT))[i] = f2bf(P.w_out[((size_t)l * DM + k) * DM + n]); return; }
    if (it < WC_R3) { const long i = it - WC_R2; const int n = (int)(i / DM), k = (int)(i % DM); ((bf16_t*)(P.ws + WS_WF1))[i] = f2bf(P.w_ffn1[((size_t)l * DM + k) * FF + n]); return; }
    { const long i = it - WC_R3; const int n = (int)(i / FF), k = (int)(i % FF); ((bf16_t*)(P.ws + WS_WF2))[i] = f2bf(P.w_ffn2[((size_t)l * FF + k) * DM + n]); }
}
DEV void st_norm(const Params& P, long it, int l, int which) {
    const int r = (int)it; const float* xr = which == 0 ? xin_row(P, l, r) : resid_row(P, r); const float* md = mod_row(P, l, r);
    const float* g = (which == 0 ? P.g_mix : P.g_ffn) + (size_t)l * DM; const float* sh = md + (which == 0 ? 0 : 3072); const float* sc = sh + 1024;
    float ss = 0.f; for (int k = 0; k < DM; ++k) ss += xr[k] * xr[k];
    const float rs = 1.0f / sqrtf(ss * (1.0f / DM) + EPS);
    bf16_t* o = (bf16_t*)(P.ws + WS_XN) + (size_t)r * DM; const float* wdt = (const float*)(P.ws + WS_WDT);
    float dt[8]; for (int j = 0; j < 8; ++j) dt[j] = 0.f;
    for (int k = 0; k < DM; ++k) { const float v = (xr[k] * rs * g[k]) * (1.f + sc[k]) + sh[k]; o[k] = f2bf(v);
        if (which == 0) { for (int j = 0; j < 8; ++j) dt[j] += v * wdt[j * DM + k]; } }
    if (which == 0) { float* d = (float*)(P.ws + WS_DTP) + (size_t)r * 8; for (int j = 0; j < 8; ++j) d[j] = dt[j]; }
}
template <class Epi> DEV void st_gemm(long it, const bf16_t* A, int lda, const bf16_t* Bt, int N, int K, const Epi& E) {
    const int ntn = N / 4; const int r0 = (int)(it / ntn) * 8, n0 = (int)(it % ntn) * 4;
    float acc[8][4];
#pragma unroll
    for (int i = 0; i < 8; ++i)
#pragma unroll
        for (int j = 0; j < 4; ++j) acc[i][j] = 0.f;
#pragma unroll 1
    for (int k = 0; k < K; k += 4) {
        U2 a[8], b[4];
#pragma unroll
        for (int i = 0; i < 8; ++i) a[i] = *(const U2*)(A + (size_t)(r0 + i) * lda + k);
#pragma unroll
        for (int j = 0; j < 4; ++j) b[j] = *(const U2*)(Bt + (size_t)(n0 + j) * K + k);
#pragma unroll
        for (int kk = 0; kk < 2; ++kk) {
            float al[8], ah[8], bl[4], bh[4];
#pragma unroll
            for (int i = 0; i < 8; ++i) { const uint32_t wa = kk == 0 ? a[i].x : a[i].y; al[i] = bflo(wa); ah[i] = bfhi(wa); }
#pragma unroll
            for (int j = 0; j < 4; ++j) { const uint32_t wb = kk == 0 ? b[j].x : b[j].y; bl[j] = bflo(wb); bh[j] = bfhi(wb); }
#pragma unroll
            for (int i = 0; i < 8; ++i)
#pragma unroll
                for (int j = 0; j < 4; ++j) acc[i][j] += al[i] * bl[j] + ah[i] * bh[j];
        }
    }
    E(r0, n0, acc);
}
struct EpiPL { const Params& P; DEVM void operator()(int r0, int n0, const float (&acc)[8][4]) const { bf16_t* pl = (bf16_t*)(P.ws + WS_PL);
#pragma unroll
    for (int i = 0; i < 8; ++i)
#pragma unroll
        for (int j = 0; j < 4; ++j) pl[(size_t)(r0 + i) * NPL + n0 + j] = f2bf(acc[i][j]); } };
struct EpiOut { const Params& P; int l; DEVM void operator()(int r0, int n0, const float (&acc)[8][4]) const {
#pragma unroll
    for (int i = 0; i < 8; ++i) { const int r = r0 + i; const float* md = mod_row(P, l, r) + 2048; const float* xi = xin_row(P, l, r); float* xo = resid_row(P, r);
#pragma unroll
        for (int j = 0; j < 4; ++j) xo[n0 + j] = xi[n0 + j] + md[n0 + j] * acc[i][j]; } } };
struct EpiF1 { const Params& P; DEVM void operator()(int r0, int n0, const float (&acc)[8][4]) const { bf16_t* h = (bf16_t*)(P.ws + WS_H);
#pragma unroll
    for (int i = 0; i < 8; ++i)
#pragma unroll
        for (int j = 0; j < 4; ++j) { const float v = fmaxf(acc[i][j], 0.f); h[(size_t)(r0 + i) * FF + n0 + j] = f2bf(v * v); } } };
struct EpiF2 { const Params& P; int l; DEVM void operator()(int r0, int n0, const float (&acc)[8][4]) const {
#pragma unroll
    for (int i = 0; i < 8; ++i) { const int r = r0 + i; const float* md = mod_row(P, l, r) + 5120; float* xo = resid_row(P, r);
#pragma unroll
        for (int j = 0; j < 4; ++j) xo[n0 + j] = xo[n0 + j] + md[n0 + j] * acc[i][j]; } } };

DEV void st_prep(const Params& P, long it, int l) {
    const int r = (int)(it >> 10), c = (int)(it & 1023); const int b = r / SB, s = r % SB; const int lo = s < CTX ? 0 : CTX, hi = s < CTX ? CTX : SB;
    const bf16_t* pl = (const bf16_t*)(P.ws + WS_PL);
    if (c < 768) { float acc = P.ssd_conv_b[l * 768 + c];
        for (int t = 0; t < 4; ++t) { const int ss = s + t - 2; if (ss >= lo && ss < hi) acc += P.ssd_conv_w[(l * 4 + t) * 768 + c] * bf2f(pl[(size_t)(b * SB + ss) * NPL + PL_XBC + c]); }
        ((bf16_t*)(P.ws + WS_XBC))[(size_t)r * 768 + c] = f2bf(silu_f(acc)); }
    else { const int ch = c - 768; float acc = P.lru_conv_b[l * 256 + ch];
        for (int t = 0; t < 4; ++t) { const int ss = s + t - 2; if (ss >= lo && ss < hi) acc += P.lru_conv_w[(l * 4 + t) * 256 + ch] * bf2f(pl[(size_t)(b * SB + ss) * NPL + PL_LX + ch]); }
        ((float*)(P.ws + WS_XLC))[(size_t)r * 256 + ch] = acc; }
}
DEV void st_qk(const Params& P, long it, int l) {
    const int r = (int)(it / 12), slot = (int)(it % 12); const int t = slot / 6, hs = slot % 6; const int s = r % SB;
    const int col = (t ? PL_D : PL_C) + (hs < 4 ? hs * 64 : 256 + (hs - 4) * 64);
    const float* g = (hs < 4 ? (t ? P.swa_q_norm : P.gqa_q_norm) : (t ? P.swa_k_norm : P.gqa_k_norm)) + l * 64;
    bf16_t* p = (bf16_t*)(P.ws + WS_PL) + (size_t)r * NPL + col;
    float ss = 0.f;
    for (int d = 0; d < 64; ++d) { const float v = bf2f(p[d]); ss += v * v; }
    const float rs = 1.0f / sqrtf(ss * (1.0f / 64) + EPS); const float qs = hs < 4 ? 0.125f : 1.f;
    const bool lat = s >= CTX; const int pos = s - CTX; const float pr = (float)(pos / GRIDW), pc = (float)(pos % GRIDW);
#pragma unroll 1
    for (int pi = 0; pi < 32; ++pi) { const int a = pi >> 4, i = pi & 15; const int d1 = a * 32 + i, d2 = d1 + 16;
        const float x1 = bf2f(p[d1]) * rs * g[d1], x2 = bf2f(p[d2]) * rs * g[d2]; float cs = 1.f, sn = 0.f;
        if (lat) { const float inv = expf(-(float)i * (9.210340371976184f / 16.f)); const float ang = (a ? pc : pr) * inv; cs = cosf(ang); sn = sinf(ang); }
        p[d1] = f2bf((x1 * cs - x2 * sn) * qs); p[d2] = f2bf((x2 * cs + x1 * sn) * qs); }
}
DEV void st_lru_gate(const Params& P, long it, int l, int dir) {
    const int r = (int)(it >> 8), ch = (int)(it & 255); const int k = ch >> 6, j = ch & 63;
    const float* xr = (const float*)(P.ws + WS_XLC) + (size_t)r * 256 + k * 64;
    const float* wa = P.lru_w_a + ((((size_t)l * 2 + dir) * 4 + k) * 64) * 64 + j; const float* wi = P.lru_w_i + ((((size_t)l * 2 + dir) * 4 + k) * 64) * 64 + j;
    float da = P.lru_b_a[(l * 2 + dir) * 256 + ch], di = P.lru_b_i[(l * 2 + dir) * 256 + ch];
    for (int i = 0; i < 64; ++i) { const float xv = xr[i]; da += xv * wa[i * 64]; di += xv * wi[i * 64]; }
    const float sp = softplus_f(-P.lru_lambda[(l * 2 + dir) * 256 + ch]);
    const float la = -8.0f * sigmoid_f(da) * sp;
    ((float*)(P.ws + WS_LA))[it] = expf(la); ((float*)(P.ws + WS_LB))[it] = sqrtf(-expm1f(2.f * la)) * (sigmoid_f(di) * xr[j]);
}
DEV void st_lru_scan(const Params& P, long it, int l, int dir) {
    const int ch = (int)(it & 255), b = (int)(it >> 8);
    const float* LA = (const float*)(P.ws + WS_LA); const float* LB = (const float*)(P.ws + WS_LB);
    float* lhf = (float*)(P.ws + WS_LHF); bf16_t* mix = (bf16_t*)(P.ws + WS_XN); const bf16_t* pl = (const bf16_t*)(P.ws + WS_PL);
    float h = 0.f;
    for (int step = 0; step < SB; ++step) { const int r = b * SB + scan_pos(dir, step);
        h = LA[(size_t)r * 256 + ch] * h + LB[(size_t)r * 256 + ch];
        if (dir == 0) lhf[(size_t)r * 256 + ch] = h;
        else mix[(size_t)r * DM + MIX_B + ch] = f2bf((lhf[(size_t)r * 256 + ch] + h) * gelu_tanh_f(bf2f(pl[(size_t)r * NPL + PL_LG + ch]))); }
}
DEV void st_ssd_scan(const Params& P, long it, int l) {
    const int p = (int)(it & 63), nh = (int)((it >> 6) & 1), dir = (int)((it >> 7) & 1), hd = (int)((it >> 8) & 3), b = (int)(it >> 10);
    const float a = -expf(P.ssd_a_log[(l * 2 + dir) * 4 + hd]), dtb = P.ssd_dt_bias[(l * 2 + dir) * 4 + hd];
    const bf16_t* xbc = (const bf16_t*)(P.ws + WS_XBC); const float* dtp = (const float*)(P.ws + WS_DTP); float* Y = (float*)(P.ws + WS_T0 + (size_t)(dir * 2 + nh) * (WS_T1 - WS_T0));
    float hst[64];
#pragma unroll
    for (int n = 0; n < 64; ++n) hst[n] = 0.f;
#pragma unroll 1
    for (int step = 0; step < SB; ++step) { const int r = b * SB + scan_pos(dir, step);
        const float dt = softplus_f(dtp[(size_t)r * 8 + dir * 4 + hd] + dtb); const float dec = expf(dt * a);
        const float dx = dt * bf2f(xbc[(size_t)r * 768 + hd * 64 + p]);
        const bf16_t* Bp = xbc + (size_t)r * 768 + 256 + (hd >> 1) * 128 + nh * 64; const bf16_t* Cp = Bp + 256;
        float y = 0.f;
#pragma unroll
        for (int n8 = 0; n8 < 8; ++n8) { const U4 bw = *(const U4*)(Bp + n8 * 8), cw = *(const U4*)(Cp + n8 * 8);
            const float bv[8] = {bflo(bw.x), bfhi(bw.x), bflo(bw.y), bfhi(bw.y), bflo(bw.z), bfhi(bw.z), bflo(bw.w), bfhi(bw.w)};
            const float cv[8] = {bflo(cw.x), bfhi(cw.x), bflo(cw.y), bfhi(cw.y), bflo(cw.z), bfhi(cw.z), bflo(cw.w), bfhi(cw.w)};
#pragma unroll
            for (int e = 0; e < 8; ++e) { const int n = n8 * 8 + e; hst[n] = dec * hst[n] + dx * bv[e]; y += hst[n] * cv[e]; } }
        Y[(size_t)r * 256 + hd * 64 + p] = y; }
}
DEV void st_ssd_out(const Params& P, long it, int l) {
    const int r = (int)it; const float* y0 = (const float*)(P.ws + WS_T0) + (size_t)r * 256; const float* y1 = (const float*)(P.ws + WS_T1) + (size_t)r * 256;
    const float* y2 = (const float*)(P.ws + WS_T2) + (size_t)r * 256; const float* y3 = (const float*)(P.ws + WS_T3) + (size_t)r * 256;
    const bf16_t* xs = (const bf16_t*)(P.ws + WS_XBC) + (size_t)r * 768; const bf16_t* z = (const bf16_t*)(P.ws + WS_PL) + (size_t)r * NPL + PL_Z;
    bf16_t* mix = (bf16_t*)(P.ws + WS_XN) + (size_t)r * DM + MIX_A;
    float ss = 0.f;
    for (int c = 0; c < 256; ++c) { const float y = ((y0[c] + y1[c]) + (y2[c] + y3[c]) + P.ssd_d[l * 4 + (c >> 6)] * bf2f(xs[c])) * silu_f(bf2f(z[c])); ss += y * y; }
    const float rs = 1.0f / sqrtf(ss * (1.0f / 256) + EPS);
    for (int c = 0; c < 256; ++c) { const float y = ((y0[c] + y1[c]) + (y2[c] + y3[c]) + P.ssd_d[l * 4 + (c >> 6)] * bf2f(xs[c])) * silu_f(bf2f(z[c])); mix[c] = f2bf(y * rs * P.ssd_norm_g[l * 256 + c]); }
}
DEV void st_attn(const Params& P, long it, int l, int type) {
    const int hq = (int)(it / MT), r = (int)(it % MT); const int b = r / SB, s = r % SB; const bool isctx = s < CTX;
    if (isctx && l == NL - 1) return;
    const bf16_t* pl = (const bf16_t*)(P.ws + WS_PL); const int cb = type ? PL_D : PL_C; const int kcol = cb + 256 + (hq >> 1) * 64, vcol = kcol + 128;
    float q[64], o[64];
#pragma unroll
    for (int d = 0; d < 64; ++d) { q[d] = bf2f(pl[(size_t)r * NPL + cb + hq * 64 + d]); o[d] = 0.f; }
    float m = -INFINITY, ls = 0.f;
    for (int seg = 0; seg < 2; ++seg) {
        int lo, hi;
        if (seg == 0) { lo = 0; hi = CTX; }
        else { if (isctx) break; if (type == 0) { lo = CTX; hi = SB; } else { lo = s - 128 < CTX ? CTX : s - 128; hi = s + 129 > SB ? SB : s + 129; } }
        for (int sk = lo; sk < hi; ++sk) { const bf16_t* kp = pl + (size_t)(b * SB + sk) * NPL + kcol; const bf16_t* vp = pl + (size_t)(b * SB + sk) * NPL + vcol;
            float sc = 0.f;
#pragma unroll
            for (int d8 = 0; d8 < 8; ++d8) { const U4 w = *(const U4*)(kp + d8 * 8);
                sc += q[d8 * 8 + 0] * bflo(w.x) + q[d8 * 8 + 1] * bfhi(w.x) + q[d8 * 8 + 2] * bflo(w.y) + q[d8 * 8 + 3] * bfhi(w.y) + q[d8 * 8 + 4] * bflo(w.z) + q[d8 * 8 + 5] * bfhi(w.z) + q[d8 * 8 + 6] * bflo(w.w) + q[d8 * 8 + 7] * bfhi(w.w); }
            const float mn = fmaxf(m, sc); const float al = expf(m - mn), pe = expf(sc - mn); m = mn; ls = ls * al + pe;
#pragma unroll
            for (int d8 = 0; d8 < 8; ++d8) { const U4 w = *(const U4*)(vp + d8 * 8);
                o[d8 * 8 + 0] = o[d8 * 8 + 0] * al + pe * bflo(w.x); o[d8 * 8 + 1] = o[d8 * 8 + 1] * al + pe * bfhi(w.x); o[d8 * 8 + 2] = o[d8 * 8 + 2] * al + pe * bflo(w.y); o[d8 * 8 + 3] = o[d8 * 8 + 3] * al + pe * bfhi(w.y);
                o[d8 * 8 + 4] = o[d8 * 8 + 4] * al + pe * bflo(w.z); o[d8 * 8 + 5] = o[d8 * 8 + 5] * al + pe * bfhi(w.z); o[d8 * 8 + 6] = o[d8 * 8 + 6] * al + pe * bflo(w.w); o[d8 * 8 + 7] = o[d8 * 8 + 7] * al + pe * bfhi(w.w); } }
    }
    if (type == 1) { const float sk = P.swa_sink[l * 4 + hq]; const float mn = fmaxf(m, sk); const float al = expf(m - mn); ls = ls * al + expf(sk - mn);
#pragma unroll
        for (int d = 0; d < 64; ++d) o[d] *= al; }
    const float inv = 1.0f / ls; bf16_t* mix = (bf16_t*)(P.ws + WS_XN) + (size_t)r * DM + (type ? MIX_D : MIX_C) + hq * 64;
#pragma unroll
    for (int d = 0; d < 64; ++d) mix[d] = f2bf(o[d] * inv);
}

#ifdef CPU_EMU
#define RUN(off, n, CALL) do { const long _n = (n); _Pragma("omp parallel for schedule(dynamic, 16)") for (long it = 0; it < _n; ++it) { CALL; } } while (0)
#define SYNC() do {} while (0)
#else
#define RUN(off, n, CALL) do { const long _n = (n); for (long _iw = (gw + NGW - ((off) % NGW)) % NGW; _iw * 64 < _n; _iw += NGW) { const long it = _iw * 64 + lane; if (it < _n) { CALL; } } } while (0)
#define SYNC() grid.sync()
#endif
#ifndef STAGE_MASK
#define STAGE_MASK 0xffff
#endif
#define SM(b) if (STAGE_MASK & (1 << (b)))
#define FORWARD_PROGRAM() do { \
    const bf16_t* XN = (const bf16_t*)(P.ws + WS_XN); const bf16_t* HB = (const bf16_t*)(P.ws + WS_H); \
    const bf16_t* WIN = (const bf16_t*)(P.ws + WS_WIN); const bf16_t* WOUT = (const bf16_t*)(P.ws + WS_WOUT); const bf16_t* WF1 = (const bf16_t*)(P.ws + WS_WF1); const bf16_t* WF2 = (const bf16_t*)(P.ws + WS_WF2); \
    SM(0) RUN(0, (long)NL * (NB + 1) * NMOD, st_mod(P, it)); \
    for (int l = 0; l < NL; ++l) { \
        SM(1) RUN(960, WC_R4, st_wconv(P, it, l)); SYNC(); \
        SM(2) RUN(0, MT, st_norm(P, it, l, 0)); SYNC(); \
        SM(3) RUN(0, (long)(MT / 8) * (NPL / 4), st_gemm(it, XN, DM, WIN, NPL, DM, EpiPL{P})); SYNC(); \
        SM(4) RUN(0, (long)MT * 1024, st_prep(P, it, l)); SM(5) RUN(0, (long)MT * 12, st_qk(P, it, l)); SYNC(); \
        SM(6) RUN(0, (long)MT * 256, st_lru_gate(P, it, l, 0)); SM(8) RUN(0, (long)MT * 4, st_attn(P, it, l, 0)); SM(9) RUN(0, (long)MT * 4, st_attn(P, it, l, 1)); SYNC(); \
        SM(6) RUN(0, (long)NB * 256, st_lru_scan(P, it, l, 0)); SYNC(); \
        SM(6) RUN(0, (long)MT * 256, st_lru_gate(P, it, l, 1)); SYNC(); \
        SM(6) RUN(0, (long)NB * 256, st_lru_scan(P, it, l, 1)); SYNC(); \
        SM(7) RUN(0, (long)NB * 1024, st_ssd_scan(P, it, l)); SYNC(); \
        SM(10) RUN(0, MT, st_ssd_out(P, it, l)); SYNC(); \
        SM(11) RUN(0, (long)(MT / 8) * (DM / 4), st_gemm(it, XN, DM, WOUT, DM, DM, EpiOut{P, l})); SYNC(); \
        SM(2) RUN(0, MT, st_norm(P, it, l, 1)); SYNC(); \
        SM(12) RUN(0, (long)(MT / 8) * (FF / 4), st_gemm(it, XN, DM, WF1, FF, DM, EpiF1{P})); SYNC(); \
        SM(13) RUN(0, (long)(MT / 8) * (DM / 4), st_gemm(it, HB, FF, WF2, DM, FF, EpiF2{P, l})); SYNC(); \
    } } while (0)

#ifdef CPU_EMU
static void forward_emu(const Params& P) { FORWARD_PROGRAM(); }
#else
constexpr int NTHREADS = 512;
__global__ void __launch_bounds__(NTHREADS) fwd_kernel(Params P) {
    cg::grid_group grid = cg::this_grid();
    const int lane = threadIdx.x & 63, wave = threadIdx.x >> 6; const long G = gridDim.x; const long gw = (long)wave * G + blockIdx.x, NGW = 8 * G;
    FORWARD_PROGRAM();
}

extern "C" void kernel_launch(void* const* d_in, const int* in_sizes, int n_in, void* d_out, int out_size, void* d_ws, size_t ws_size, hipStream_t stream) {
    static int grid_blocks = 0;
    if (!grid_blocks) {
        int dev = 0, cus = 0, per_cu = 0;
        hipGetDevice(&dev); hipDeviceGetAttribute(&cus, hipDeviceAttributeMultiprocessorCount, dev);
        hipOccupancyMaxActiveBlocksPerMultiprocessor(&per_cu, fwd_kernel, NTHREADS, 0);
        if (per_cu < 1) per_cu = 1;
        if (per_cu > 1) per_cu = 1;
        grid_blocks = cus * per_cu;
        if (n_in != 30 || out_size != NB * SEQ * DM || ws_size < WS_END) fprintf(stderr, "kernel_launch: unexpected shapes n_in %d out %d ws %zu\n", n_in, out_size, ws_size);
    }
    Params p{};
    const float** pp = (const float**)&p;
    for (int i = 0; i < 30; ++i) pp[i] = (const float*)d_in[i];
    p.out = (float*)d_out; p.ws = (unsigned char*)d_ws;
    void* args[] = {&p};
    hipError_t e = hipLaunchCooperativeKernel((void*)fwd_kernel, dim3(grid_blocks), dim3(NTHREADS), args, 0, stream);
    if (e != hipSuccess) fprintf(stderr, "cooperative launch failed: %s (grid %d)\n", hipGetErrorString(e), grid_blocks);
}
#endif
```

```cpp
#ifndef CPU_EMU
#include <hip/hip_runtime.h>
#include <hip/hip_cooperative_groups.h>
#include <cstdio>
namespace cg = cooperative_groups;
#define DEV __device__ __forceinline__
#define DEVM __device__ __forceinline__
#else
#define DEV static inline
#define DEVM inline
#endif
#include <stdint.h>
#include <stddef.h>
#include <math.h>
#include <string.h>

#ifndef CFG_BATCH
#define CFG_BATCH 4
#endif
#ifndef CFG_SEQ
#define CFG_SEQ 4096
#endif
constexpr int NB = CFG_BATCH, SEQ = CFG_SEQ, CTX = 256, DM = 1024, SB = CTX + SEQ, MT = NB * SB;
constexpr int NPL = 2560, FF = 4096, NMOD = 6144, NL = 2, GRIDW = 64;
constexpr int CHK = 128, NCH = SB / CHK, NCC = CTX / CHK;
constexpr float EPS = 1e-6f, LOG2E = 1.4426950408889634f, QSCALE = 0.125f * 1.4426950408889634f;
constexpr int PL_Z = 0, PL_XBC = 256, PL_LG = 1024, PL_LX = 1280, PL_C = 1536, PL_D = 2048;
constexpr int MIX_A = 0, MIX_B = 256, MIX_C = 512, MIX_D = 768;
constexpr size_t MiB = 1u << 20;
constexpr size_t WS_CTL = 0, WS_MOD = 1 * MiB, WS_WDT = WS_MOD + 256 * 1024, WS_WIN = 1 * MiB + 512 * 1024, WS_WOUT = 7 * MiB, WS_WF1 = 9 * MiB, WS_WF2 = 17 * MiB, WS_XRC = 25 * MiB, WS_DTP = 29 * MiB;
constexpr size_t WS_LWT = WS_CTL + 576 * 1024;
constexpr size_t WS_XN = 30 * MiB;
constexpr size_t WS_B = 64 * MiB;
constexpr size_t WS_PL = WS_B, WS_XBC = 149 * MiB, WS_TAIL = 243 * MiB, WS_END = 256 * MiB;
constexpr size_t WS_XA2 = WS_B;
constexpr size_t WS_H = 98 * MiB;
__host__ __device__ constexpr size_t ws_h(int l) { return l == NL - 1 ? 30 * MiB : WS_H; }
__host__ __device__ constexpr size_t ws_xa2(int l) { return l == NL - 1 ? 200 * MiB : WS_XA2; }
constexpr size_t WS_X1L = 166 * MiB;
constexpr size_t WS_RS1 = WS_CTL + 448 * 1024, WS_BIN = WS_CTL + 768 * 1024;
constexpr size_t WS_RS2 = WS_CTL + 128 * 1024, WS_BF1 = WS_CTL + 256 * 1024;
constexpr int XBP = 512;
constexpr size_t TR_BYTES = (size_t)MT * 256 * 2;
constexpr size_t WS_XT = 166 * MiB, WS_BT = WS_XT + TR_BYTES, WS_ZT = WS_BT + TR_BYTES;
constexpr size_t WS_SST = WS_ZT + TR_BYTES;
constexpr size_t WS_LAB = WS_SST + 2 * TR_BYTES;
constexpr size_t WS_GB = WS_LAB, WS_YG = WS_LAB + TR_BYTES;
constexpr size_t WS_XLC = WS_TAIL;
constexpr size_t WS_SLAB = 234 * MiB;
constexpr size_t WS_SC4 = WS_TAIL + 9 * MiB, WS_DEC = WS_SC4 + (size_t)MT * 64 + 65536;
constexpr size_t WS_LHE = WS_TAIL + 11 * MiB, WS_LCP = WS_LHE + 512 * 1024, WS_LCI = WS_LCP + 512 * 1024;
static_assert((size_t)MT * NPL * 2 <= WS_XBC - WS_PL && (size_t)MT * XBP * 2 <= WS_XT - WS_XBC && (size_t)MT * FF * 2 <= WS_END - WS_H && (size_t)MT * DM * 2 <= WS_B - WS_XN, "ws map");
static_assert(TR_BYTES <= 9 * MiB && WS_LAB + 4 * TR_BYTES <= WS_TAIL && WS_DEC + 65536 <= WS_LHE && (size_t)NB * NCH * 512 * 4 <= 512 * 1024 && WS_LCI + 512 * 1024 <= WS_END, "ws map 3");
static_assert((size_t)NB * CTX * DM * 4 <= WS_DTP - WS_XRC && (size_t)MT * 8 * 4 <= WS_XN - WS_DTP && (size_t)NL * (NB + 1) * NMOD * 4 <= 256 * 1024, "ws map 2");

struct Params {
    const float *x, *c, *ctx, *c_ctx, *w_mod, *b_mod, *g_mix, *w_in, *ssd_conv_w, *ssd_conv_b, *ssd_a_log, *ssd_dt_bias, *ssd_d, *ssd_norm_g, *lru_conv_w, *lru_conv_b, *lru_lambda,
        *lru_w_a, *lru_b_a, *lru_w_i, *lru_b_i, *gqa_q_norm, *gqa_k_norm, *swa_q_norm, *swa_k_norm, *swa_sink, *w_out, *g_ffn, *w_ffn1, *w_ffn2;
    float* out; unsigned char* ws;
};
typedef uint16_t bf16_t;
struct U4 { uint32_t x, y, z, w; };
struct U2 { uint32_t x, y; };

DEV float u2f(uint32_t u) { float f; memcpy(&f, &u, 4); return f; }
DEV uint32_t f2u(float f) { uint32_t u; memcpy(&u, &f, 4); return u; }
DEV float bf2f(bf16_t h) { return u2f((uint32_t)h << 16); }
DEV bf16_t f2bf(float f) { uint32_t u = f2u(f); return (bf16_t)((u + 0x7fffu + ((u >> 16) & 1u)) >> 16); }
DEV float bflo(uint32_t w) { return u2f(w << 16); }
DEV float bfhi(uint32_t w) { return u2f(w & 0xffff0000u); }
DEV float silu_f(float x) { return x / (1.f + expf(-x)); }
DEV float sigmoid_f(float x) { return 1.f / (1.f + expf(-x)); }
DEV float softplus_f(float x) { return fmaxf(x, 0.f) + log1pf(expf(-fabsf(x))); }
DEV float gelu_tanh_f(float x) { return 0.5f * x * (1.f + tanhf(0.7978845608028654f * (x + 0.044715f * x * x * x))); }

DEV float* resid_row(const Params& P, int r) { const int b = r / SB, s = r % SB; return s < CTX ? (float*)(P.ws + WS_XRC) + ((size_t)b * CTX + s) * DM : P.out + ((size_t)b * SEQ + (s - CTX)) * DM; }
DEV const float* xin_row(const Params& P, int l, int r) { const int b = r / SB, s = r % SB; if (l == 0) return s < CTX ? P.ctx + ((size_t)b * CTX + s) * DM : P.x + ((size_t)b * SEQ + (s - CTX)) * DM; return resid_row(P, r); }
DEV const float* mod_row(const Params& P, int l, int r) { const int b = r / SB, s = r % SB; const int bm = s < CTX ? NB : b; return (const float*)(P.ws + WS_MOD) + ((size_t)l * (NB + 1) + bm) * NMOD; }
DEV int chunk_at(int dir, int k) { return dir == 0 ? k : (k < NCC ? NCC - 1 - k : NCH - 1 - (k - NCC)); }
DEV int scan_pos(int dir, int step) { return dir == 0 ? step : (step < CTX ? CTX - 1 - step : SB - 1 - (step - CTX)); }

DEV void st_mod(const Params& P, long it) {
    const int n = (int)(it % NMOD); const int rb = (int)(it / NMOD); const int bm = rb % (NB + 1), l = rb / (NB + 1);
    const float* cv = bm < NB ? P.c + (size_t)bm * DM : P.c_ctx;
    float acc = P.b_mod[(size_t)l * NMOD + n];
    for (int k = 0; k < DM; ++k) acc += silu_f(cv[k]) * P.w_mod[((size_t)l * DM + k) * NMOD + n];
    ((float*)(P.ws + WS_MOD))[it] = acc;
}
constexpr long WC_R0 = (long)NPL * DM, WC_R1 = WC_R0 + 8 * DM, WC_R2 = WC_R1 + (long)DM * DM, WC_R3 = WC_R2 + (long)FF * DM, WC_R4 = WC_R3 + (long)DM * FF;
DEV void st_wconv(const Params& P, long it, int l) {
    if (it < WC_R0) { const int n = (int)(it / DM), k = (int)(it % DM); const int no = n < 1024 ? n : n + 8; ((bf16_t*)(P.ws + WS_WIN))[it] = f2bf(P.w_in[((size_t)l * DM + k) * 2568 + no]); return; }
    if (it < WC_R1) { const long i = it - WC_R0; const int j = (int)(i / DM), k = (int)(i % DM); ((float*)(P.ws + WS_WDT))[i] = P.w_in[((size_t)l * DM + k) * 2568 + 1024 + j]; return; }
    if (it < WC_R2) { const long i = it - WC_R1; const int n = (int)(i / DM), k = (int)(i % DM); ((bf16_t*)(P.ws + WS_WOUT))[i] = f2bf(P.w_out[((size_t)l * DM + k) * DM + n]); return; }
    if (it < WC_R3) { const long i = it - WC_R2; const int n = (int)(i / DM), k = (int)(i % DM); ((bf16_t*)(P.ws + WS_WF1))[i] = f2bf(P.w_ffn1[((size_t)l * DM + k) * FF + n]); return; }
    { const long i = it - WC_R3; const int n = (int)(i / FF), k = (int)(i % FF); ((bf16_t*)(P.ws + WS_WF2))[i] = f2bf(P.w_ffn2[((size_t)l * FF + k) * DM + n]); }
}
DEV void st_norm(const Params& P, long it, int l, int which) {
    const int r = (int)it; const float* xr = which == 0 ? xin_row(P, l, r) : resid_row(P, r); const float* md = mod_row(P, l, r);
    const float* g = (which == 0 ? P.g_mix : P.g_ffn) + (size_t)l * DM; const float* sh = md + (which == 0 ? 0 : 3072); const float* sc = sh + 1024;
    float ss = 0.f; for (int k = 0; k < DM; ++k) ss += xr[k] * xr[k];
    const float rs = 1.0f / sqrtf(ss * (1.0f / DM) + EPS);
    bf16_t* o = (bf16_t*)(P.ws + WS_XN) + (size_t)r * DM; const float* wdt = (const float*)(P.ws + WS_WDT);
    float dt[8]; for (int j = 0; j < 8; ++j) dt[j] = 0.f;
    for (int k = 0; k < DM; ++k) { const float v = (xr[k] * rs * g[k]) * (1.f + sc[k]) + sh[k]; o[k] = f2bf(v);
        if (which == 0) { for (int j = 0; j < 8; ++j) dt[j] += v * wdt[j * DM + k]; } }
    if (which == 0) { float* d = (float*)(P.ws + WS_DTP) + (size_t)r * 8; for (int j = 0; j < 8; ++j) d[j] = dt[j]; }
}
template <class Epi> DEV void st_gemm(long it, const bf16_t* A, int lda, const bf16_t* Bt, int N, int K, const Epi& E) {
    const int ntn = N / 4; const int r0 = (int)(it / ntn) * 8, n0 = (int)(it % ntn) * 4;
    float acc[8][4];
#pragma unroll
    for (int i = 0; i < 8; ++i)
#pragma unroll
        for (int j = 0; j < 4; ++j) acc[i][j] = 0.f;
#pragma unroll 1
    for (int k = 0; k < K; k += 4) {
        U2 a[8], b[4];
#pragma unroll
        for (int i = 0; i < 8; ++i) a[i] = *(const U2*)(A + (size_t)(r0 + i) * lda + k);
#pragma unroll
        for (int j = 0; j < 4; ++j) b[j] = *(const U2*)(Bt + (size_t)(n0 + j) * K + k);
#pragma unroll
        for (int kk = 0; kk < 2; ++kk) {
            float al[8], ah[8], bl[4], bh[4];
#pragma unroll
            for (int i = 0; i < 8; ++i) { const uint32_t wa = kk == 0 ? a[i].x : a[i].y; al[i] = bflo(wa); ah[i] = bfhi(wa); }
#pragma unroll
            for (int j = 0; j < 4; ++j) { const uint32_t wb = kk == 0 ? b[j].x : b[j].y; bl[j] = bflo(wb); bh[j] = bfhi(wb); }
#pragma unroll
            for (int i = 0; i < 8; ++i)
#pragma unroll
                for (int j = 0; j < 4; ++j) acc[i][j] += al[i] * bl[j] + ah[i] * bh[j];
        }
    }
    E(r0, n0, acc);
}
struct EpiPL { const Params& P; DEVM void operator()(int r0, int n0, const float (&acc)[8][4]) const { bf16_t* pl = (bf16_t*)(P.ws + WS_PL);
#pragma unroll
    for (int i = 0; i < 8; ++i)
#pragma unroll
        for (int j = 0; j < 4; ++j) pl[(size_t)(r0 + i) * NPL + n0 + j] = f2bf(acc[i][j]); } };
struct EpiOut { const Params& P; int l; DEVM void operator()(int r0, int n0, const float (&acc)[8][4]) const {
#pragma unroll
    for (int i = 0; i < 8; ++i) { const int r = r0 + i; const float* md = mod_row(P, l, r) + 2048; const float* xi = xin_row(P, l, r); float* xo = resid_row(P, r);
#pragma unroll
        for (int j = 0; j < 4; ++j) xo[n0 + j] = xi[n0 + j] + md[n0 + j] * acc[i][j]; } } };
struct EpiF1 { const Params& P; DEVM void operator()(int r0, int n0, const float (&acc)[8][4]) const { bf16_t* h = (bf16_t*)(P.ws + WS_H);
#pragma unroll
    for (int i = 0; i < 8; ++i)
#pragma unroll
        for (int j = 0; j < 4; ++j) { const float v = fmaxf(acc[i][j], 0.f); h[(size_t)(r0 + i) * FF + n0 + j] = f2bf(v * v); } } };
struct EpiF2 { const Params& P; int l; DEVM void operator()(int r0, int n0, const float (&acc)[8][4]) const {
#pragma unroll
    for (int i = 0; i < 8; ++i) { const int r = r0 + i; const float* md = mod_row(P, l, r) + 5120; float* xo = resid_row(P, r);
#pragma unroll
        for (int j = 0; j < 4; ++j) xo[n0 + j] = xo[n0 + j] + md[n0 + j] * acc[i][j]; } } };

DEV void st_prep(const Params& P, long it, int l) {
    const int r = (int)(it / 1280), c = (int)(it % 1280); const int b = r / SB, s = r % SB; const int lo = s < CTX ? 0 : CTX, hi = s < CTX ? CTX : SB;
    const bf16_t* pl = (const bf16_t*)(P.ws + WS_PL); const size_t tro = ((size_t)(b * NCH + s / CHK) * 256) * CHK + (s % CHK);
    if (c < 768) { float acc = P.ssd_conv_b[l * 768 + c];
        for (int t = 0; t < 4; ++t) { const int ss = s + t - 2; if (ss >= lo && ss < hi) acc += P.ssd_conv_w[(l * 4 + t) * 768 + c] * bf2f(pl[(size_t)(b * SB + ss) * NPL + PL_XBC + c]); }
        const bf16_t v = f2bf(silu_f(acc)); if (c >= 256) ((bf16_t*)(P.ws + WS_XBC))[(size_t)r * XBP + c - 256] = v;
        if (c < 256) ((bf16_t*)(P.ws + WS_XT))[tro + (size_t)c * CHK] = v; else if (c < 512) ((bf16_t*)(P.ws + WS_BT))[tro + (size_t)(c - 256) * CHK] = v; }
    else if (c < 1024) { const int ch = c - 768; float acc = P.lru_conv_b[l * 256 + ch];
        for (int t = 0; t < 4; ++t) { const int ss = s + t - 2; if (ss >= lo && ss < hi) acc += P.lru_conv_w[(l * 4 + t) * 256 + ch] * bf2f(pl[(size_t)(b * SB + ss) * NPL + PL_LX + ch]); }
        ((bf16_t*)(P.ws + WS_XLC))[(size_t)r * 256 + ch] = f2bf(acc); }
    else { const int ch = c - 1024; ((bf16_t*)(P.ws + WS_ZT))[tro + (size_t)ch * CHK] = pl[(size_t)r * NPL + PL_Z + ch]; }
}
DEV void st_qk(const Params& P, long it, int l) {
    const int r = (int)(it / 12), slot = (int)(it % 12); const int t = slot / 6, hs = slot % 6; const int s = r % SB;
    const int col = (t ? PL_D : PL_C) + (hs < 4 ? hs * 64 : 256 + (hs - 4) * 64);
    const float *g0 = P.gqa_q_norm, *g1 = P.swa_q_norm, *g2 = P.gqa_k_norm, *g3 = P.swa_k_norm;
#ifndef CPU_EMU
    asm volatile("" : "+s"(g0), "+s"(g1), "+s"(g2), "+s"(g3));
#endif
    const float* g = (hs < 4 ? (t ? g1 : g0) : (t ? g3 : g2)) + l * 64;
    bf16_t* p = (bf16_t*)(P.ws + WS_PL) + (size_t)r * NPL + col;
    float ss = 0.f;
    for (int d = 0; d < 64; ++d) { const float v = bf2f(p[d]); ss += v * v; }
    const float rs = 1.0f / sqrtf(ss * (1.0f / 64) + EPS); const float qs = hs < 4 ? QSCALE : 1.f;
    const bool lat = s >= CTX; const int pos = s - CTX; const float pr = (float)(pos / GRIDW), pc = (float)(pos % GRIDW);
#pragma unroll 1
    for (int pi = 0; pi < 32; ++pi) { const int a = pi >> 4, i = pi & 15; const int d1 = a * 32 + i, d2 = d1 + 16;
        const float x1 = bf2f(p[d1]) * rs * g[d1], x2 = bf2f(p[d2]) * rs * g[d2]; float cs = 1.f, sn = 0.f;
        if (lat) { const float inv = expf(-(float)i * (9.210340371976184f / 16.f)); const float ang = (a ? pc : pr) * inv; cs = cosf(ang); sn = sinf(ang); }
        p[d1] = f2bf((x1 * cs - x2 * sn) * qs); p[d2] = f2bf((x2 * cs + x1 * sn) * qs); }
}
DEV void st_lru_gate(const Params& P, long it, int l) {
    const int r = (int)(it >> 8), ch = (int)(it & 255); const int k = ch >> 6, j = ch & 63;
    const bf16_t* xr = (const bf16_t*)(P.ws + WS_XLC) + (size_t)r * 256 + k * 64; uint32_t* lab = (uint32_t*)(P.ws + WS_LAB);
    for (int dir = 0; dir < 2; ++dir) {
        const float* wa = P.lru_w_a + ((((size_t)l * 2 + dir) * 4 + k) * 64) * 64 + j; const float* wi = P.lru_w_i + ((((size_t)l * 2 + dir) * 4 + k) * 64) * 64 + j;
        float da = P.lru_b_a[(l * 2 + dir) * 256 + ch], di = P.lru_b_i[(l * 2 + dir) * 256 + ch];
        for (int i = 0; i < 64; ++i) { const float xv = bf2f(xr[i]); da += xv * wa[i * 64]; di += xv * wi[i * 64]; }
        const float sp = softplus_f(-P.lru_lambda[(l * 2 + dir) * 256 + ch]);
        const float la = -8.0f * sigmoid_f(da) * sp; const float bb = sqrtf(-expm1f(2.f * la)) * (sigmoid_f(di) * bf2f(xr[j]));
        lab[((size_t)dir * MT + r) * 256 + ch] = (uint32_t)f2bf(la * LOG2E) | ((uint32_t)f2bf(bb) << 16); }
}
DEV void st_lru_local(const Params& P, long it) {
    const int ch = (int)(it & 255), dir = (int)((it >> 8) & 1); const int bc = (int)(it >> 9); const int c = bc % NCH, b = bc / NCH;
    const uint32_t* lab = (const uint32_t*)(P.ws + WS_LAB) + ((size_t)dir * MT + (size_t)b * SB + c * CHK) * 256 + ch;
    float h = 0.f, cp = 1.f;
#pragma unroll 16
    for (int i = 0; i < CHK; ++i) { const uint32_t w = lab[(size_t)(dir ? CHK - 1 - i : i) * 256]; const float a = exp2f(bflo(w)); h = a * h + bfhi(w); cp *= a; }
    ((float*)(P.ws + WS_LHE))[it] = h; ((float*)(P.ws + WS_LCP))[it] = cp;
}
DEV void st_lru_carry(const Params& P, long it) {
    const int ch = (int)(it & 255), dir = (int)((it >> 8) & 1), b = (int)(it >> 9);
    const float* he = (const float*)(P.ws + WS_LHE); const float* cpv = (const float*)(P.ws + WS_LCP); float* ci = (float*)(P.ws + WS_LCI);
    float hv[NCH], cv[NCH];
#pragma unroll
    for (int k = 0; k < NCH; ++k) { const size_t idx = (((size_t)b * NCH + chunk_at(dir, k)) * 2 + dir) * 256 + ch; hv[k] = he[idx]; cv[k] = cpv[idx]; }
    float carry = 0.f;
#pragma unroll
    for (int k = 0; k < NCH; ++k) { const size_t idx = (((size_t)b * NCH + chunk_at(dir, k)) * 2 + dir) * 256 + ch; ci[idx] = carry; carry = carry * cv[k] + hv[k]; }
}
DEV void st_lru_final(const Params& P, long it, int l, int dir) {
    const int ch = (int)(it & 255); const int bc = (int)(it >> 8); const int c = bc % NCH, b = bc / NCH; const size_t r0 = (size_t)b * SB + c * CHK;
    const uint32_t* lab = (const uint32_t*)(P.ws + WS_LAB) + ((size_t)dir * MT + r0) * 256 + ch;
    bf16_t* mix = (bf16_t*)(P.ws + WS_XN) + r0 * DM + MIX_B + ch; const bf16_t* pl = (const bf16_t*)(P.ws + WS_PL) + r0 * NPL + PL_LG + ch;
    float h = ((const float*)(P.ws + WS_LCI))[(((size_t)b * NCH + c) * 2 + dir) * 256 + ch];
#pragma unroll 8
    for (int i = 0; i < CHK; ++i) { const int ii = dir ? CHK - 1 - i : i; const uint32_t w = lab[(size_t)ii * 256]; h = exp2f(bflo(w)) * h + bfhi(w);
        if (dir == 0) mix[(size_t)ii * DM] = f2bf(h);
        else mix[(size_t)ii * DM] = f2bf((bf2f(mix[(size_t)ii * DM]) + h) * gelu_tanh_f(bf2f(pl[(size_t)ii * NPL]))); }
}
DEV void st_ssd_dt(const Params& P, long it, int l) {
    const int dir = (int)(it & 1), hd = (int)((it >> 1) & 3); const int bc = (int)(it >> 3);
    const float a2 = -expf(P.ssd_a_log[(l * 2 + dir) * 4 + hd]) * LOG2E, dtb = P.ssd_dt_bias[(l * 2 + dir) * 4 + hd];
    const float* dtp = (const float*)(P.ws + WS_DTP); float* sc4 = (float*)(P.ws + WS_SC4);
    float acc = 0.f;
    for (int k = 0; k < CHK; ++k) { const size_t r = (size_t)bc * CHK + (dir ? CHK - 1 - k : k); const float dt = softplus_f(dtp[r * 8 + dir * 4 + hd] + dtb); acc += dt * a2;
        sc4[(r * 4 + hd) * 4 + dir * 2] = acc; sc4[(r * 4 + hd) * 4 + dir * 2 + 1] = dt; }
    ((float*)(P.ws + WS_DEC))[it] = exp2f(acc);
}
DEV void st_ssd_state(const Params& P, long it) {
    const int n = (int)(it & 127), p = (int)((it >> 7) & 63), dir = (int)((it >> 13) & 1), hd = (int)((it >> 14) & 3); const int bc = (int)(it >> 16);
    const float* sc4 = (const float*)(P.ws + WS_SC4); const size_t r0 = (size_t)bc * CHK;
    const bf16_t* xt = (const bf16_t*)(P.ws + WS_XT) + ((size_t)bc * 256 + hd * 64 + p) * CHK; const bf16_t* bt = (const bf16_t*)(P.ws + WS_BT) + ((size_t)bc * 256 + (hd >> 1) * 128 + n) * CHK;
    const float aend = sc4[((r0 + (dir ? 0 : CHK - 1)) * 4 + hd) * 4 + dir * 2];
    float acc = 0.f;
    for (int j = 0; j < CHK; ++j) { const float* sj = sc4 + ((r0 + j) * 4 + hd) * 4 + dir * 2; acc += exp2f(aend - sj[0]) * sj[1] * bf2f(xt[j]) * bf2f(bt[j]); }
    ((bf16_t*)(P.ws + WS_SST))[it] = f2bf(acc);
}
DEV void st_ssd_carry(const Params& P, long it) {
    const int pn = (int)(it & 8191), dir = (int)((it >> 13) & 1), hd = (int)((it >> 14) & 3), b = (int)(it >> 16);
    bf16_t* sst = (bf16_t*)(P.ws + WS_SST); const float* dec = (const float*)(P.ws + WS_DEC);
    bf16_t sv[NCH]; float dv[NCH];
#pragma unroll
    for (int k = 0; k < NCH; ++k) { const size_t cd = (((size_t)b * NCH + chunk_at(dir, k)) * 4 + hd) * 2 + dir; sv[k] = sst[cd * 8192 + pn]; dv[k] = dec[cd]; }
    float run = 0.f;
#pragma unroll
    for (int k = 0; k < NCH; ++k) { const size_t cd = (((size_t)b * NCH + chunk_at(dir, k)) * 4 + hd) * 2 + dir; sst[cd * 8192 + pn] = f2bf(run); run = run * dv[k] + bf2f(sv[k]); }
}
DEV void st_ssd_g(const Params& P, long it) {
    const int j = (int)(it & 127), i = (int)((it >> 7) & 127), g = (int)((it >> 14) & 1); const int bc = (int)(it >> 15);
    const bf16_t* xbc = (const bf16_t*)(P.ws + WS_XBC); const bf16_t* cp = xbc + ((size_t)bc * CHK + i) * XBP + 256 + g * 128; const bf16_t* bp = xbc + ((size_t)bc * CHK + j) * XBP + g * 128;
    float acc = 0.f;
    for (int n8 = 0; n8 < 16; ++n8) { const U4 cw = *(const U4*)(cp + n8 * 8), bw = *(const U4*)(bp + n8 * 8);
        acc += bflo(cw.x) * bflo(bw.x) + bfhi(cw.x) * bfhi(bw.x) + bflo(cw.y) * bflo(bw.y) + bfhi(cw.y) * bfhi(bw.y) + bflo(cw.z) * bflo(bw.z) + bfhi(cw.z) * bfhi(bw.z) + bflo(cw.w) * bflo(bw.w) + bfhi(cw.w) * bfhi(bw.w); }
    ((bf16_t*)(P.ws + WS_GB))[it] = f2bf(acc);
}
DEV void st_ssd_y(const Params& P, long it, int l) {
    const int p = (int)(it & 63), i = (int)((it >> 6) & 127), hd = (int)((it >> 13) & 3); const int bc = (int)(it >> 15); const size_t r0 = (size_t)bc * CHK, r = r0 + i;
    const float* sc4 = (const float*)(P.ws + WS_SC4); const float acf = sc4[(r * 4 + hd) * 4], acb = sc4[(r * 4 + hd) * 4 + 2];
    const bf16_t* gb = (const bf16_t*)(P.ws + WS_GB) + (((size_t)bc * 2 + (hd >> 1)) * 128 + i) * 128; const bf16_t* xt = (const bf16_t*)(P.ws + WS_XT) + ((size_t)bc * 256 + hd * 64 + p) * CHK;
    float y = 0.f;
    for (int j = 0; j < CHK; ++j) { const float* sj = sc4 + ((r0 + j) * 4 + hd) * 4; float w = 0.f;
        if (j <= i) w += exp2f(acf - sj[0]) * sj[1];
        if (j >= i) w += exp2f(acb - sj[2]) * sj[3];
        y += bf2f(gb[j]) * w * bf2f(xt[j]); }
    const bf16_t* cp = (const bf16_t*)(P.ws + WS_XBC) + r * XBP + 256 + (hd >> 1) * 128;
    for (int dir = 0; dir < 2; ++dir) { const bf16_t* hs = (const bf16_t*)(P.ws + WS_SST) + ((((size_t)bc * 4 + hd) * 2 + dir) * 64 + p) * 128; float t = 0.f;
        for (int n = 0; n < 128; ++n) t += bf2f(cp[n]) * bf2f(hs[n]);
        y += exp2f(dir ? acb : acf) * t; }
    const float xv = bf2f(xt[i]), zv = bf2f(((const bf16_t*)(P.ws + WS_ZT))[((size_t)bc * 256 + hd * 64 + p) * CHK + i]);
    ((float*)(P.ws + WS_YG))[r * 256 + hd * 64 + p] = (y + P.ssd_d[l * 4 + hd] * xv) * silu_f(zv);
}
DEV void st_ssd_norm(const Params& P, long it, int l) {
    const int r = (int)it; const float* yg = (const float*)(P.ws + WS_YG) + (size_t)r * 256; bf16_t* mix = (bf16_t*)(P.ws + WS_XN) + (size_t)r * DM + MIX_A;
    float ss = 0.f;
    for (int c = 0; c < 256; ++c) ss += yg[c] * yg[c];
    const float rs = 1.0f / sqrtf(ss * (1.0f / 256) + EPS);
    for (int c = 0; c < 256; ++c) mix[c] = f2bf(yg[c] * rs * P.ssd_norm_g[l * 256 + c]);
}
DEV void st_attn(const Params& P, long it, int l, int type) {
    const int hq = (int)(it / MT), r = (int)(it % MT); const int b = r / SB, s = r % SB; const bool isctx = s < CTX;
    if (isctx && l == NL - 1) return;
    const bf16_t* pl = (const bf16_t*)(P.ws + WS_PL); const int cb = type ? PL_D : PL_C; const int kcol = cb + 256 + (hq >> 1) * 64, vcol = kcol + 128;
    float q[64], o[64];
#pragma unroll
    for (int d = 0; d < 64; ++d) { q[d] = bf2f(pl[(size_t)r * NPL + cb + hq * 64 + d]); o[d] = 0.f; }
    float m = -INFINITY, ls = 0.f;
    for (int seg = 0; seg < 2; ++seg) {
        int lo, hi;
        if (seg == 0) { lo = 0; hi = CTX; }
        else { if (isctx) break; if (type == 0) { lo = CTX; hi = SB; } else { lo = s - 128 < CTX ? CTX : s - 128; hi = s + 129 > SB ? SB : s + 129; } }
        for (int sk = lo; sk < hi; ++sk) { const bf16_t* kp = pl + (size_t)(b * SB + sk) * NPL + kcol; const bf16_t* vp = pl + (size_t)(b * SB + sk) * NPL + vcol;
            float sc = 0.f;
#pragma unroll
            for (int d8 = 0; d8 < 8; ++d8) { const U4 w = *(const U4*)(kp + d8 * 8);
                sc += q[d8 * 8 + 0] * bflo(w.x) + q[d8 * 8 + 1] * bfhi(w.x) + q[d8 * 8 + 2] * bflo(w.y) + q[d8 * 8 + 3] * bfhi(w.y) + q[d8 * 8 + 4] * bflo(w.z) + q[d8 * 8 + 5] * bfhi(w.z) + q[d8 * 8 + 6] * bflo(w.w) + q[d8 * 8 + 7] * bfhi(w.w); }
            const float mn = fmaxf(m, sc); const float al = exp2f(m - mn), pe = exp2f(sc - mn); m = mn; ls = ls * al + pe;
#pragma unroll
            for (int d8 = 0; d8 < 8; ++d8) { const U4 w = *(const U4*)(vp + d8 * 8);
                o[d8 * 8 + 0] = o[d8 * 8 + 0] * al + pe * bflo(w.x); o[d8 * 8 + 1] = o[d8 * 8 + 1] * al + pe * bfhi(w.x); o[d8 * 8 + 2] = o[d8 * 8 + 2] * al + pe * bflo(w.y); o[d8 * 8 + 3] = o[d8 * 8 + 3] * al + pe * bfhi(w.y);
                o[d8 * 8 + 4] = o[d8 * 8 + 4] * al + pe * bflo(w.z); o[d8 * 8 + 5] = o[d8 * 8 + 5] * al + pe * bfhi(w.z); o[d8 * 8 + 6] = o[d8 * 8 + 6] * al + pe * bflo(w.w); o[d8 * 8 + 7] = o[d8 * 8 + 7] * al + pe * bfhi(w.w); } }
    }
    if (type == 1) { const float sk = P.swa_sink[l * 4 + hq] * LOG2E; const float mn = fmaxf(m, sk); const float al = exp2f(m - mn); ls = ls * al + exp2f(sk - mn);
#pragma unroll
        for (int d = 0; d < 64; ++d) o[d] *= al; }
    const float inv = 1.0f / ls; bf16_t* mix = (bf16_t*)(P.ws + WS_XN) + (size_t)r * DM + (type ? MIX_D : MIX_C) + hq * 64;
#pragma unroll
    for (int d = 0; d < 64; ++d) mix[d] = f2bf(o[d] * inv);
}

#ifndef CPU_EMU
__device__ __forceinline__ int tid_from_wave(int wave_s) { int z = 0; asm volatile("" : "+v"(z)); return (wave_s << 6) | (int)__builtin_amdgcn_mbcnt_hi(~0u, __builtin_amdgcn_mbcnt_lo(~0u, (unsigned)z)); }
namespace pg8 {
#define PG8_LAS __attribute__((address_space(3)))
typedef unsigned short bf16_t;
typedef short bf16x8 __attribute__((ext_vector_type(8)));
typedef float f32x4 __attribute__((ext_vector_type(4)));
typedef unsigned u32x4 __attribute__((ext_vector_type(4)));
constexpr int BM = 256, BK = 64, HALF = 128, HTB = HALF * BK * 2  , STAGE_BYTES = 8 * HTB, NXCD = 8, WGM = 4;

__host__ __device__ __forceinline__ int lds_byte(int r, int c) { const int st = (r >> 4) * 2 + (c >> 5), rr = r & 15, cc = c & 31, ob = rr * 64 + cc * 2; return st * 1024 + (ob ^ (((ob >> 9) & 1) << 5)); }
__host__ __device__ __forceinline__ void stage_rc(int b, int& R, int& C) { const int st = b / 1024, sb = b % 1024, swz = sb ^ (((sb >> 9) & 1) << 5); R = (st >> 1) * 16 + swz / 64; C = (st & 1) * 32 + (swz % 64) / 2; }
__host__ __device__ __forceinline__ int perm32(int rho) { const int n = rho >> 4, i = rho & 15; return 8 * (i >> 2) + 4 * n + (i & 3); }

struct Unit { int pm, pn, ko; };
struct Gemm { const bf16_t* A; const bf16_t* Bt; int M, N, K, ldk; };

struct StaticOrder {
    int nM, nN, nwg, G, c;
    __host__ __device__ void init(int M, int N, int G_, int c_) { nM = M / BM; nN = N / BM; nwg = nM * nN; G = G_; c = c_; }
    __host__ __device__ bool next(int i, Unit& u) const {
        const long L = (long)i * G + c; if (L >= nwg) return false;
        int wgid = (int)L; { const int q = nwg / NXCD, r = nwg % NXCD, xcd = wgid % NXCD, off = wgid / NXCD; wgid = (xcd < r ? xcd * (q + 1) : r * (q + 1) + (xcd - r) * q) + off; }
        const int nig = WGM * nN, gid = wgid / nig, fm = gid * WGM, gsz = (nM - fm) < WGM ? (nM - fm) : WGM;
        u.pm = fm + ((wgid % nig) % gsz); u.pn = (wgid % nig) / gsz; u.ko = 0; return true;
    }
    __device__ __forceinline__ void a_ready(const Unit&) const {}
    __device__ __forceinline__ void done(const Unit&) const {}
};

__device__ __forceinline__ unsigned cvt_pk_bf16(float lo, float hi) { unsigned r; asm volatile("v_cvt_pk_bf16_f32 %0, %1, %2" : "=v"(r) : "v"(lo), "v"(hi)); return r; }
typedef float f32x2 __attribute__((ext_vector_type(2)));

typedef unsigned u32x4 __attribute__((ext_vector_type(4)));
template <int ACT> struct EpiBf16A {
    static constexpr bool PERM = true, AFTER_DRAIN = false;
    bf16_t* O; int ldc; const float* rsq; const float* bias; float* dtp; int bpitch;
    __device__ __forceinline__ void operator()(const f32x4 (&acc)[2][2][4][2], const Unit& u, int wr, int wc, int fr_, int fq_) const {
        int fr = fr_, fq = fq_; asm volatile("" : "+v"(fr), "+v"(fq));
        const int row0 = u.pm * BM + wr * 64 + fr; const int col0 = u.pn * BM + wc * 32 + 8 * fq;
        if (dtp && u.pn * BM >= ldc) {
            if (wc == 0 && fq == 0) { f32x4 b0 = {0.f, 0.f, 0.f, 0.f}, b1 = b0;
                if (rsq) { constexpr int PPB = SB / 256; const float* bp_ = bias + (size_t)((u.pm % PPB) == 0 ? NB : u.pm / PPB) * bpitch + col0; b0 = *(const f32x4*)bp_; b1 = *(const f32x4*)(bp_ + 4); }
#pragma unroll
                for (int ai = 0; ai < 2; ++ai)
#pragma unroll
                    for (int m = 0; m < 4; ++m) { float* d = dtp + (size_t)(row0 + ai * HALF + m * 16) * 8; const float rsv = rsq ? __builtin_amdgcn_rsqf(rsq[row0 + ai * HALF + m * 16] * (1.0f / DM) + EPS) : 1.f;
                        *(f32x4*)d = acc[ai][0][m][0] * rsv + b0; *(f32x4*)(d + 4) = acc[ai][0][m][1] * rsv + b1; } }
            return; }
        f32x4 bv[2][2];
        if (rsq) { constexpr int PPB = SB / 256; const float* bp_ = bias + (size_t)((u.pm % PPB) == 0 ? NB : u.pm / PPB) * bpitch + col0;
#pragma unroll
            for (int bj = 0; bj < 2; ++bj) { bv[bj][0] = *(const f32x4*)(bp_ + bj * HALF); bv[bj][1] = *(const f32x4*)(bp_ + bj * HALF + 4); } }
#pragma unroll
        for (int ai = 0; ai < 2; ++ai)
#pragma unroll
            for (int m = 0; m < 4; ++m) { bf16_t* rowp = O + (size_t)(row0 + ai * HALF + m * 16) * ldc + col0;
                float rsv = 1.f; if (rsq) rsv = __builtin_amdgcn_rsqf(rsq[row0 + ai * HALF + m * 16] * (1.0f / DM) + EPS);
#pragma unroll
                for (int bj = 0; bj < 2; ++bj) { f32x4 v0 = acc[ai][bj][m][0], v1 = acc[ai][bj][m][1];
                    if (rsq) { v0 = v0 * rsv + bv[bj][0]; v1 = v1 * rsv + bv[bj][1]; }
                    if (ACT == 2) {
#pragma unroll
                        for (int e = 0; e < 4; ++e) { const float a = fmaxf(v0[e], 0.f), b = fmaxf(v1[e], 0.f); v0[e] = a * a; v1[e] = b * b; } }
                    u32x4 w; w.x = cvt_pk_bf16(v0[0], v0[1]); w.y = cvt_pk_bf16(v0[2], v0[3]); w.z = cvt_pk_bf16(v1[0], v1[1]); w.w = cvt_pk_bf16(v1[2], v1[3]);
                    *(u32x4*)(rowp + bj * HALF) = w; } }
    }
};
struct EpiResid {
    static constexpr bool PERM = true, AFTER_DRAIN = false;
    const void* in_lat; void* out_lat; int in_bf, out_bf; const float* mod; int goff; int kslice; float* slab; bf16_t* xa; const float* gn; const float* modn; int scoff; float* rsq;
    __device__ __forceinline__ void operator()(const f32x4 (&acc)[2][2][4][2], const Unit& u, int wr, int wc, int fr_, int fq_) const {
        int fr = fr_, fq = fq_; asm volatile("" : "+v"(fr), "+v"(fq) :: "memory");
        constexpr int PPB = SB / 256; const int b = u.pm / PPB, j = u.pm % PPB;
        const size_t lrow = ((size_t)b * SEQ + (size_t)(j - 1) * 256) * DM;
        const float* g = mod + (size_t)(j == 0 ? NB : b) * NMOD + goff;
        const int col0 = u.pn * BM + wc * 32 + 8 * fq;
        f32x4 gv[2][2], Gn[2][2];
#pragma unroll
        for (int bj = 0; bj < 2; ++bj)
#pragma unroll
            for (int n = 0; n < 2; ++n) { gv[bj][n] = *(const f32x4*)(g + col0 + bj * HALF + n * 4);
                if (xa) Gn[bj][n] = *(const f32x4*)(gn + col0 + bj * HALF + n * 4) * (1.f + *(const f32x4*)(modn + (size_t)(j == 0 ? NB : b) * NMOD + scoff + col0 + bj * HALF + n * 4)); }
        const int lane_ = fq * 16 + fr;
        u32x4 xr[2][4][2];
#define XR_LOAD(ai_) do { if (!kslice && in_bf) { _Pragma("unroll") for (int m_ = 0; m_ < 4; ++m_) _Pragma("unroll") for (int bj_ = 0; bj_ < 2; ++bj_) \
            xr[ai_][m_][bj_] = *(const u32x4*)((const bf16_t*)in_lat + lrow + (size_t)((ai_) * HALF + wr * 64 + m_ * 16 + fr) * DM + col0 + bj_ * HALF); } } while (0)
        XR_LOAD(0);
#pragma unroll
        for (int ai = 0; ai < 2; ++ai)
#pragma unroll
            for (int m = 0; m < 4; ++m) { const int rl = ai * HALF + wr * 64 + m * 16 + fr; const size_t off = (size_t)rl * DM + col0; float sq = 0.f;
                if (ai == 0 && m == 2) XR_LOAD(1);
#pragma unroll
                for (int bj = 0; bj < 2; ++bj) { const f32x4 t0 = gv[bj][0] * acc[ai][bj][m][0], t1 = gv[bj][1] * acc[ai][bj][m][1];
                    if (kslice) { float* sp = slab + ((size_t)(u.ko / kslice) * NB + b) * CTX * DM + off + bj * HALF; *(f32x4*)sp = t0; *(f32x4*)(sp + 4) = t1; }
                    else { f32x4 x0, x1;
                        if (in_bf) { const u32x4 w = xr[ai][m][bj];
                            x0 = f32x4{__uint_as_float(w.x << 16), __uint_as_float(w.x & 0xffff0000u), __uint_as_float(w.y << 16), __uint_as_float(w.y & 0xffff0000u)}; x1 = f32x4{__uint_as_float(w.z << 16), __uint_as_float(w.z & 0xffff0000u), __uint_as_float(w.w << 16), __uint_as_float(w.w & 0xffff0000u)}; }
                        else { x0 = *(const f32x4*)((const float*)in_lat + lrow + off + bj * HALF); x1 = *(const f32x4*)((const float*)in_lat + lrow + off + bj * HALF + 4); }
                        x0 += t0; x1 += t1;
                        if (out_bf) { u32x4 w; w.x = cvt_pk_bf16(x0[0], x0[1]); w.y = cvt_pk_bf16(x0[2], x0[3]); w.z = cvt_pk_bf16(x1[0], x1[1]); w.w = cvt_pk_bf16(x1[2], x1[3]); *(u32x4*)((bf16_t*)out_lat + lrow + off + bj * HALF) = w; }
                        else { *(f32x4*)((float*)out_lat + lrow + off + bj * HALF) = x0; *(f32x4*)((float*)out_lat + lrow + off + bj * HALF + 4) = x1; }
                        if (xa) { const f32x4 a0 = x0 * Gn[bj][0], a1 = x1 * Gn[bj][1]; u32x4 w; w.x = cvt_pk_bf16(a0[0], a0[1]); w.y = cvt_pk_bf16(a0[2], a0[3]); w.z = cvt_pk_bf16(a1[0], a1[1]); w.w = cvt_pk_bf16(a1[2], a1[3]);
                            *(u32x4*)(xa + ((size_t)u.pm * BM + rl) * DM + col0 + bj * HALF) = w;
                            sq += ((x0[0] * x0[0] + x0[1] * x0[1]) + (x0[2] * x0[2] + x0[3] * x0[3])) + ((x1[0] * x1[0] + x1[1] * x1[1]) + (x1[2] * x1[2] + x1[3] * x1[3])); } } }
                if (xa && !kslice) { sq += __int_as_float(__builtin_amdgcn_ds_bpermute((lane_ ^ 16) << 2, __float_as_int(sq))); sq += __int_as_float(__builtin_amdgcn_ds_bpermute((lane_ ^ 32) << 2, __float_as_int(sq)));
                    if (fq == 0) atomicAdd(rsq + (size_t)u.pm * BM + rl, sq); }
                if (m & 1) asm volatile("" ::: "memory"); }
#undef XR_LOAD
    }
};
struct RowOrder {
    static constexpr int KSPLIT = 4;
    StaticOrder S; int mode, nN, G, c, kslice;
    __device__ void init(int N, int G_, int c_, int mode_, int kslice_ = 0) { mode = mode_; nN = N / BM; G = G_; c = c_; kslice = kslice_; S.init(mode_ == 1 ? NB * SEQ : MT, N, G_, c_); }
    __device__ bool next(int i, Unit& u) const {
        if (mode == 2) { const int Lx = i * G + c; if (Lx >= NB * nN * KSPLIT) return false; const int ks = Lx % KSPLIT, t = Lx / KSPLIT; u.pn = t % nN; u.pm = (t / nN) * (SB / 256); u.ko = ks * kslice; return true; }
        if (!S.next(i, u)) return false; if (mode == 1) u.pm = u.pm + u.pm / (SEQ / 256) + 1; return true; }
    __device__ __forceinline__ void a_ready(const Unit&) const {}
    __device__ __forceinline__ void done(const Unit&) const {}
};
template <class Epi, class Sched, bool ALIGN_EPI = false, bool SP2 = false>
__device__ __forceinline__ void gemm_phase(PG8_LAS unsigned char* lds, const Gemm g, const Sched& S, const Epi& E, int wave_s) {
    const int tid = tid_from_wave(wave_s);
    const int wid = __builtin_amdgcn_readfirstlane(tid >> 6), lane = tid & 63, wr = wid >> 2, wc = wid & 3, fr = lane & 15, fq = lane >> 4;
    const int K = g.ldk, nt = g.K / BK;
    unsigned voffA[2], voffB[2];
#pragma unroll
    for (int i = 0; i < 2; ++i) { int R, C; stage_rc(tid * 16 + i * 8192, R, C); const int Rb = Epi::PERM ? ((R & ~31) + perm32(R & 31)) : R;
        voffA[i] = (unsigned)(R * K + C) * 2u; voffB[i] = (unsigned)(Rb * K + C) * 2u; }
    const size_t kstep = (size_t)(BK * 2);
    const size_t hstep = (size_t)HALF * K * 2;
    const size_t tstep = 2 * hstep;
    const unsigned ldsw = (unsigned)wid * 1024u;
    const int aoff = lds_byte(wr * 64 + fr, fq * 8), boff = lds_byte(wc * 32 + fr, fq * 8);
#define PG8_SA(b, h) (((b) * 2 + (h)) * HTB)
#define PG8_SB(b, h) ((4 + (b) * 2 + (h)) * HTB)
#define PG8_STAGE(bufoff, gbase, voff) do { _Pragma("unroll") for (int _i = 0; _i < 2; ++_i) \
        __builtin_amdgcn_global_load_lds((const unsigned*)((const char*)(gbase) + (voff)[_i]), (PG8_LAS unsigned*)(lds + (bufoff) + ldsw + _i * 8192), 16, 0, 0); } while (0)
#define PG8_LDA(dst, b, h) do { _Pragma("unroll") for (int m = 0; m < 4; ++m) _Pragma("unroll") for (int k = 0; k < 2; ++k) dst[m][k] = *(const PG8_LAS bf16x8*)(lds + PG8_SA(b, h) + aoff + m * 2048 + k * 1024); } while (0)
#define PG8_LDB(dst, b, h) do { _Pragma("unroll") for (int n = 0; n < 2; ++n) _Pragma("unroll") for (int k = 0; k < 2; ++k) dst[n][k] = *(const PG8_LAS bf16x8*)(lds + PG8_SB(b, h) + boff + n * 2048 + k * 1024); } while (0)
#define PG8_MMA(ai, bj, At, Bt) do { __builtin_amdgcn_s_setprio(1); _Pragma("unroll") for (int m = 0; m < 4; ++m) _Pragma("unroll") for (int n = 0; n < 2; ++n) _Pragma("unroll") for (int k = 0; k < 2; ++k) \
        acc[ai][bj][m][n] = __builtin_amdgcn_mfma_f32_16x16x32_bf16(Bt[n][k], At[m][k], acc[ai][bj][m][n], 0, 0, 0); __builtin_amdgcn_s_setprio(0); } while (0)
#define PG8_WAIT_V(n) asm volatile("s_waitcnt vmcnt(" #n ")" ::: "memory")
#define PG8_WAIT_L(n) asm volatile("s_waitcnt lgkmcnt(" #n ")" ::: "memory")
#define PG8_BAR __builtin_amdgcn_s_barrier()
#define PG8_SCHED __builtin_amdgcn_sched_barrier(0)
    Unit cur, nxt; int ui = 0;
    if (!S.next(0, cur)) return;
    f32x4 acc[2][2][4][2];
#pragma unroll
    for (int a = 0; a < 2; ++a)
#pragma unroll
        for (int b = 0; b < 2; ++b)
#pragma unroll
            for (int m = 0; m < 4; ++m)
#pragma unroll
                for (int n = 0; n < 2; ++n) acc[a][b][m][n] = (f32x4){0.f, 0.f, 0.f, 0.f};
    bf16x8 At[4][2], B0[2][2], B1[2][2];
    const char* cA = (const char*)g.A + (size_t)cur.pm * tstep + (size_t)cur.ko * 2; const char* cB = (const char*)g.Bt + (size_t)cur.pn * tstep + (size_t)cur.ko * 2;
    S.a_ready(cur);
    if constexpr (SP2) {
        PG8_STAGE(PG8_SB(0, 0), cB, voffB); PG8_STAGE(PG8_SB(0, 1), cB + hstep, voffB); PG8_STAGE(PG8_SA(0, 0), cA, voffA); PG8_STAGE(PG8_SA(0, 1), cA + hstep, voffA);
        if (wr == 1) PG8_BAR;
        PG8_WAIT_V(2); PG8_BAR;
        PG8_STAGE(PG8_SB(1, 0), cB + kstep, voffB); PG8_STAGE(PG8_SA(1, 0), cA + kstep, voffA); PG8_STAGE(PG8_SB(1, 1), cB + hstep + kstep, voffB);
        PG8_WAIT_V(6); PG8_BAR;
    } else {
        PG8_STAGE(PG8_SB(0, 0), cB, voffB); PG8_STAGE(PG8_SA(0, 0), cA, voffA); PG8_STAGE(PG8_SB(0, 1), cB + hstep, voffB); PG8_STAGE(PG8_SA(0, 1), cA + hstep, voffA);
        if (wr == 1) PG8_BAR;
        PG8_WAIT_V(4); PG8_BAR;
        PG8_STAGE(PG8_SB(1, 0), cB + kstep, voffB); PG8_STAGE(PG8_SA(1, 0), cA + kstep, voffA); PG8_STAGE(PG8_SB(1, 1), cB + hstep + kstep, voffB);
        PG8_WAIT_V(6); PG8_BAR;
    }
    for (;;) {
        const bool has_next = S.next(ui + 1, nxt);
        const char* nA = has_next ? (const char*)g.A + (size_t)nxt.pm * tstep + (size_t)nxt.ko * 2 : cA; const char* nB = has_next ? (const char*)g.Bt + (size_t)nxt.pn * tstep + (size_t)nxt.ko * 2 : cB;
        for (int t = 0; t < nt; t += 2) {
            const bool last = (t == nt - 2);
            const char* a1 = cA + (size_t)(t + 1) * kstep;
            const char* a2 = last ? nA : cA + (size_t)(t + 2) * kstep; const char* b2 = last ? nB : cB + (size_t)(t + 2) * kstep;
            const char* a3 = a2 + kstep; const char* b3 = b2 + kstep;
            if (last && has_next) S.a_ready(nxt);
            if constexpr (SP2) {
            PG8_LDB(B0, 0, 0); PG8_LDB(B1, 0, 1); PG8_SCHED; PG8_LDA(At, 0, 0); PG8_STAGE(PG8_SA(1, 1), a1 + hstep, voffA);
            PG8_WAIT_V(8); PG8_WAIT_L(0); PG8_BAR; PG8_MMA(0, 0, At, B0); PG8_MMA(0, 1, At, B1); PG8_BAR; PG8_SCHED;
            PG8_LDA(At, 0, 1); PG8_STAGE(PG8_SB(0, 0), b2, voffB); PG8_STAGE(PG8_SB(0, 1), b2 + hstep, voffB); PG8_STAGE(PG8_SA(0, 0), a2, voffA);
            PG8_WAIT_V(8); PG8_WAIT_L(0); PG8_BAR; PG8_MMA(1, 0, At, B0); PG8_MMA(1, 1, At, B1); PG8_BAR; PG8_SCHED;
            PG8_LDB(B0, 1, 0); PG8_LDB(B1, 1, 1); PG8_SCHED; PG8_LDA(At, 1, 0); PG8_STAGE(PG8_SA(0, 1), a2 + hstep, voffA);
            PG8_WAIT_V(8); PG8_WAIT_L(0); PG8_BAR; PG8_MMA(0, 0, At, B0); PG8_MMA(0, 1, At, B1); PG8_BAR; PG8_SCHED;
            PG8_LDA(At, 1, 1); PG8_STAGE(PG8_SB(1, 0), b3, voffB); PG8_STAGE(PG8_SB(1, 1), b3 + hstep, voffB); PG8_STAGE(PG8_SA(1, 0), a3, voffA);
            PG8_WAIT_V(8); PG8_WAIT_L(0); PG8_BAR; PG8_MMA(1, 0, At, B0); PG8_MMA(1, 1, At, B1); PG8_BAR; PG8_SCHED;
            } else {
            PG8_LDB(B0, 0, 0); PG8_SCHED; PG8_LDA(At, 0, 0); PG8_STAGE(PG8_SA(1, 1), a1 + hstep, voffA);
            PG8_WAIT_L(8); PG8_BAR; PG8_WAIT_L(0); PG8_MMA(0, 0, At, B0); PG8_BAR; PG8_SCHED;
            PG8_LDB(B1, 0, 1); PG8_STAGE(PG8_SB(0, 0), b2, voffB);
            PG8_BAR; PG8_WAIT_L(0); PG8_MMA(0, 1, At, B1); PG8_BAR;
            PG8_LDA(At, 0, 1); PG8_STAGE(PG8_SA(0, 0), a2, voffA);
            PG8_BAR; PG8_WAIT_L(0); PG8_MMA(1, 0, At, B0); PG8_BAR; PG8_SCHED;
            PG8_STAGE(PG8_SB(0, 1), b2 + hstep, voffB);
            PG8_WAIT_V(6); PG8_BAR; PG8_MMA(1, 1, At, B1); PG8_BAR;
            PG8_LDB(B0, 1, 0); PG8_SCHED; PG8_LDA(At, 1, 0); PG8_STAGE(PG8_SA(0, 1), a2 + hstep, voffA);
            PG8_WAIT_L(8); PG8_BAR; PG8_WAIT_L(0); PG8_MMA(0, 0, At, B0); PG8_BAR; PG8_SCHED;
            PG8_LDB(B1, 1, 1); PG8_STAGE(PG8_SB(1, 0), b3, voffB);
            PG8_BAR; PG8_WAIT_L(0); PG8_MMA(0, 1, At, B1); PG8_BAR;
            PG8_LDA(At, 1, 1); PG8_STAGE(PG8_SA(1, 0), a3, voffA);
            PG8_BAR; PG8_WAIT_L(0); PG8_MMA(1, 0, At, B0); PG8_BAR; PG8_SCHED;
            PG8_STAGE(PG8_SB(1, 1), b3 + hstep, voffB);
            PG8_WAIT_V(6); PG8_BAR; PG8_MMA(1, 1, At, B1); PG8_BAR;
            }
        }
        if constexpr (ALIGN_EPI) { if (wr == 0) PG8_BAR; }
        if constexpr (!Epi::AFTER_DRAIN) { E(acc, cur, wr, wc, fr, fq); S.done(cur); }
        if (!has_next) break;
#pragma unroll
        for (int a = 0; a < 2; ++a)
#pragma unroll
            for (int b = 0; b < 2; ++b)
#pragma unroll
                for (int m = 0; m < 4; ++m)
#pragma unroll
                    for (int n = 0; n < 2; ++n) acc[a][b][m][n] = (f32x4){0.f, 0.f, 0.f, 0.f};
        cur = nxt; cA = nA; cB = nB; ++ui;
        if constexpr (ALIGN_EPI) { if (wr == 1) PG8_BAR; }
    }
    PG8_WAIT_V(0);
    if constexpr (!ALIGN_EPI) { if (wr == 0) PG8_BAR; }
    PG8_BAR;
    if constexpr (Epi::AFTER_DRAIN) { E.fused(acc, cur, wr, wc, fr, fq, lds, wid, lane); S.done(cur); }
#undef PG8_SA
#undef PG8_SB
#undef PG8_STAGE
#undef PG8_LDA
#undef PG8_LDB
#undef PG8_MMA
#undef PG8_WAIT_V
#undef PG8_WAIT_L
#undef PG8_BAR
#undef PG8_SCHED
}
}

#include <hip/hip_bf16.h>
#include <cmath>
namespace attn_body {
using bf16=__hip_bfloat16;
using bf16x8=__attribute__((ext_vector_type(8)))short;
using s16x4=__attribute__((ext_vector_type(4)))short;
using f32x16=__attribute__((ext_vector_type(16)))float;
using u32x4=__attribute__((ext_vector_type(4)))unsigned;
constexpr int D=64,PP=NPL,OP=::DM;
constexpr int NW=8,QBLK=32,QB=QBLK*NW,KVBLK=64;
__device__ __forceinline__ int crow(int r,int hi){return (r&3)+8*(r>>2)+4*hi;}
#define SBAR() __builtin_amdgcn_sched_barrier(0)
__device__ __forceinline__ void wmask(f32x16&p0,f32x16&p1,int dk,int hi){
  const float NEG=-INFINITY; const int kb=dk+4*hi;
  #pragma unroll
  for(int r=0;r<16;++r){const int d=kb+(r&3)+8*(r>>2); if(d>128||d<-128)p0[r]=NEG; if(d+32>128||d+32<-128)p1[r]=NEG;}
}
struct AttnDesc { int qrow,qcol,kcol,vcol,ocol,rowA,rowB,NT,masked,qpos0,kpos4,has_sink; float sinkl2; };

constexpr int NSLOT=3, SLOTB=8192;
constexpr int LDS_K=0, LDS_V=NSLOT*SLOTB, LDS_WS=2*NSLOT*SLOTB, LDS_OST=LDS_WS+NW*64*4, LDS_BYTES=LDS_OST+NW*4096;
constexpr float C2=0.125f*1.4426950408889634f;
__device__ __forceinline__ void glds16(const void*gsrc,unsigned lds_dst){unsigned keep;
  asm volatile("s_mov_b32 %0, m0\n\ts_mov_b32 m0, %2\n\ts_nop 0\n\tglobal_load_lds_dwordx4 %1, off\n\ts_mov_b32 m0, %0":"=&s"(keep):"v"(gsrc),"s"(lds_dst):"memory");}
__device__ __forceinline__ float max3f(float a,float b,float c){float r;asm("v_max3_f32 %0, %1, %2, %3":"=v"(r):"v"(a),"v"(b),"v"(c));return r;}
__device__ __forceinline__ float max2f(float a,float b){float r;asm("v_max_f32_e32 %0, %1, %2":"=v"(r):"v"(a),"v"(b));return r;}
__device__ __forceinline__ float fadd_s(float a,float b){float r;asm("v_add_f32_e32 %0, %1, %2":"=v"(r):"v"(a),"v"(b));return r;}
__device__ __forceinline__ float fsub_s(float a,float b){float r;asm("v_sub_f32_e32 %0, %1, %2":"=v"(r):"v"(a),"v"(b));return r;}
typedef float f32x2_t __attribute__((ext_vector_type(2))); typedef __bf16 bf16x2_t __attribute__((ext_vector_type(2)));
__device__ __forceinline__ unsigned cvtpk_s(float lo,float hi){f32x2_t v={lo,hi};bf16x2_t b=__builtin_convertvector(v,bf16x2_t);return __builtin_bit_cast(unsigned,b);}
#define WAIT_BAR(N) asm volatile("s_waitcnt vmcnt(" #N ") lgkmcnt(0)\n\ts_barrier":::"memory")

__device__ __forceinline__ void qkt(f32x16&p0,f32x16&p1,const char*Kslot,const bf16x8*qr,const f32x16&negm,int r32,int hi){
  const char*kb=Kslot+hi*1024+r32*16;
  #pragma unroll
  for(int d0=0;d0<4;++d0){
    const bf16x8 b0=*reinterpret_cast<const bf16x8*>(kb+d0*2048);
    const bf16x8 b1=*reinterpret_cast<const bf16x8*>(kb+d0*2048+512);
    if(d0==0){p0=__builtin_amdgcn_mfma_f32_32x32x16_bf16(b0,qr[0],negm,0,0,0);p1=__builtin_amdgcn_mfma_f32_32x32x16_bf16(b1,qr[0],negm,0,0,0);}
    else{p0=__builtin_amdgcn_mfma_f32_32x32x16_bf16(b0,qr[d0],p0,0,0,0);p1=__builtin_amdgcn_mfma_f32_32x32x16_bf16(b1,qr[d0],p1,0,0,0);}}
}
typedef __attribute__((address_space(3))) const char* lds_cptr;
typedef short v4i16_t __attribute__((ext_vector_type(4)));
__device__ __forceinline__ void kload8(bf16x8*kf,lds_cptr kp){
  kf[0]=*(const __attribute__((address_space(3))) bf16x8*)(kp);      kf[1]=*(const __attribute__((address_space(3))) bf16x8*)(kp+512);
  kf[2]=*(const __attribute__((address_space(3))) bf16x8*)(kp+2048); kf[3]=*(const __attribute__((address_space(3))) bf16x8*)(kp+2560);
  kf[4]=*(const __attribute__((address_space(3))) bf16x8*)(kp+4096); kf[5]=*(const __attribute__((address_space(3))) bf16x8*)(kp+4608);
  kf[6]=*(const __attribute__((address_space(3))) bf16x8*)(kp+6144); kf[7]=*(const __attribute__((address_space(3))) bf16x8*)(kp+6656);
}
__device__ __forceinline__ void kload2(bf16x8*kf,lds_cptr kp,int j){ kf[2*j]=*(const __attribute__((address_space(3))) bf16x8*)(kp+j*2048); kf[2*j+1]=*(const __attribute__((address_space(3))) bf16x8*)(kp+j*2048+512); }
__device__ __forceinline__ s16x4 vtr(lds_cptr p){ return __builtin_bit_cast(s16x4,__builtin_amdgcn_ds_read_tr16_b64_v4i16((__attribute__((address_space(3))) v4i16_t*)p)); }
__device__ __forceinline__ float rowmax(const f32x16&p0,const f32x16&p1){
  float a=max3f(p0[0],p0[1],p1[0]),b=max3f(p0[2],p0[3],p1[1]);a=max3f(a,p1[2],p1[3]);
  #pragma unroll
  for(int r=4;r<16;r+=4){a=max3f(a,p0[r],p0[r+1]);b=max3f(b,p0[r+2],p0[r+3]);a=max3f(a,p1[r],p1[r+1]);b=max3f(b,p1[r+2],p1[r+3]);}
  const float m=max2f(a,b);
  auto rr=__builtin_amdgcn_permlane32_swap(__float_as_uint(m),__float_as_uint(m),false,false);
  return max2f(__uint_as_float(rr[0]),__uint_as_float(rr[1]));
}
__device__ __forceinline__ void pv(f32x16*o,int vb,bf16x8 pa0,bf16x8 pa1,bf16x8 pa2,bf16x8 pa3){
  #pragma unroll
  for(int d0=0;d0<2;++d0){s16x4 lo[4],hi[4];
    #pragma unroll
    for(int ks=0;ks<4;++ks){
      asm volatile("ds_read_b64_tr_b16 %0,%1 offset:%c2":"=&v"(lo[ks]):"v"(vb),"i"(d0*4096+ks*1024):"memory");
      asm volatile("ds_read_b64_tr_b16 %0,%1 offset:%c2":"=&v"(hi[ks]):"v"(vb),"i"(d0*4096+ks*1024+512):"memory");}
    asm volatile("s_waitcnt lgkmcnt(0)":::"memory");SBAR();
    #define PK(k) (bf16x8){lo[k][0],lo[k][1],lo[k][2],lo[k][3],hi[k][0],hi[k][1],hi[k][2],hi[k][3]}
    o[d0]=__builtin_amdgcn_mfma_f32_32x32x16_bf16(pa0,PK(0),o[d0],0,0,0);
    o[d0]=__builtin_amdgcn_mfma_f32_32x32x16_bf16(pa1,PK(1),o[d0],0,0,0);
    o[d0]=__builtin_amdgcn_mfma_f32_32x32x16_bf16(pa2,PK(2),o[d0],0,0,0);
    o[d0]=__builtin_amdgcn_mfma_f32_32x32x16_bf16(pa3,PK(3),o[d0],0,0,0);
    #undef PK
  }
}

#ifndef ATTN_STORE16
#define ATTN_STORE16(p,v) (*(u32x4*)(p)=(v))
#endif
template<int THRL> __device__ __forceinline__ void attn_unit(const AttnDesc u,const bf16*__restrict__ PLb,bf16*__restrict__ MIXb,char*shm,int wave_s){
  const int tid=tid_from_wave(wave_s);
  const int lane=tid&63,r32=lane&31,hi=lane>>5; const int wid=__builtin_amdgcn_readfirstlane(tid>>6);
  const bf16*Qw=PLb+(long)(u.qrow+wid*QBLK)*PP+u.qcol;
  const bf16*Kh=PLb+u.kcol,*Vh=PLb+u.vcol;
  const unsigned lds0=(unsigned)(uintptr_t)shm;
  float*wsf=(float*)(shm+LDS_WS)+wid*64;
  const bf16*ksrc=Kh+(long)lane*PP+wid*8;
  const bf16*vsrc=Vh+(long)(16*(wid&3)+(lane>>2))*PP+(wid>>2)*32+(lane&3)*8;
  #define TROW(t) ((t)<4 ? u.rowA+64*(t) : u.rowB+64*((t)-4))
  const unsigned kdst=lds0+LDS_K+wid*1024, vdst=lds0+LDS_V+wid*1024;
  #define DMA_K(t,slot) glds16(ksrc+(long)TROW(t)*PP,(unsigned)__builtin_amdgcn_readfirstlane(kdst+(slot)))
  #define DMA_V(t,slot) glds16(vsrc+(long)TROW(t)*PP,(unsigned)__builtin_amdgcn_readfirstlane(vdst+(slot)))
  const int vb0=(int)(lds0+LDS_V)+((lane>>4)&1)*32+(lane&3)*8+(4*hi+((lane&15)>>2))*64;
  const char*Kbase=shm+LDS_K; bf16x8 kf[8];
  const lds_cptr shm3=(lds_cptr)shm; const lds_cptr kp0=shm3+LDS_K+hi*1024+r32*16; const lds_cptr vp0=shm3+LDS_V+((lane>>4)&1)*32+(lane&3)*8+(4*hi+((lane&15)>>2))*64;
  const int NT=u.NT;
  DMA_K(0,0);DMA_V(0,0);DMA_K(1,SLOTB);
  bf16x8 qr[4];
  #pragma unroll
  for(int d0=0;d0<4;++d0)qr[d0]=*reinterpret_cast<const bf16x8*>(&Qw[(long)r32*PP+d0*16+hi*8]);
  float mhat=0.f,l_reg=0.f;f32x16 o[2];o[0]=f32x16{};o[1]=f32x16{};f32x16 negm=f32x16{};asm volatile("":"+v"(negm));
  const int qpos=u.qpos0+wid*QBLK+r32;
  #define CMASK(P0,P1,t) do{ if(u.masked && (t)>=4) wmask(P0,P1,u.kpos4+64*((t)-4)-qpos,hi); }while(0)
  bool resc=false;
  #define START(P0,P1) do{ const float rm=rowmax(P0,P1); resc=false; \
    { const float dl=rm; mhat=fadd_s(mhat,dl); \
      _Pragma("unroll") for(int r=0;r<16;++r){P0[r]=fsub_s(P0[r],dl);P1[r]=fsub_s(P1[r],dl);} \
      _Pragma("unroll") for(int r=0;r<16;++r)negm[r]=-mhat; asm volatile("":"+v"(negm)); } \
    _Pragma("unroll") for(int r=0;r<16;++r)P0[r]=__builtin_amdgcn_exp2f(P0[r]); }while(0)
  #define RESC() do{ if(resc){ asm volatile("s_waitcnt lgkmcnt(0)":::"memory"); \
      _Pragma("unroll") for(int d_=0;d_<2;++d_) _Pragma("unroll") for(int r=0;r<16;++r)o[d_][r]*=wsf[crow(r,hi)]; } }while(0)
  f32x16 pA0,pA1,pB0,pB1;
  int sl_prev=0,sl_cur=0,sl_next=SLOTB;
  #define ROT() do{sl_prev=sl_cur;sl_cur=sl_next;sl_next=(sl_next==(NSLOT-1)*SLOTB)?0:sl_next+SLOTB;}while(0)
  DMA_K(2,2*SLOTB);
  WAIT_BAR(3);
  qkt(pA0,pA1,Kbase,qr,negm,r32,hi);asm volatile("s_nop 15\n\ts_nop 7":"+v"(pA0),"+v"(pA1));CMASK(pA0,pA1,0);
  START(pA0,pA1);
  _Pragma("unroll") for(int r=0;r<16;++r)pA1[r]=__builtin_amdgcn_exp2f(pA1[r]);
  WAIT_BAR(0);
  DMA_K(3,0);DMA_V(1,SLOTB);
  ROT();
  kload8(kf,kp0+sl_cur);
  WAIT_BAR(2);
  s16x4 vlo[8],vhi[8]; u32x4 pw0,pw1,pw2,pw3;
  #define PKW(P,B) cvtpk_s(P[B],P[B+1])
  #define PAF(k) __builtin_bit_cast(bf16x8,pw##k)
  #define VFR(i) (bf16x8){vlo[i][0],vlo[i][1],vlo[i][2],vlo[i][3],vhi[i][0],vhi[i][1],vhi[i][2],vhi[i][3]}
  #define PIN(x) asm volatile("":"+v"(x))
  #define MX3(a,b,c) __builtin_fmaxf(__builtin_fmaxf((a),(b)),(c))
  #define GAPA(MF,A0,A1,A2,A3,W0,W1,PW) do{ MF; sacc+=A0; sacc+=A1; sacc+=A2; sacc+=A3; PIN(sacc); W0; W1; PIN(PW); SBAR(); }while(0)
  #define EX(v) __builtin_amdgcn_exp2f(v)
  #define GAPB(MF,X,B) do{ MF; X[B]=EX(X[B]); X[B+1]=EX(X[B+1]); X[B+2]=EX(X[B+2]); X[B+3]=EX(X[B+3]); PIN(X); SBAR(); }while(0)
  #define VRD(i) do{ vlo[i]=vtr(vp_+(((i)>>2)*4096+((i)&3)*1024)); vhi[i]=vtr(vp_+(((i)>>2)*4096+((i)&3)*1024+512)); }while(0)
  #define KRD(G,j) do{ if(G){ kload2(kf,kp0+sl_next,j); SBAR(); } }while(0)
  #define STEP(C0,C1,P0,P1,t,GK,GV,GL) do{ SBAR(); \
    const lds_cptr vp_=vp0+sl_prev; \
    VRD(0); SBAR(); float sacc=(P0[0]+P0[1]); \
    GAPA(C0=__builtin_amdgcn_mfma_f32_32x32x16_bf16(kf[0],qr[0],negm,0,0,0), P0[2],P0[3],P0[4],P0[5],     pw0[0]=PKW(P0,0), pw0[1]=PKW(P0,2), pw0); \
    VRD(4); SBAR(); GAPA(C1=__builtin_amdgcn_mfma_f32_32x32x16_bf16(kf[1],qr[0],negm,0,0,0), P0[6],P0[7],P0[8],P0[9],     pw0[2]=PKW(P0,4), pw0[3]=PKW(P0,6), pw0); \
    VRD(1); SBAR(); GAPA(C0=__builtin_amdgcn_mfma_f32_32x32x16_bf16(kf[2],qr[1],C0,0,0,0),   P0[10],P0[11],P0[12],P0[13], pw1[0]=PKW(P0,8), pw1[1]=PKW(P0,10), pw1); \
    VRD(5); SBAR(); GAPA(C1=__builtin_amdgcn_mfma_f32_32x32x16_bf16(kf[3],qr[1],C1,0,0,0),   P0[14],P0[15],P1[0],P1[1],   pw1[2]=PKW(P0,12),pw1[3]=PKW(P0,14), pw1); \
    VRD(2); SBAR(); GAPA(C0=__builtin_amdgcn_mfma_f32_32x32x16_bf16(kf[4],qr[2],C0,0,0,0),   P1[2],P1[3],P1[4],P1[5],     pw2[0]=PKW(P1,0), pw2[1]=PKW(P1,2), pw2); \
    VRD(6); SBAR(); GAPA(C1=__builtin_amdgcn_mfma_f32_32x32x16_bf16(kf[5],qr[2],C1,0,0,0),   P1[6],P1[7],P1[8],P1[9],     pw2[2]=PKW(P1,4), pw2[3]=PKW(P1,6), pw2); \
    VRD(3); SBAR(); GAPA(C0=__builtin_amdgcn_mfma_f32_32x32x16_bf16(kf[6],qr[3],C0,0,0,0),   P1[10],P1[11],P1[12],P1[13], pw3[0]=PKW(P1,8), pw3[1]=PKW(P1,10), pw3); \
    VRD(7); SBAR(); GAPA(C1=__builtin_amdgcn_mfma_f32_32x32x16_bf16(kf[7],qr[3],C1,0,0,0),   P1[14],P1[15],0.f,0.f,       pw3[2]=PKW(P1,12),pw3[3]=PKW(P1,14), pw3); \
    l_reg+=sacc; \
    if(GK){DMA_K((t)+3,sl_cur);} if(GV){DMA_V((t)+1,sl_next);} \
    CMASK(C0,C1,t); \
    { float a=MX3(C0[0],C0[1],C1[0]),b=MX3(C0[2],C0[3],C1[1]); a=MX3(a,C1[2],C1[3]); \
      _Pragma("unroll") for(int r=4;r<16;r+=4){a=MX3(a,C0[r],C0[r+1]);b=MX3(b,C0[r+2],C0[r+3]);a=MX3(a,C1[r],C1[r+1]);b=MX3(b,C1[r+2],C1[r+3]);} \
      float rm=__builtin_fmaxf(a,b); { auto rr=__builtin_amdgcn_permlane32_swap(__float_as_uint(rm),__float_as_uint(rm),false,false); rm=__builtin_fmaxf(__uint_as_float(rr[0]),__uint_as_float(rr[1])); } \
      resc=false; \
      if(__builtin_expect(__any(rm>(float)THRL),0)){ const float dl=__builtin_fmaxf(rm,0.f); mhat+=dl; \
        _Pragma("unroll") for(int r=0;r<16;++r){C0[r]-=dl;C1[r]-=dl;} \
        _Pragma("unroll") for(int r=0;r<16;++r)negm[r]=-mhat; asm volatile("":"+v"(negm)); \
        const float f=__builtin_amdgcn_exp2f(-dl); l_reg*=f; if(hi==0)wsf[r32]=f; resc=true; } } \
    SBAR(); \
    GAPB(o[0]=__builtin_amdgcn_mfma_f32_32x32x16_bf16(PAF(0),VFR(0),o[0],0,0,0), C0,0); \
    GAPB(o[1]=__builtin_amdgcn_mfma_f32_32x32x16_bf16(PAF(0),VFR(4),o[1],0,0,0), C0,4); \
    KRD(GL,0); GAPB(o[0]=__builtin_amdgcn_mfma_f32_32x32x16_bf16(PAF(1),VFR(1),o[0],0,0,0), C0,8); \
    KRD(GL,1); GAPB(o[1]=__builtin_amdgcn_mfma_f32_32x32x16_bf16(PAF(1),VFR(5),o[1],0,0,0), C0,12); \
    KRD(GL,2); GAPB(o[0]=__builtin_amdgcn_mfma_f32_32x32x16_bf16(PAF(2),VFR(2),o[0],0,0,0), C1,0); \
    KRD(GL,3); GAPB(o[1]=__builtin_amdgcn_mfma_f32_32x32x16_bf16(PAF(2),VFR(6),o[1],0,0,0), C1,4); \
    GAPB(o[0]=__builtin_amdgcn_mfma_f32_32x32x16_bf16(PAF(3),VFR(3),o[0],0,0,0), C1,8); \
    GAPB(o[1]=__builtin_amdgcn_mfma_f32_32x32x16_bf16(PAF(3),VFR(7),o[1],0,0,0), C1,12); \
    }while(0)
  int t=1;
  for(;t+5<NT;t+=2){
    STEP(pB0,pB1,pA0,pA1,t,true,true,true);     WAIT_BAR(2); RESC(); ROT();
    STEP(pA0,pA1,pB0,pB1,t+1,true,true,true);   WAIT_BAR(2); RESC(); ROT();
  }
  #define ENDW(tt) do{ if((tt)+3<NT){WAIT_BAR(2);} else if((tt)+2<NT){WAIT_BAR(1);} else {WAIT_BAR(0);} }while(0)
  for(;t+1<NT;t+=2){
    STEP(pB0,pB1,pA0,pA1,t,(t+3<NT),(t+1<NT),(t+1<NT));       ENDW(t);   RESC(); ROT();
    STEP(pA0,pA1,pB0,pB1,t+1,(t+4<NT),(t+2<NT),(t+2<NT));     ENDW(t+1); RESC(); ROT();
  }
  STEP(pB0,pB1,pA0,pA1,NT-1,false,false,false); RESC();
  { float sacc=pB0[0]+pB0[1]; _Pragma("unroll") for(int r=2;r<16;++r)sacc+=pB0[r]; _Pragma("unroll") for(int r=0;r<16;++r)sacc+=pB1[r]; l_reg+=sacc;
    pw0=(u32x4){PKW(pB0,0),PKW(pB0,2),PKW(pB0,4),PKW(pB0,6)};pw1=(u32x4){PKW(pB0,8),PKW(pB0,10),PKW(pB0,12),PKW(pB0,14)};pw2=(u32x4){PKW(pB1,0),PKW(pB1,2),PKW(pB1,4),PKW(pB1,6)};pw3=(u32x4){PKW(pB1,8),PKW(pB1,10),PKW(pB1,12),PKW(pB1,14)};
    SBAR(); pv(o,vb0+sl_cur,PAF(0),PAF(1),PAF(2),PAF(3)); }
  #undef PKW
  #undef PAF
  #undef VFR
  #undef PIN
  #undef MX3
  #undef GAPA
  #undef GAPB
  #undef EX
  #undef VRD
  #undef KRD
  #undef STEP
  #undef ENDW
  {auto rr=__builtin_amdgcn_permlane32_swap(__float_as_uint(l_reg),__float_as_uint(l_reg),false,false);l_reg=__uint_as_float(rr[0])+__uint_as_float(rr[1]);}
  if(u.has_sink)l_reg+=__builtin_amdgcn_exp2f(u.sinkl2-mhat);
  if(hi==0)wsf[32+r32]=l_reg;asm volatile("s_waitcnt lgkmcnt(0)":::"memory");
  float rli[16];
  #pragma unroll
  for(int r=0;r<16;++r)rli[r]=__builtin_amdgcn_rcpf(wsf[32+crow(r,hi)]);
  bf16*Ow=MIXb+(long)(u.qrow+wid*QBLK)*OP+u.ocol;
  { bf16*stg=(bf16*)(shm+LDS_OST)+wid*2048;
    #pragma unroll
    for(int r=0;r<16;++r){const int orow=crow(r,hi);
      #pragma unroll
      for(int d0=0;d0<2;++d0)stg[orow*64+d0*32+r32]=__float2bfloat16(o[d0][r]*rli[r]);}
    asm volatile("s_waitcnt lgkmcnt(0)":::"memory");
    #pragma unroll
    for(int i=0;i<4;++i){const int row=i*8+(lane>>3),ch=lane&7; const u32x4 v=*(const u32x4*)(stg+row*64+ch*8); ATTN_STORE16(Ow+(long)row*OP+ch*8,v);} }
  asm volatile("s_waitcnt lgkmcnt(0)\n\ts_barrier":::"memory");
  #undef TROW
  #undef DMA_K
  #undef DMA_V
  #undef CMASK
  #undef START
  #undef RESC
  #undef ROT
}
constexpr int ATTN_LDS_BYTES=LDS_BYTES;
#undef SBAR
#undef WAIT_BAR
}

__device__ __forceinline__ void attention_phase(const Params& P, int l, char* lds, int G, int bx, int wave_s) {
    using namespace attn_body;
    const int vcu = (G % 8 == 0) ? (bx % 8) * (G / 8) + bx / 8 : bx;
    const bf16* PLb = (const bf16*)(P.ws + WS_PL); bf16* MIXb = (bf16*)(P.ws + WS_XN);
    constexpr int NQB = SEQ / 256, NU = NB * 4 * NQB; const int ntot = 2 * NU + (l < NL - 1 ? NB * 8 : 0);
    for (int idx = vcu; idx < ntot; idx += G) {
        AttnDesc d; int type, b, hq, kvh;
        if (idx < 2 * NU) { type = idx >= NU ? 1 : 0; const int u = idx - type * NU; const int bk = u / (2 * NQB), g = (u / NQB) & 1, qb = u % NQB; b = bk >> 1; kvh = bk & 1; hq = kvh * 2 + g;
            d.qrow = b * SB + CTX + qb * 256; d.qpos0 = qb * 256; d.rowA = b * SB;
            if (type == 0) { d.rowB = b * SB + CTX; d.NT = SB / 64; d.masked = 0; d.kpos4 = 0; }
            else { const int lat0 = qb * 256 - 128 < 0 ? 0 : qb * 256 - 128, lat1 = qb * 256 + 384 > SEQ ? SEQ : qb * 256 + 384; d.rowB = b * SB + CTX + lat0; d.NT = 4 + (lat1 - lat0) / 64; d.masked = 1; d.kpos4 = lat0; } }
        else { const int u = idx - 2 * NU; type = u & 1; hq = (u >> 1) & 3; kvh = hq >> 1; b = u >> 3; d.qrow = b * SB; d.qpos0 = 0; d.rowA = b * SB; d.rowB = b * SB; d.NT = 4; d.masked = 0; d.kpos4 = 0; }
        const int cb = type ? PL_D : PL_C;
        d.qcol = cb + hq * 64; d.kcol = cb + 256 + kvh * 64; d.vcol = cb + 384 + kvh * 64; d.ocol = (type ? MIX_D : MIX_C) + hq * 64;
        d.has_sink = type; d.sinkl2 = type ? P.swa_sink[l * 4 + hq] * LOG2E : 0.f;
        attn_unit<8>(d, PLb, MIXb, lds, wave_s);
    }
}

#define GAS __attribute__((address_space(1)))
#define LAS __attribute__((address_space(3)))
typedef unsigned short bf16;
typedef unsigned v4u __attribute__((ext_vector_type(4)));
typedef float f32x4 __attribute__((ext_vector_type(4)));
typedef short bf16x8 __attribute__((ext_vector_type(8)));
typedef GAS unsigned gu32;
typedef GAS unsigned long long gu64;
#define RLX_AGENT __ATOMIC_RELAXED, __HIP_MEMORY_SCOPE_AGENT
#define LDS_WAIT() asm volatile("s_waitcnt lgkmcnt(0)" ::: "memory")
#define VM_WAIT() asm volatile("s_waitcnt vmcnt(0)" ::: "memory")
__device__ __forceinline__ unsigned long long rt() { return __builtin_amdgcn_s_memrealtime(); }
__device__ __forceinline__ unsigned pk2(float lo, float hi) { return (unsigned)f2bf(lo) | ((unsigned)f2bf(hi) << 16); }

#define XB_TMO      128
#define XB_XCNT(j)  (256  + 64 * (j))
#define XB_XSUB(j)  (1280 + 64 * (j))
#define XB_XGEN(j)  (2304 + 64 * (j))
#define XB_TOP      3328
#define XB_TOPGEN   3392
#define XCD_BAR_WORDS 3456
#define XB_SPIN_CAP (1u << 27)

__device__ __forceinline__ unsigned xb_ld(unsigned* p)              { return __hip_atomic_load(p, __ATOMIC_RELAXED, __HIP_MEMORY_SCOPE_AGENT); }
__device__ __forceinline__ unsigned xb_add(unsigned* p, unsigned v) { return __hip_atomic_fetch_add(p, v, __ATOMIC_RELAXED, __HIP_MEMORY_SCOPE_AGENT); }
__device__ __forceinline__ unsigned xb_xcc_id() { return (unsigned)__builtin_amdgcn_s_getreg((3 << 11) | 20) & 0xFu; }
#define XB_SPIN(cond, bar) do { unsigned _sp = 0; while (cond) { __builtin_amdgcn_s_sleep(1); \
    if ((++_sp & 255u) == 0u) { if (xb_ld(&(bar)[XB_TMO])) break; if (_sp > XB_SPIN_CAP) { atomicAdd(&(bar)[XB_TMO], 1u); break; } } } } while (0)

struct XcdBarrier {
    unsigned* bar; unsigned x;
    volatile LAS unsigned* st;
};

__device__ __forceinline__ XcdBarrier xcd_barrier_post(unsigned* bar, volatile LAS unsigned* st) {
    XcdBarrier b; b.bar = bar; b.x = xb_xcc_id(); b.st = st;
    if (threadIdx.x == 0) (void)xb_add(&bar[XB_XCNT(b.x)], 1u);
    return b;
}
__device__ __forceinline__ void xcd_barrier_complete(unsigned* bar, unsigned x, unsigned& nloc, unsigned& nx) {
    const unsigned G = gridDim.x * gridDim.y * gridDim.z;
    unsigned sum, cnt, mine, sp = 0u;
    for (;;) {
        sum = 0u; cnt = 0u; mine = 0u;
#pragma unroll
        for (unsigned j = 0; j < 16; ++j) { const unsigned c = xb_ld(&bar[XB_XCNT(j)]); sum += c; cnt += (c > 0u) ? 1u : 0u; mine = (j == x) ? c : mine; }
        if (sum == G) break;
        __builtin_amdgcn_s_sleep(1);
        if ((++sp & 255u) == 0u) { if (xb_ld(&bar[XB_TMO])) break; if (sp > XB_SPIN_CAP) { atomicAdd(&bar[XB_TMO], 1u); break; } }
    }
    nloc = mine > 0u ? mine : 1u; nx = cnt > 0u ? cnt : 1u;
}

__device__ __forceinline__ void xcd_barrier(const XcdBarrier& b, int wave_s) {
    asm volatile("s_waitcnt vmcnt(0)" ::: "memory");
    __syncthreads();
    if (tid_from_wave(wave_s) == 0) {
        unsigned* bar = b.bar; unsigned bx = b.x; asm volatile("" : "+s"(bar), "+s"(bx));
        __builtin_amdgcn_s_waitcnt(0);
        unsigned nloc = b.st[0], nx = b.st[1];
        if (nloc == 0u) { xcd_barrier_complete(bar, bx, nloc, nx); b.st[0] = nloc; b.st[1] = nx; }
        const unsigned old = xb_add(&bar[XB_XSUB(bx)], 1u);
        const unsigned gen = old / nloc;
        if (old + 1u == (gen + 1u) * nloc) {
            __builtin_amdgcn_fence(__ATOMIC_RELEASE, "agent");
            asm volatile("s_waitcnt vmcnt(0)" ::: "memory");
            const unsigned og = xb_add(&bar[XB_TOP], 1u);
            const unsigned tg = og / nx;
            if (og + 1u == (tg + 1u) * nx) xb_add(&bar[XB_TOPGEN], 1u);
            else XB_SPIN(xb_ld(&bar[XB_TOPGEN]) == tg, bar);
            __builtin_amdgcn_fence(__ATOMIC_ACQUIRE, "agent");
            xb_add(&bar[XB_XGEN(bx)], 1u);
            asm volatile("s_waitcnt vmcnt(0)" ::: "memory");
        } else {
            XB_SPIN(xb_ld(&bar[XB_XGEN(bx)]) == gen, bar);
            __builtin_amdgcn_fence(__ATOMIC_ACQUIRE, "agent");
            asm volatile("s_waitcnt vmcnt(0)" ::: "memory");
        }
    }
    __syncthreads();
}

__device__ __forceinline__ float frcp(float x) { return __builtin_amdgcn_rcpf(x); }
__device__ __forceinline__ float frsq(float x) { return __builtin_amdgcn_rsqf(x); }
__device__ __forceinline__ float fsqrt(float x) { return __builtin_amdgcn_sqrtf(x); }
__device__ __forceinline__ float shfl_idx_l(float v, int src) { return __int_as_float(__builtin_amdgcn_ds_bpermute(src << 2, __float_as_int(v))); }
__device__ __forceinline__ float shfl_xor_l(float v, int m, int lane) { return shfl_idx_l(v, lane ^ m); }
__device__ __forceinline__ float wave_sum(float v, int lane) {
#pragma unroll
    for (int o = 1; o < 64; o <<= 1) v += shfl_xor_l(v, o, lane);
    return v;
}
__device__ __forceinline__ void transpose_item(const float* W, int ldw, int K, bf16_t* WT, int k0, int ns, int nd, LAS float* scr, int lane) {
    const float* wp_ = W + (size_t)(k0 + (lane >> 5)) * ldw + ns + (lane & 31);
    float wv_[32];
#pragma unroll
    for (int i = 0; i < 32; ++i) { wv_[i] = *wp_; wp_ += 2 * (size_t)ldw; }
#pragma unroll
    for (int i = 0; i < 32; ++i) scr[(2 * i + (lane >> 5)) * 33 + (lane & 31)] = wv_[i];
    LDS_WAIT(); asm volatile("" ::: "memory");
    const int c = lane & 7;
#pragma unroll
    for (int j = 0; j < 4; ++j) { const int n = (lane >> 3) + 8 * j; const LAS float* s = scr + (8 * c) * 33 + n;
        v4u o; o.x = pk2(s[0 * 33], s[1 * 33]); o.y = pk2(s[2 * 33], s[3 * 33]); o.z = pk2(s[4 * 33], s[5 * 33]); o.w = pk2(s[6 * 33], s[7 * 33]);
        *(GAS v4u*)(WT + (size_t)(nd + n) * K + k0 + 8 * c) = o; }
    LDS_WAIT(); asm volatile("" ::: "memory");
}
__device__ __forceinline__ void wconv_phase(const Params& P, int l, int parts, LAS unsigned char* L, int wave, int lane, int gw, int NGW) {
    LAS float* scr = (LAS float*)(L + wave * 16384);
    constexpr int I_IN = (DM / 64) * (NPL / 32), I_OUT = (DM / 64) * (DM / 32), I_F1 = (DM / 64) * (FF / 32), I_F2 = (FF / 64) * (DM / 32);
    if (parts & 1) { for (int r = gw; r < I_IN; r += NGW) { const int nb = r % (NPL / 32), kb = r / (NPL / 32); const int nd = 32 * nb; transpose_item(P.w_in + (size_t)l * DM * 2568, 2568, DM, (bf16_t*)(P.ws + WS_WIN), 64 * kb, nd < 1024 ? nd : nd + 8, nd, scr, lane); }
        for (int i = gw * 64 + lane; i < 256 * DM / 2; i += NGW * 64) { const int j = i / (DM / 2), kx = 2 * (i % (DM / 2));
            ((uint32_t*)(P.ws + WS_WIN))[(size_t)NPL * DM / 2 + i] = j < 8 ? pk2(P.w_in[((size_t)l * DM + kx) * 2568 + 1024 + j], P.w_in[((size_t)l * DM + kx + 1) * 2568 + 1024 + j]) : 0u; } }
    if (parts & 2) for (int r = gw; r < I_OUT; r += NGW) { const int nb = r % (DM / 32), kb = r / (DM / 32); transpose_item(P.w_out + (size_t)l * DM * DM, DM, DM, (bf16_t*)(P.ws + WS_WOUT), 64 * kb, 32 * nb, 32 * nb, scr, lane); }
    if (parts & 4) for (int r = gw; r < I_F1; r += NGW) { const int nb = r % (FF / 32), kb = r / (FF / 32); transpose_item(P.w_ffn1 + (size_t)l * DM * FF, FF, DM, (bf16_t*)(P.ws + WS_WF1), 64 * kb, 32 * nb, 32 * nb, scr, lane); }
    if (parts & 8) for (int r = gw; r < I_F2; r += NGW) { const int nb = r % (DM / 32), kb = r / (DM / 32); transpose_item(P.w_ffn2 + (size_t)l * FF * DM, DM, FF, (bf16_t*)(P.ws + WS_WF2), 64 * kb, 32 * nb, 32 * nb, scr, lane); }
    if (parts & 16) { bf16_t* lwt = (bf16_t*)(P.ws + WS_LWT);
        for (int idx = gw * 64 + lane; idx < 32768; idx += NGW * 64) { const int i = idx & 63, j = (idx >> 6) & 63, kb = (idx >> 12) & 3, dir = idx >> 14; const size_t src = ((((size_t)l * 2 + dir) * 4 + kb) * 64 + i) * 64 + j;
            lwt[(size_t)(((dir * 2 + 0) * 4 + kb) * 64 + j) * 64 + i] = f2bf(P.lru_w_a[src]); lwt[(size_t)(((dir * 2 + 1) * 4 + kb) * 64 + j) * 64 + i] = f2bf(P.lru_w_i[src]); } }
}
__device__ __forceinline__ void norm_phase(const Params& P, int l, int which, int slabs, int fmt, int lane, int gw, int NGW) {
    const float* g = (which == 0 ? P.g_mix : P.g_ffn) + (size_t)l * DM; const float* wdt = (const float*)(P.ws + WS_WDT);
    for (int rb = gw; rb < MT; rb += 2 * NGW) {
        f32x4 v[2][4]; bool act[2]; int rr[2];
#pragma unroll
        for (int h = 0; h < 2; ++h) { const int r = rb + h * NGW; rr[h] = r;
            if (which == 0 && fmt == 1 && r < MT && (r % SB) >= CTX && lane == 0) ((float*)(P.ws + WS_RS2))[r] = 0.f;
            act[h] = r < MT && !(which == 1 && l == NL - 1 && (r % SB) < CTX) && !(fmt == 1 && (r % SB) >= CTX);
            if (act[h]) { const float* xr = which == 0 ? xin_row(P, l, r) : resid_row(P, r);
#pragma unroll
                for (int j = 0; j < 4; ++j) v[h][j] = *(const f32x4*)(xr + 4 * lane + 256 * j);
                if (slabs && (r % SB) < CTX) {
                    const size_t cro = ((size_t)(r / SB) * CTX + (r % SB)) * DM;
#pragma unroll
                    for (int ks = 0; ks < 4; ++ks)
#pragma unroll
                        for (int j = 0; j < 4; ++j) v[h][j] += *(const f32x4*)((const float*)(P.ws + WS_SLAB) + (size_t)ks * NB * CTX * DM + cro + 4 * lane + 256 * j);
#pragma unroll
                    for (int j = 0; j < 4; ++j) *(f32x4*)((float*)(P.ws + WS_XRC) + cro + 4 * lane + 256 * j) = v[h][j]; } } }
#pragma unroll
        for (int h = 0; h < 2; ++h) if (act[h]) { const int r = rr[h]; const float* md = mod_row(P, l, r); const float* sh = md + (which == 0 ? 0 : 3072); const float* sc = sh + 1024;
            float s = 0.f;
#pragma unroll
            for (int j = 0; j < 4; ++j) s += (v[h][j].x * v[h][j].x + v[h][j].y * v[h][j].y) + (v[h][j].z * v[h][j].z + v[h][j].w * v[h][j].w);
            const float ssum = wave_sum(s, lane); const float rs = fmt == 1 ? 1.f : frsq(ssum * (1.0f / DM) + EPS);
            if (fmt == 1 && lane == 0) ((float*)(P.ws + (which == 0 ? WS_RS1 : WS_RS2)))[r] = ssum;
            float dt[8];
#pragma unroll
            for (int jj = 0; jj < 8; ++jj) dt[jj] = 0.f;
#pragma unroll
            for (int j = 0; j < 4; ++j) { const int idx = 4 * lane + 256 * j; const f32x4 gv = *(const f32x4*)(g + idx), sv = *(const f32x4*)(sc + idx), hv = *(const f32x4*)(sh + idx);
                const f32x4 o = fmt == 1 ? (v[h][j] * gv) * (1.f + sv) : (v[h][j] * rs * gv) * (1.f + sv) + hv;
                *(unsigned long long*)((bf16_t*)(P.ws + (fmt == 1 && which == 1 ? WS_XA2 : WS_XN)) + (size_t)r * DM + idx) = (unsigned long long)pk2(o.x, o.y) | ((unsigned long long)pk2(o.z, o.w) << 32);
                if (which == 0 && fmt != 1) {
#pragma unroll
                    for (int jj = 0; jj < 8; ++jj) { const f32x4 w = *(const f32x4*)(wdt + jj * DM + idx); dt[jj] += (o.x * w.x + o.y * w.y) + (o.z * w.z + o.w * w.w); } } }
            if (which == 0 && fmt != 1) {
#pragma unroll
                for (int jj = 0; jj < 8; ++jj) dt[jj] = wave_sum(dt[jj], lane);
                if (lane == 0) { ((float*)(P.ws + WS_RS2))[r] = 0.f;
                    float* d = (float*)(P.ws + WS_DTP) + (size_t)r * 8;
#pragma unroll
                    for (int jj = 0; jj < 8; ++jj) d[jj] = dt[jj]; } } }
    }
}
__device__ __forceinline__ void norm1_phase(const Params& P, int l, int slabs, LAS unsigned char* L, int tid, int lane, int gw, int NGW) {
    LAS float* scl = (LAS float*)(L + 32768); LAS float* shl = (LAS float*)(L + 32768 + (NB + 1) * DM * 4); LAS float* gl = (LAS float*)(L + 32768 + 2 * (NB + 1) * DM * 4);
    __syncthreads();
    for (int i = tid; i < DM; i += 512) gl[i] = P.g_mix[(size_t)l * DM + i];
    for (int i = tid; i < (NB + 1) * DM; i += 512) { const float* md = (const float*)(P.ws + WS_MOD) + ((size_t)l * (NB + 1) + i / DM) * NMOD + (i % DM); shl[i] = md[0]; scl[i] = md[1024]; }
    __syncthreads();
    f32x4 vn[2][4];
#define N1_LOAD(dst, rb_) do { _Pragma("unroll") for (int h_ = 0; h_ < 2; ++h_) { const int r_ = (rb_) + h_ * NGW; if (r_ < MT) { \
        if (l > 0 && (r_ % SB) >= CTX) { const bf16_t* xb_ = (const bf16_t*)P.out + ((size_t)(r_ / SB) * SEQ + (r_ % SB - CTX)) * DM; \
            _Pragma("unroll") for (int j_ = 0; j_ < 4; ++j_) { const U2 w_ = *(const U2*)(xb_ + 4 * lane + 256 * j_); dst[h_][j_].x = __uint_as_float(w_.x); dst[h_][j_].y = __uint_as_float(w_.y); } } \
        else { const float* xr_ = xin_row(P, l, r_); \
            _Pragma("unroll") for (int j_ = 0; j_ < 4; ++j_) dst[h_][j_] = *(const f32x4*)(xr_ + 4 * lane + 256 * j_); } } } } while (0)
    N1_LOAD(vn, gw);
    for (int rb = gw; rb < MT; rb += 2 * NGW) {
        f32x4 v[2][4];
#pragma unroll
        for (int h = 0; h < 2; ++h)
#pragma unroll
            for (int j = 0; j < 4; ++j) v[h][j] = vn[h][j];
        if (rb + 2 * NGW < MT) N1_LOAD(vn, rb + 2 * NGW);
#pragma unroll
        for (int h = 0; h < 2; ++h) { const int r = rb + h * NGW; if (r < MT) { const int b_ = r / SB, s_ = r % SB; const int bm = s_ < CTX ? NB : b_;
            if (l > 0 && s_ >= CTX) {
#pragma unroll
                for (int j = 0; j < 4; ++j) { const unsigned w0 = __float_as_uint(v[h][j].x), w1 = __float_as_uint(v[h][j].y); v[h][j] = f32x4{__uint_as_float(w0 << 16), __uint_as_float(w0 & 0xffff0000u), __uint_as_float(w1 << 16), __uint_as_float(w1 & 0xffff0000u)}; } }
            if (slabs && s_ < CTX) {
                const size_t cro = ((size_t)b_ * CTX + s_) * DM;
#pragma unroll
                for (int ks = 0; ks < 4; ++ks)
#pragma unroll
                    for (int j = 0; j < 4; ++j) v[h][j] += *(const f32x4*)((const float*)(P.ws + WS_SLAB) + (size_t)ks * NB * CTX * DM + cro + 4 * lane + 256 * j);
#pragma unroll
                for (int j = 0; j < 4; ++j) *(f32x4*)((float*)(P.ws + WS_XRC) + cro + 4 * lane + 256 * j) = v[h][j]; }
            float sq = 0.f;
#pragma unroll
            for (int j = 0; j < 4; ++j) sq += (v[h][j].x * v[h][j].x + v[h][j].y * v[h][j].y) + (v[h][j].z * v[h][j].z + v[h][j].w * v[h][j].w);
            const float rs = frsq(wave_sum(sq, lane) * (1.0f / DM) + EPS);
#pragma unroll
            for (int j = 0; j < 4; ++j) { const int idx = 4 * lane + 256 * j; const f32x4 sv = *(const LAS f32x4*)(scl + bm * DM + idx), hv = *(const LAS f32x4*)(shl + bm * DM + idx);
                const f32x4 o = (v[h][j] * rs * *(const LAS f32x4*)(gl + idx)) * (1.f + sv) + hv;
                *(unsigned long long*)((bf16_t*)(P.ws + WS_XN) + (size_t)r * DM + idx) = (unsigned long long)pk2(o.x, o.y) | ((unsigned long long)pk2(o.z, o.w) << 32);
                __builtin_amdgcn_sched_barrier(0); }
            if (lane == 0) { ((float*)(P.ws + WS_RS2))[r] = 0.f; ((float*)(P.ws + WS_RS1))[r] = 0.f; }
            } }
    }
#undef N1_LOAD
    __syncthreads();
}
__device__ __forceinline__ void qk_phase(const Params& P, int l, int lane, int gw, int NGW) {
    const int l16 = lane & 15, ax = l16 >> 3, second = (l16 >> 2) & 1, tk = lane >> 5;
    f32x4 gA, gB, gC, inv;
    { const float* gq0 = P.gqa_q_norm + l * 64 + 4 * l16; const float* gq1 = P.swa_q_norm + l * 64 + 4 * l16; const float* gk0 = P.gqa_k_norm + l * 64 + 4 * l16; const float* gk1 = P.swa_k_norm + l * 64 + 4 * l16;
        gA = *(const f32x4*)gq0 * QSCALE; gB = *(const f32x4*)gq1 * QSCALE; const f32x4 k0 = *(const f32x4*)gk0, k1 = *(const f32x4*)gk1; gC = tk ? k1 : k0;
#pragma unroll
        for (int e = 0; e < 4; ++e) inv[e] = expf(-(float)(4 * (l16 & 3) + e) * (9.210340371976184f / 16.f)) * 0.15915494309189535f; }
    const int offA = PL_C + 4 * lane, offB = PL_D + 4 * lane, offC = (tk ? PL_D : PL_C) + 256 + 4 * (lane & 31);
    U2 wn[2][3];
#define QK_LOAD(dst, rb_) do { _Pragma("unroll") for (int h_ = 0; h_ < 2; ++h_) { const int r_ = (rb_) + h_ * NGW; if (r_ < MT) { const bf16_t* p_ = (const bf16_t*)(P.ws + WS_PL) + (size_t)r_ * NPL; \
        dst[h_][0] = *(const U2*)(p_ + offA); dst[h_][1] = *(const U2*)(p_ + offB); dst[h_][2] = *(const U2*)(p_ + offC); } } } while (0)
    QK_LOAD(wn, gw);
    for (int rb = gw; rb < MT; rb += 2 * NGW) {
        U2 w[2][3];
#pragma unroll
        for (int h = 0; h < 2; ++h)
#pragma unroll
            for (int c = 0; c < 3; ++c) w[h][c] = wn[h][c];
        if (rb + 2 * NGW < MT) QK_LOAD(wn, rb + 2 * NGW);
#pragma unroll
        for (int h = 0; h < 2; ++h) { const int r = rb + h * NGW; if (r < MT) { const int s = r % SB; bf16_t* p = (bf16_t*)(P.ws + WS_PL) + (size_t)r * NPL;
            f32x4 cs = {1.f, 1.f, 1.f, 1.f}, sn = {0.f, 0.f, 0.f, 0.f};
            if (s >= CTX) { const int pos = s - CTX; const float pc = (float)(ax ? pos % GRIDW : pos / GRIDW);
#pragma unroll
                for (int e = 0; e < 4; ++e) { const float rev = pc * inv[e]; cs[e] = __builtin_amdgcn_cosf(rev); sn[e] = __builtin_amdgcn_sinf(rev); } }
            if (!second) sn = -sn;
#pragma unroll
            for (int c = 0; c < 3; ++c) { const f32x4 g = c == 0 ? gA : (c == 1 ? gB : gC);
                f32x4 x = {__uint_as_float(w[h][c].x << 16), __uint_as_float(w[h][c].x & 0xffff0000u), __uint_as_float(w[h][c].y << 16), __uint_as_float(w[h][c].y & 0xffff0000u)};
                float ss = (x.x * x.x + x.y * x.y) + (x.z * x.z + x.w * x.w);
#pragma unroll
                for (int o = 1; o < 16; o <<= 1) ss += shfl_xor_l(ss, o, lane);
                const float rs = frsq(ss * (1.0f / 64) + EPS);
                x = x * rs * g;
                f32x4 pt; pt.x = shfl_xor_l(x.x, 4, lane); pt.y = shfl_xor_l(x.y, 4, lane); pt.z = shfl_xor_l(x.z, 4, lane); pt.w = shfl_xor_l(x.w, 4, lane);
                x = x * cs + pt * sn;
                U2 o2; o2.x = pk2(x.x, x.y); o2.y = pk2(x.z, x.w);
                *(U2*)(p + (c == 0 ? offA : (c == 1 ? offB : offC))) = o2; } } }
    }
#undef QK_LOAD
}
__device__ __forceinline__ void prep_phase(const Params& P, int l, LAS unsigned char* L, int tid, int vcu, int G) {
    constexpr int TP = 136;
    LAS bf16_t* OT = (LAS bf16_t*)L;
    const int cp = tid & 127, tq = tid >> 7;
    for (int u = vcu; u < NB * NCH * 5; u += G) {
        const int bc = u / 5, part = u % 5; const int b = bc / NCH, c = bc % NCH; const int s0 = c * CHK; const int lo = s0 < CTX ? 0 : CTX, hi = s0 < CTX ? CTX : SB;
        const bf16_t* pl = (const bf16_t*)(P.ws + WS_PL) + (size_t)b * SB * NPL + (part < 3 ? PL_XBC + 256 * part : part == 3 ? PL_LX : PL_Z) + 2 * cp;
        float w0[4], w1[4], b0 = 0.f, b1 = 0.f;
#pragma unroll
        for (int t = 0; t < 4; ++t) { w0[t] = 0.f; w1[t] = 0.f; }
        if (part < 3) { const int ch = 256 * part + 2 * cp;
#pragma unroll
            for (int t = 0; t < 4; ++t) { w0[t] = P.ssd_conv_w[(l * 4 + t) * 768 + ch]; w1[t] = P.ssd_conv_w[(l * 4 + t) * 768 + ch + 1]; }
            b0 = P.ssd_conv_b[l * 768 + ch]; b1 = P.ssd_conv_b[l * 768 + ch + 1]; }
        else if (part == 3) {
#pragma unroll
            for (int t = 0; t < 4; ++t) { w0[t] = P.lru_conv_w[(l * 4 + t) * 256 + 2 * cp]; w1[t] = P.lru_conv_w[(l * 4 + t) * 256 + 2 * cp + 1]; }
            b0 = P.lru_conv_b[l * 256 + 2 * cp]; b1 = P.lru_conv_b[l * 256 + 2 * cp + 1]; }
        else { w0[2] = 1.f; w1[2] = 1.f; }
        const int sA = s0 + 32 * tq;
        auto ldrow = [&](int ss) -> unsigned { return (ss >= lo && ss < hi) ? *(const unsigned*)(pl + (size_t)ss * NPL) : 0u; };
        unsigned xr[35];
#pragma unroll
        for (int i = 0; i < 35; ++i) xr[i] = ldrow(sA - 2 + i);
        const bool tr = (part == 0 || part == 1 || part == 4);
#pragma unroll
        for (int i = 0; i < 32; ++i) { const int ss = sA + i; const unsigned xm2 = xr[i], xm1 = xr[i + 1], x0 = xr[i + 2], xp1 = xr[i + 3];
            float a0 = b0 + w0[0] * bflo(xm2) + w0[1] * bflo(xm1) + w0[2] * bflo(x0) + w0[3] * bflo(xp1);
            float a1 = b1 + w1[0] * bfhi(xm2) + w1[1] * bfhi(xm1) + w1[2] * bfhi(x0) + w1[3] * bfhi(xp1);
            if (part < 3) { a0 = a0 * frcp(1.f + __expf(-a0)); a1 = a1 * frcp(1.f + __expf(-a1)); }
            const unsigned o = part == 4 ? x0 : pk2(a0, a1); const size_t r = (size_t)b * SB + ss;
            if (part == 1 || part == 2) *(unsigned*)((bf16_t*)(P.ws + WS_XBC) + r * XBP + 256 * (part - 1) + 2 * cp) = o;
            else if (part == 3) *(unsigned*)((bf16_t*)(P.ws + WS_XLC) + r * 256 + 2 * cp) = o;
            if (tr) { OT[(2 * cp) * TP + 32 * tq + i] = (bf16_t)(o & 0xffffu); OT[(2 * cp + 1) * TP + 32 * tq + i] = (bf16_t)(o >> 16); } }
        if (tr) { __syncthreads();
            bf16_t* dst = (bf16_t*)(P.ws + (part == 0 ? WS_XT : part == 1 ? WS_BT : WS_ZT)) + (size_t)bc * 256 * CHK;
#pragma unroll
            for (int k = 0; k < 8; ++k) { const int piece = tid + 512 * k; const int ch = piece >> 4, q = piece & 15; *(GAS v4u*)(dst + (size_t)ch * CHK + 8 * q) = *(const LAS v4u*)(OT + ch * TP + 8 * q); }
            __syncthreads(); }
    }
}

namespace ssdk {
typedef short bf16x8 __attribute__((ext_vector_type(8)));
typedef float f32x16 __attribute__((ext_vector_type(16)));
typedef float f32x2_t __attribute__((ext_vector_type(2))); typedef __bf16 bf16x2_t __attribute__((ext_vector_type(2)));
typedef unsigned u32x2 __attribute__((ext_vector_type(2)));
__device__ __forceinline__ unsigned cvtpk(float lo, float hi) { f32x2_t v = {lo, hi}; bf16x2_t b = __builtin_convertvector(v, bf16x2_t); return __builtin_bit_cast(unsigned, b); }
#define SSD_MFMA(a, b, c) __builtin_amdgcn_mfma_f32_32x32x16_bf16(a, b, c, 0, 0, 0)
__device__ __forceinline__ int drow(int q, int hh) { return (q & 3) + 8 * (q >> 2) + 4 * hh; }

__device__ __forceinline__ void ssd_state_item(const Params& P, int l, LAS unsigned char* L, int tid, int bc, int hd, int dir) {
    const int lane = tid & 63, wid = __builtin_amdgcn_readfirstlane(tid >> 6), r32 = lane & 31, hh = lane >> 5;
    LAS float* wl = (LAS float*)(L + wid * 512);
    float* sc4w = (float*)(P.ws + WS_SC4); const float* dtp = (const float*)(P.ws + WS_DTP);
    const float a2 = -expf(P.ssd_a_log[(l * 2 + dir) * 4 + hd]) * LOG2E, dtb = P.ssd_dt_bias[(l * 2 + dir) * 4 + hd];
    {
        const size_t r0 = (size_t)bc * CHK;
        const bf16_t* xt = (const bf16_t*)(P.ws + WS_XT) + ((size_t)bc * 256 + hd * 64 + r32) * CHK + 8 * hh;
        const bf16_t* bt = (const bf16_t*)(P.ws + WS_BT) + ((size_t)bc * 256 + (hd >> 1) * 128 + r32) * CHK + 8 * hh;
        v4u xq[8][2]; bf16x8 bq[8][2];
        float dtv[2], cum[2]; int tk[2]; float carry = 0.f;
#pragma unroll
        for (int jj = 0; jj < 2; ++jj) { const int idx = lane + 64 * jj; tk[jj] = dir ? CHK - 1 - idx : idx; dtv[jj] = dtp[(r0 + tk[jj]) * 8 + dir * 4 + hd]; }
#pragma unroll
        for (int s = 0; s < 8; ++s) {
#pragma unroll
            for (int pt = 0; pt < 2; ++pt) xq[s][pt] = *(const GAS v4u*)(xt + (size_t)pt * 32 * CHK + 16 * s);
#pragma unroll
            for (int nt = 0; nt < 2; ++nt) bq[s][nt] = *(const GAS bf16x8*)(bt + (size_t)nt * 32 * CHK + 16 * s); }
#pragma unroll
        for (int jj = 0; jj < 2; ++jj) { dtv[jj] = softplus_f(dtv[jj] + dtb); float v = dtv[jj] * a2;
#pragma unroll
            for (int o = 1; o < 64; o <<= 1) { const float t = shfl_idx_l(v, (lane - o) & 63); if (lane >= o) v += t; }
            cum[jj] = v + carry; carry = shfl_idx_l(cum[jj], 63); }
        const float aend = carry;
#pragma unroll
        for (int jj = 0; jj < 2; ++jj) { float* so4 = sc4w + ((r0 + tk[jj]) * 4 + hd) * 4 + dir * 2; so4[0] = cum[jj]; so4[1] = dtv[jj]; wl[tk[jj]] = __builtin_amdgcn_exp2f(aend - cum[jj]) * dtv[jj]; }
        if (lane == 0) ((float*)(P.ws + WS_DEC))[((size_t)bc * 4 + hd) * 2 + dir] = __builtin_amdgcn_exp2f(aend);
        LDS_WAIT(); asm volatile("" ::: "memory");
        bf16_t* so = (bf16_t*)(P.ws + WS_SST) + (((size_t)bc * 4 + hd) * 2 + dir) * 8192 + (size_t)r32 * 128 + 4 * hh;
#pragma unroll
        for (int pass = 0; pass < 2; ++pass) {
            f32x16 acc[2][2];
#pragma unroll
            for (int a = 0; a < 2; ++a)
#pragma unroll
                for (int b = 0; b < 2; ++b) acc[a][b] = f32x16{};
#pragma unroll
            for (int s = 0; s < 8; ++s) {
                if (pass == 0) { const f32x4 w0 = *(const LAS f32x4*)(wl + 16 * s + 8 * hh), w1 = *(const LAS f32x4*)(wl + 16 * s + 8 * hh + 4);
#pragma unroll
                    for (int pt = 0; pt < 2; ++pt) { const v4u raw = xq[s][pt];
                        v4u o; o.x = cvtpk(bflo(raw.x) * w0.x, bfhi(raw.x) * w0.y); o.y = cvtpk(bflo(raw.y) * w0.z, bfhi(raw.y) * w0.w); o.z = cvtpk(bflo(raw.z) * w1.x, bfhi(raw.z) * w1.y); o.w = cvtpk(bflo(raw.w) * w1.z, bfhi(raw.w) * w1.w);
                        xq[s][pt] = o; } }
#pragma unroll
                for (int pt = 0; pt < 2; ++pt)
#pragma unroll
                    for (int nt = 0; nt < 2; ++nt) acc[pt][nt] = SSD_MFMA(bq[s][nt], __builtin_bit_cast(bf16x8, xq[s][pt]), acc[pt][nt]);
                __builtin_amdgcn_sched_barrier(0);
                if (pass == 0) {
#pragma unroll
                    for (int nt = 0; nt < 2; ++nt) bq[s][nt] = *(const GAS bf16x8*)(bt + (size_t)(2 + nt) * 32 * CHK + 16 * s); }
                __builtin_amdgcn_sched_barrier(0);
            }
#pragma unroll
            for (int pt = 0; pt < 2; ++pt)
#pragma unroll
                for (int nt = 0; nt < 2; ++nt)
#pragma unroll
                    for (int gq = 0; gq < 4; ++gq) { U2 w; w.x = cvtpk(acc[pt][nt][4 * gq], acc[pt][nt][4 * gq + 1]); w.y = cvtpk(acc[pt][nt][4 * gq + 2], acc[pt][nt][4 * gq + 3]);
                        *(U2*)(so + (size_t)(32 * pt) * 128 + 64 * pass + 32 * nt + 8 * gq) = w; }
        }
        LDS_WAIT(); asm volatile("" ::: "memory");
    }
}
template <int ABL = 0> __device__ __forceinline__ void ssd_out_phase(const Params& P, int l, LAS unsigned char* L, int wave_s, int vcu, int nssd) {
    const int wid = wave_s; const int hd = wid & 3, hb = wid >> 2, g = hd >> 1;
    LAS f32x4* sc = (LAS f32x4*)(L + hb * 8192);
    LAS float* SS = (LAS float*)(L + 16384 + hb * 512);
    constexpr int OP_ = 72;
    LAS bf16_t* OST = (LAS bf16_t*)(L + 32768 + wid * (32 * OP_ * 2));
    constexpr int CTP = 264;
    LAS bf16_t* CT = (LAS bf16_t*)(L + 73728 + hb * (32 * CTP * 2));
    const float dsk = P.ssd_d[l * 4 + hd];
    const float* sc4 = (const float*)(P.ws + WS_SC4); const bf16_t* xbc = (const bf16_t*)(P.ws + WS_XBC);
    const int nlat = l == NL - 1;
    const int ntile = nlat ? NB * (NCH - NCC) * 4 : NB * NCH * 4;
    for (int T = vcu < nssd ? 2 * vcu + hb : ntile; T < ntile; T += 2 * nssd) {
        const int cq = T >> 2, ti = T & 3; const int bc = nlat ? cq + NCC * (cq / (NCH - NCC) + 1) : cq; const size_t r0 = (size_t)bc * CHK;
        const int tid = tid_from_wave(wave_s); const int lane = tid & 63, r32 = lane & 31, hh = lane >> 5, th = tid & 255;
        __syncthreads();
#pragma unroll
        for (int k2 = 0; k2 < 2; ++k2) { const int e = th + 256 * k2; sc[(e & 3) * 128 + (e >> 2)] = *(const GAS f32x4*)(sc4 + ((r0 + (e >> 2)) * 4 + (e & 3)) * 4); }
#pragma unroll
        for (int k4 = 0; k4 < 4; ++k4) { const int e = th + 256 * k4; *(LAS v4u*)(CT + (e >> 5) * CTP + (e & 31) * 8) = *(const GAS v4u*)(xbc + (r0 + 32 * ti + (e >> 5)) * XBP + 256 + (e & 31) * 8); }
        __syncthreads();
        f32x16 val[2];
        {
            {
            const int il = 32 * ti + r32; const f32x4 sci = sc[hd * 128 + il]; const float acf = sci.x, acb = sci.z;
            const LAS bf16_t* cfp = CT + r32 * CTP + g * 128 + 8 * hh;
            const bf16_t* xt = (const bf16_t*)(P.ws + WS_XT) + ((size_t)bc * 256 + hd * 64 + r32) * CHK + 4 * hh;
            const bf16_t* bp0 = xbc + (r0 + r32) * XBP + g * 128 + 8 * hh;
#define SSD_CF(s_) (*(const LAS bf16x8*)(cfp + 16 * (s_)))
            bf16x8 bcur[8];
#pragma unroll
            for (int s = 0; s < 8; ++s) bcur[s] = *(const GAS bf16x8*)(bp0 + 16 * s);
            f32x16 yt[2]; yt[0] = f32x16{}; yt[1] = f32x16{};
            if (!(ABL & 1)) { bf16x8 hf[2][2][4]; f32x16 tt[2];
#define HF_LOAD(buf_, g_) do { const bf16_t* hs_ = (const bf16_t*)(P.ws + WS_SST) + ((((size_t)bc * 4 + hd) * 2 + ((g_) >> 1)) * 64 + r32) * 128 + 8 * hh; \
                _Pragma("unroll") for (int s_ = 0; s_ < 4; ++s_) _Pragma("unroll") for (int pt_ = 0; pt_ < 2; ++pt_) hf[buf_][pt_][s_] = *(const GAS bf16x8*)(hs_ + (size_t)pt_ * 32 * 128 + 16 * (4 * ((g_) & 1) + s_)); } while (0)
                HF_LOAD(0, 0); HF_LOAD(1, 1);
#pragma unroll
                for (int g4 = 0; g4 < 4; ++g4) { const int dir = g4 >> 1, sh = g4 & 1;
                    if (sh == 0) { tt[0] = f32x16{}; tt[1] = f32x16{}; }
#pragma unroll
                    for (int s = 0; s < 4; ++s)
#pragma unroll
                        for (int pt = 0; pt < 2; ++pt) tt[pt] = SSD_MFMA(hf[g4 & 1][pt][s], SSD_CF(4 * sh + s), tt[pt]);
                    __builtin_amdgcn_sched_barrier(0);
                    if (g4 + 2 < 4) HF_LOAD(g4 & 1, g4 + 2);
                    if (sh == 1) { const float e = __builtin_amdgcn_exp2f(dir ? acb : acf); yt[0] += tt[0] * e; yt[1] += tt[1] * e; }
                    __builtin_amdgcn_sched_barrier(0); }
#undef HF_LOAD
            }
#pragma unroll
            for (int jt = 0; jt < ((ABL & 2) ? 0 : 4); ++jt) {
                bf16x8 bnxt[8]; u32x2 xcur[8];
#pragma unroll
                for (int e = 0; e < 8; ++e) xcur[e] = *(const GAS u32x2*)(xt + (size_t)(e >> 2) * 32 * CHK + 32 * jt + 16 * ((e >> 1) & 1) + 8 * (e & 1));
                if (jt < 3) {
#pragma unroll
                    for (int s = 0; s < 8; ++s) bnxt[s] = *(const GAS bf16x8*)(bp0 + (size_t)(32 * (jt + 1)) * XBP + 16 * s); }
                f32x16 gt = f32x16{};
#pragma unroll
                for (int s = 0; s < 8; ++s) gt = SSD_MFMA(bcur[s], SSD_CF(s), gt);
#pragma unroll
                for (int q4 = 0; q4 < 4; ++q4) {
#pragma unroll
                    for (int e = 0; e < 4; ++e) { const int q = 4 * q4 + e; const int j = 32 * jt + drow(q, hh); const f32x4 sj = sc[hd * 128 + j];
                        const float af_ = j <= il ? acf - sj.x : -INFINITY, ab_ = j >= il ? acb - sj.z : -INFINITY;
                        gt[q] *= __builtin_amdgcn_exp2f(af_) * sj.y + __builtin_amdgcn_exp2f(ab_) * sj.w; }
                    __builtin_amdgcn_sched_barrier(0); }
#pragma unroll
                for (int sp = 0; sp < 2; ++sp) { v4u o; o.x = cvtpk(gt[8 * sp + 0], gt[8 * sp + 1]); o.y = cvtpk(gt[8 * sp + 2], gt[8 * sp + 3]); o.z = cvtpk(gt[8 * sp + 4], gt[8 * sp + 5]); o.w = cvtpk(gt[8 * sp + 6], gt[8 * sp + 7]);
                    const bf16x8 wt = __builtin_bit_cast(bf16x8, o);
#pragma unroll
                    for (int pt = 0; pt < 2; ++pt) { const v4u a4 = {xcur[pt * 4 + sp * 2].x, xcur[pt * 4 + sp * 2].y, xcur[pt * 4 + sp * 2 + 1].x, xcur[pt * 4 + sp * 2 + 1].y}; yt[pt] = SSD_MFMA(__builtin_bit_cast(bf16x8, a4), wt, yt[pt]); } }
                __builtin_amdgcn_sched_barrier(0);
                if (jt < 3) {
#pragma unroll
                    for (int s = 0; s < 8; ++s) bcur[s] = bnxt[s]; }
            }
            float ss = 0.f; const bf16_t* xg = (const bf16_t*)(P.ws + WS_XT) + ((size_t)bc * 256 + hd * 64) * CHK + il; const bf16_t* zg = (const bf16_t*)(P.ws + WS_ZT) + ((size_t)bc * 256 + hd * 64) * CHK + il;
#pragma unroll
            for (int pt = 0; pt < 2; ++pt)
#pragma unroll
                for (int q = 0; q < 16; ++q) { const int p = 32 * pt + drow(q, hh); const float xv = (ABL & 4) ? 1.f : bf2f(xg[(size_t)p * CHK]), zv = (ABL & 4) ? 1.f : bf2f(zg[(size_t)p * CHK]);
                    const float v = (yt[pt][q] + dsk * xv) * (zv * frcp(1.f + __expf(-zv))); val[pt][q] = v; ss += v * v; }
            ss += shfl_xor_l(ss, 32, lane);
            if (hh == 0) SS[hd * 32 + r32] = ss;
            __syncthreads();
            }
            {
            const int tid = tid_from_wave(wave_s); const int lane = tid & 63, r32 = lane & 31, hh = lane >> 5;
            const float tot = (SS[r32] + SS[32 + r32]) + (SS[64 + r32] + SS[96 + r32]); const float rs = frsq(tot * (1.0f / 256) + EPS);
#pragma unroll
            for (int pt = 0; pt < 2; ++pt)
#pragma unroll
                for (int q4 = 0; q4 < 4; ++q4) { const int p0 = 32 * pt + 8 * q4 + 4 * hh; const f32x4 gn = *(const f32x4*)(P.ssd_norm_g + l * 256 + hd * 64 + p0);
                    u32x2 o; o.x = cvtpk(val[pt][4 * q4 + 0] * rs * gn.x, val[pt][4 * q4 + 1] * rs * gn.y); o.y = cvtpk(val[pt][4 * q4 + 2] * rs * gn.z, val[pt][4 * q4 + 3] * rs * gn.w);
                    *(LAS u32x2*)(OST + r32 * OP_ + p0) = o; }
            LDS_WAIT(); asm volatile("" ::: "memory");
            bf16_t* mixo = (bf16_t*)(P.ws + WS_XN) + (r0 + 32 * ti) * DM + MIX_A + hd * 64;
#pragma unroll
            for (int k = 0; k < 4; ++k) { const int piece = lane + 64 * k; const int tok = piece >> 3, q8 = piece & 7; *(GAS v4u*)(mixo + (size_t)tok * DM + q8 * 8) = *(const LAS v4u*)(OST + tok * OP_ + q8 * 8); }
            LDS_WAIT(); asm volatile("" ::: "memory");
            }
            __syncthreads();
        }
    }
}
}

namespace lruk {
using ssdk::bf16x8; using ssdk::f32x16; using ssdk::drow;
__device__ __forceinline__ void lru_gate_half(const Params& P, int l, int tid, int bc, int k, int dir, int ct) {
    const int lane = tid & 63, r32 = lane & 31, hh = lane >> 5;
    const bf16_t* lwt = (const bf16_t*)(P.ws + WS_LWT); const bf16_t* xlc = (const bf16_t*)(P.ws + WS_XLC); uint32_t* lab = (uint32_t*)(P.ws + WS_LAB);
    const int ch = k * 64 + 32 * ct + r32;
    const float ba = -LOG2E * P.lru_b_a[(l * 2 + dir) * 256 + ch], bi = -LOG2E * P.lru_b_i[(l * 2 + dir) * 256 + ch], c8 = -8.0f * LOG2E * softplus_f(-P.lru_lambda[(l * 2 + dir) * 256 + ch]);
    bf16x8 bw[2][4];
#pragma unroll
    for (int gate = 0; gate < 2; ++gate)
#pragma unroll
        for (int s = 0; s < 4; ++s) bw[gate][s] = *(const GAS bf16x8*)(lwt + ((size_t)(((dir * 2 + gate) * 4 + k) * 64 + 32 * ct + r32)) * 64 + 16 * s + 8 * hh);
    {
        const size_t r0 = (size_t)bc * CHK; float hrun = 0.f, cprun = 1.f;
        bf16x8 ax[4], axn[4]; uint32_t xq[16], xqn[16];
#define LRU_LOADA(AX, rt_) do { _Pragma("unroll") for (int s_ = 0; s_ < 4; ++s_) AX[s_] = *(const GAS bf16x8*)(xlc + (r0 + 32 * (rt_) + r32) * 256 + k * 64 + 16 * s_ + 8 * hh); } while (0)
#define LRU_LOADX(XQ, rt_) do { _Pragma("unroll") for (int q_ = 0; q_ < 16; ++q_) XQ[q_] = xlc[(r0 + 32 * (rt_) + 8 * (q_ >> 2) + 4 * hh + (q_ & 3)) * 256 + ch]; } while (0)
        LRU_LOADA(ax, dir ? 3 : 0); LRU_LOADX(xq, dir ? 3 : 0);
#pragma unroll
        for (int s = 0; s < 4; ++s) asm volatile("" : "+v"(ax[s]));
#pragma unroll
        for (int q = 0; q < 16; ++q) asm volatile("" : "+v"(xq[q]));
#pragma unroll 1
        for (int kk = 0; kk < 4; ++kk) { const int rt = dir ? 3 - kk : kk;
            f32x16 acc[2];
#pragma unroll
            for (int gate = 0; gate < 2; ++gate) { acc[gate] = f32x16{};
#pragma unroll
                for (int s = 0; s < 4; ++s) acc[gate] = SSD_MFMA(ax[s], bw[gate][s], acc[gate]); }
            if (kk < 3) { LRU_LOADA(axn, dir ? 2 - kk : kk + 1); LRU_LOADX(xqn, dir ? 2 - kk : kk + 1); }
            { float Ag[4], Bg[4];
#pragma unroll
                for (int m = 0; m < 4; ++m) { float a_[4], b_[4]; uint32_t* lrow = lab + ((size_t)dir * MT + r0 + 32 * rt + 8 * m + 4 * hh) * 256 + ch;
#pragma unroll
                    for (int e = 0; e < 4; ++e) { const int q = 4 * m + e;
                        const float sa = frcp(1.f + __builtin_amdgcn_exp2f(__builtin_fmaf(acc[0][q], -LOG2E, ba))), si = frcp(1.f + __builtin_amdgcn_exp2f(__builtin_fmaf(acc[1][q], -LOG2E, bi)));
                        const float la2 = c8 * sa, av = __builtin_amdgcn_exp2f(la2);
                        const float bb = fsqrt(__builtin_fmaxf(__builtin_fmaf(-av, av, 1.f), 0.f)) * (si * __uint_as_float(xq[q] << 16));
                        lrow[e * 256] = ssdk::cvtpk(la2, bb);
                        a_[e] = av; b_[e] = bb; }
                    Ag[m] = (a_[0] * a_[1]) * (a_[2] * a_[3]);
                    Bg[m] = dir ? ((b_[3] * a_[2] + b_[2]) * a_[1] + b_[1]) * a_[0] + b_[0] : ((b_[0] * a_[1] + b_[1]) * a_[2] + b_[2]) * a_[3] + b_[3]; }
                if (dir) { float t_; t_ = Ag[0]; Ag[0] = Ag[3]; Ag[3] = t_; t_ = Ag[1]; Ag[1] = Ag[2]; Ag[2] = t_; t_ = Bg[0]; Bg[0] = Bg[3]; Bg[3] = t_; t_ = Bg[1]; Bg[1] = Bg[2]; Bg[2] = t_; }
#pragma unroll
                for (int gs = 0; gs < 8; ++gs) { const int m = gs >> 1; const bool own = ((gs & 1) ^ dir) == hh;
                    const float Ap = shfl_xor_l(Ag[m], 32, lane), Bp = shfl_xor_l(Bg[m], 32, lane); const float A = own ? Ag[m] : Ap, B = own ? Bg[m] : Bp;
                    hrun = A * hrun + B; cprun *= A; } }
            if (kk < 3) {
#pragma unroll
                for (int s = 0; s < 4; ++s) ax[s] = axn[s];
#pragma unroll
                for (int q = 0; q < 16; ++q) xq[q] = xqn[q]; }
        }
#undef LRU_LOADA
#undef LRU_LOADX
        if (hh == 0) { const size_t idx = ((size_t)bc * 2 + dir) * 256 + ch; ((float*)(P.ws + WS_LHE))[idx] = hrun; ((float*)(P.ws + WS_LCP))[idx] = cprun; }
    }
}
__device__ __forceinline__ void lru_final_phase(const Params& P, LAS unsigned char* L, int tid, int u0, int ustep, int skip_ctx) {
    LAS bf16_t* HL = (LAS bf16_t*)L; const int ch = tid & 255, dir = tid >> 8;
    for (int bc = u0; bc < NB * NCH; bc += ustep) {
        if (skip_ctx && (bc % NCH) < NCC) continue;
        const size_t r0 = (size_t)bc * CHK; const uint32_t* lab = (const uint32_t*)(P.ws + WS_LAB) + ((size_t)dir * MT + r0) * 256 + ch;
        float h = ((const float*)(P.ws + WS_LCI))[((size_t)bc * 2 + dir) * 256 + ch];
        __syncthreads();
#pragma unroll 1
        for (int ib = 0; ib < CHK; ib += 32) { uint32_t wv[32];
#pragma unroll
            for (int k = 0; k < 32; ++k) wv[k] = lab[(size_t)(dir ? CHK - 1 - (ib + k) : ib + k) * 256];
#pragma unroll
            for (int k = 0; k < 32; ++k) { const int tok = dir ? CHK - 1 - (ib + k) : ib + k; h = __builtin_amdgcn_exp2f(bflo(wv[k])) * h + bfhi(wv[k]); HL[(dir * CHK + tok) * 256 + ch] = (bf16_t)ssdk::cvtpk(h, h); } }
        __syncthreads();
#pragma unroll
        for (int kq = 0; kq < 8; ++kq) { const int piece = tid + 512 * kq; const int tok = piece >> 5, q = piece & 31;
            const v4u hf = *(const LAS v4u*)(HL + tok * 256 + 8 * q), hb = *(const LAS v4u*)(HL + (CHK + tok) * 256 + 8 * q);
            const v4u gv = *(const GAS v4u*)((const bf16_t*)(P.ws + WS_PL) + (r0 + tok) * NPL + PL_LG + 8 * q);
            v4u o; const unsigned hfw[4] = {hf.x, hf.y, hf.z, hf.w}, hbw[4] = {hb.x, hb.y, hb.z, hb.w}, gw_[4] = {gv.x, gv.y, gv.z, gv.w}; unsigned ow[4];
#pragma unroll
            for (int e = 0; e < 4; ++e) { const float g0 = bflo(gw_[e]), g1 = bfhi(gw_[e]);
                const float t0 = 0.7978845608028654f * (g0 + 0.044715f * g0 * g0 * g0), t1 = 0.7978845608028654f * (g1 + 0.044715f * g1 * g1 * g1);
                const float ge0 = g0 * frcp(1.f + __expf(-2.f * t0)), ge1 = g1 * frcp(1.f + __expf(-2.f * t1));
                ow[e] = pk2((bflo(hfw[e]) + bflo(hbw[e])) * ge0, (bfhi(hfw[e]) + bfhi(hbw[e])) * ge1); }
            o.x = ow[0]; o.y = ow[1]; o.z = ow[2]; o.w = ow[3];
            *(GAS v4u*)((bf16_t*)(P.ws + WS_XN) + (r0 + tok) * DM + MIX_B + 8 * q) = o; }
    }
}
}
__device__ __forceinline__ void bias_phase(const Params& P, LAS unsigned char* L, int tid, int vcu, int G) {
    LAS float* SH = (LAS float*)L; LAS float* RED = (LAS float*)(L + 32768); const int lane = tid & 63, wid = tid >> 6;
    for (int u = vcu; u < NL * (FF / 64); u += G) { const int l = u / (FF / 64), n0 = (u % (FF / 64)) * 64;
        __syncthreads();
        for (int i = tid; i < (NB + 1) * DM; i += 512) SH[i] = ((const float*)(P.ws + WS_MOD))[((size_t)l * (NB + 1) + i / DM) * NMOD + 3072 + (i % DM)];
        __syncthreads();
        float acc[NB + 1];
#pragma unroll
        for (int r = 0; r <= NB; ++r) acc[r] = 0.f;
        const float* wp = P.w_ffn1 + ((size_t)l * DM + 128 * wid) * FF + n0 + lane;
#pragma unroll 1
        for (int kb = 0; kb < 128; kb += 32) { float wv[32];
#pragma unroll
            for (int kx = 0; kx < 32; ++kx) wv[kx] = wp[(size_t)(kb + kx) * FF];
#pragma unroll
            for (int kx = 0; kx < 32; ++kx)
#pragma unroll
                for (int r = 0; r <= NB; ++r) acc[r] += SH[r * DM + 128 * wid + kb + kx] * wv[kx]; }
#pragma unroll
        for (int r = 0; r <= NB; ++r) RED[(wid * (NB + 1) + r) * 64 + lane] = acc[r];
        __syncthreads();
        if (tid < (NB + 1) * 64) { const int r = tid >> 6; float sv = 0.f;
#pragma unroll
            for (int w = 0; w < 8; ++w) sv += RED[(w * (NB + 1) + r) * 64 + lane];
            ((float*)(P.ws + WS_BF1))[((size_t)l * (NB + 1) + r) * FF + n0 + lane] = sv; }
    }
    __syncthreads();
}
__device__ __forceinline__ void bin_phase(const Params& P, int l, LAS unsigned char* L, int tid, int vcu, int G) {
    LAS float* SH = (LAS float*)L; LAS float* RED = (LAS float*)(L + 32768); const int lane = tid & 63, wid = tid >> 6;
    for (int u = vcu; u < NPL / 64 + 1; u += G) { const int n0 = u * 64; const int n = n0 + lane; const bool ok = n < NPL + 8; const int col = n < 1024 ? n : (n < NPL ? n + 8 : 1024 + (n - NPL));
        __syncthreads();
        for (int i = tid; i < (NB + 1) * DM; i += 512) SH[i] = ((const float*)(P.ws + WS_MOD))[((size_t)l * (NB + 1) + i / DM) * NMOD + (i % DM)];
        __syncthreads();
        float acc[NB + 1];
#pragma unroll
        for (int r = 0; r <= NB; ++r) acc[r] = 0.f;
        const float* wp = P.w_in + ((size_t)l * DM + 128 * wid) * 2568 + (ok ? col : 0);
#pragma unroll 1
        for (int kb = 0; kb < 128; kb += 32) { float wv[32];
#pragma unroll
            for (int kx = 0; kx < 32; ++kx) wv[kx] = wp[(size_t)(kb + kx) * 2568];
#pragma unroll
            for (int kx = 0; kx < 32; ++kx)
#pragma unroll
                for (int r = 0; r <= NB; ++r) acc[r] += SH[r * DM + 128 * wid + kb + kx] * wv[kx]; }
#pragma unroll
        for (int r = 0; r <= NB; ++r) RED[(wid * (NB + 1) + r) * 64 + lane] = acc[r];
        __syncthreads();
        if (tid < (NB + 1) * 64) { const int r = tid >> 6; float sv = 0.f;
#pragma unroll
            for (int w = 0; w < 8; ++w) sv += RED[(w * (NB + 1) + r) * 64 + lane];
            ((float*)(P.ws + WS_BIN))[(size_t)r * (NPL + 256) + n0 + lane] = ok ? sv : 0.f; }
    }
    __syncthreads();
}
__device__ __forceinline__ void mod_phase(const Params& P, LAS unsigned char* L, int tid, int vcu, int G) {
    LAS float* SL = (LAS float*)L; LAS float* RED = (LAS float*)(L + 32768); const int lane = tid & 63, wid = tid >> 6;
    for (int i = tid; i < (NB + 1) * DM; i += 512) { const int r = i / DM, kx = i % DM; const float cv = r < NB ? P.c[(size_t)r * DM + kx] : P.c_ctx[kx]; SL[i] = cv * frcp(1.f + __expf(-cv)); }
    __syncthreads();
    for (int u = vcu; u < NL * (NMOD / 64); u += G) { const int l = u / (NMOD / 64), n0 = (u % (NMOD / 64)) * 64;
        float acc[NB + 1];
#pragma unroll
        for (int r = 0; r <= NB; ++r) acc[r] = 0.f;
        const float* wp = P.w_mod + ((size_t)l * DM + 128 * wid) * NMOD + n0 + lane;
#pragma unroll 1
        for (int kb = 0; kb < 128; kb += 32) { float wv[32];
#pragma unroll
            for (int kx = 0; kx < 32; ++kx) wv[kx] = wp[(size_t)(kb + kx) * NMOD];
#pragma unroll
            for (int kx = 0; kx < 32; ++kx)
#pragma unroll
                for (int r = 0; r <= NB; ++r) acc[r] += SL[r * DM + 128 * wid + kb + kx] * wv[kx]; }
#pragma unroll
        for (int r = 0; r <= NB; ++r) RED[(wid * (NB + 1) + r) * 64 + lane] = acc[r];
        __syncthreads();
        if (tid < (NB + 1) * 64) { const int r = tid >> 6; float sv = P.b_mod[(size_t)l * NMOD + n0 + lane];
#pragma unroll
            for (int w = 0; w < 8; ++w) sv += RED[(w * (NB + 1) + r) * 64 + lane];
            ((float*)(P.ws + WS_MOD))[((size_t)l * (NB + 1) + r) * NMOD + n0 + lane] = sv; }
        __syncthreads();
    }
}

#endif

#ifndef STAGE_MASK
#define STAGE_MASK 0xffff
#endif
#define SM(b) if (STAGE_MASK & (1 << (b)))
#ifndef REP_MASK
#define REP_MASK 0
#endif
#ifndef ABL_SSD
#define ABL_SSD 0
#endif
#define REP(b, X) do { X; if (REP_MASK & (1 << (b))) { SYNC(); X; } } while (0)
#define FORWARD_PROGRAM() do { \
    SM(0) REP(0, RUN(0, (long)NL * (NB + 1) * NMOD, st_mod(P, it))); \
    _Pragma("unroll 1") for (int l = 0; l < NL; ++l) { \
        SM(1) REP(9, WCONV_PHASE(l)); SYNC(); \
        SM(2) REP(10, NORM_PHASE(l, 0)); SYNC(); \
        SM(3) REP(6, GEMM_INPROJ(l)); SYNC(); \
        SM(4) REP(8, PREP_PHASE(l)); SM(5) QK_PHASE(l); SM(7) REP(1, RUN(0, (long)NB * NCH * 8, st_ssd_dt(P, it, l))); SYNC(); \
        SM(6) REP(2, RUN(0, (long)MT * 256, st_lru_gate(P, it, l))); SM(8) REP(5, ATTN_PHASE(l)); SYNC(); \
        SM(6) REP(3, RUN(0, (long)NB * NCH * 512, st_lru_local(P, it))); SYNC(); \
        SM(6) REP(3, RUN(0, (long)NB * 512, st_lru_carry(P, it))); SYNC(); \
        SM(6) REP(3, RUN(0, (long)NB * NCH * 256, st_lru_final(P, it, l, 0))); SYNC(); \
        SM(6) RUN(0, (long)NB * NCH * 256, st_lru_final(P, it, l, 1)); SYNC(); \
        SM(7) REP(4, SSD_STATE_PHASE(l)); SYNC(); \
        SM(7) RUN(0, (long)NB * 65536, st_ssd_carry(P, it)); SYNC(); \
        SM(10) REP(4, SSD_OUT_PHASE(l)); SYNC(); \
        SM(11) GEMM_OUT(l); SYNC(); \
        SM(2) NORM_PHASE(l, 1); SYNC(); \
        SM(12) REP(7, GEMM_F1(l)); SYNC(); \
        SM(13) GEMM_F2(l); SYNC(); \
    } } while (0)

#ifdef CPU_EMU
#define RUN(off, n, CALL) do { const long _n = (n); _Pragma("omp parallel for schedule(dynamic, 16)") for (long it = 0; it < _n; ++it) { CALL; } } while (0)
#define SYNC() do {} while (0)
#define SSD_STATE_PHASE(l) do { RUN(0, (long)NB * NCH * 65536, st_ssd_state(P, it)); RUN(0, (long)NB * NCH * 32768, st_ssd_g(P, it)); } while (0)
#define SSD_OUT_PHASE(l) do { RUN(0, (long)NB * NCH * 32768, st_ssd_y(P, it, l)); RUN(0, MT, st_ssd_norm(P, it, l)); } while (0)
#define WCONV_PHASE(l) RUN(960, WC_R4, st_wconv(P, it, l))
#define NORM_PHASE(l, w) RUN(0, MT, st_norm(P, it, l, w))
#define PREP_PHASE(l) RUN(0, (long)MT * 1280, st_prep(P, it, l))
#define QK_PHASE(l) RUN(0, (long)MT * 12, st_qk(P, it, l))
#define ATTN_PHASE(l) do { RUN(0, (long)MT * 4, st_attn(P, it, l, 0)); RUN(0, (long)MT * 4, st_attn(P, it, l, 1)); } while (0)
#define GEMM_INPROJ(l) RUN(0, (long)(MT / 8) * (NPL / 4), st_gemm(it, (const bf16_t*)(P.ws + WS_XN), DM, (const bf16_t*)(P.ws + WS_WIN), NPL, DM, EpiPL{P}))
#define GEMM_OUT(l) RUN(0, (long)(MT / 8) * (DM / 4), st_gemm(it, (const bf16_t*)(P.ws + WS_XN), DM, (const bf16_t*)(P.ws + WS_WOUT), DM, DM, EpiOut{P, l}))
#define GEMM_F1(l) RUN(0, (long)(MT / 8) * (FF / 4), st_gemm(it, (const bf16_t*)(P.ws + WS_XN), DM, (const bf16_t*)(P.ws + WS_WF1), FF, DM, EpiF1{P}))
#define GEMM_F2(l) RUN(0, (long)(MT / 8) * (DM / 4), st_gemm(it, (const bf16_t*)(P.ws + WS_H), FF, (const bf16_t*)(P.ws + WS_WF2), DM, FF, EpiF2{P, l}))
static void forward_emu(const Params& P) { FORWARD_PROGRAM(); }
#else
typedef const __attribute__((address_space(4))) unsigned long long* karg_u64p;
__device__ __forceinline__ Params load_params(const __attribute__((address_space(4))) Params* kp) { Params P; const karg_u64p q = (karg_u64p)kp;
    P.x = (const float*)(GAS const float*)q[0];    P.c = (const float*)(GAS const float*)q[1];    P.ctx = (const float*)(GAS const float*)q[2];    P.c_ctx = (const float*)(GAS const float*)q[3];    P.w_mod = (const float*)(GAS const float*)q[4];    P.b_mod = (const float*)(GAS const float*)q[5];
    P.g_mix = (const float*)(GAS const float*)q[6];    P.w_in = (const float*)(GAS const float*)q[7];    P.ssd_conv_w = (const float*)(GAS const float*)q[8];    P.ssd_conv_b = (const float*)(GAS const float*)q[9];    P.ssd_a_log = (const float*)(GAS const float*)q[10];    P.ssd_dt_bias = (const float*)(GAS const float*)q[11];
    P.ssd_d = (const float*)(GAS const float*)q[12];    P.ssd_norm_g = (const float*)(GAS const float*)q[13];    P.lru_conv_w = (const float*)(GAS const float*)q[14];    P.lru_conv_b = (const float*)(GAS const float*)q[15];    P.lru_lambda = (const float*)(GAS const float*)q[16];    P.lru_w_a = (const float*)(GAS const float*)q[17];
    P.lru_b_a = (const float*)(GAS const float*)q[18];    P.lru_w_i = (const float*)(GAS const float*)q[19];    P.lru_b_i = (const float*)(GAS const float*)q[20];    P.gqa_q_norm = (const float*)(GAS const float*)q[21];    P.gqa_k_norm = (const float*)(GAS const float*)q[22];    P.swa_q_norm = (const float*)(GAS const float*)q[23];
    P.swa_k_norm = (const float*)(GAS const float*)q[24];    P.swa_sink = (const float*)(GAS const float*)q[25];    P.w_out = (const float*)(GAS const float*)q[26];    P.g_ffn = (const float*)(GAS const float*)q[27];    P.w_ffn1 = (const float*)(GAS const float*)q[28];    P.w_ffn2 = (const float*)(GAS const float*)q[29];

    P.out = (float*)(GAS float*)q[30]; P.ws = (unsigned char*)(GAS unsigned char*)q[31];
    return P; }
constexpr int NTHREADS = 512;
constexpr int RING_BYTES = 131072, LDSCTL_OFF = RING_BYTES, MISC_OFF = LDSCTL_OFF + 320, LDS_BYTES = 147456;
constexpr int CW_BAR = 4096;
constexpr size_t CTL_ZERO_BYTES = 64 * 1024;
#define PHASE_LOCALS const __attribute__((address_space(4))) Params* kp_ = (const __attribute__((address_space(4))) Params*)__builtin_amdgcn_kernarg_segment_ptr(); asm volatile("" : "+s"(kp_)); \
    const Params P = load_params(kp_);     \
    const int tid_ = tid_from_wave(wave_s); \
    const int lane = tid_ & 63, wave = tid_ >> 6; const int G = (int)gridDim.x; int bx_ = (int)blockIdx.x; asm volatile("" : "+s"(bx_)); const int gw = wave * G + bx_, NGW = 8 * G; (void)lane; (void)gw; (void)NGW;
#define RUN(off, n, CALL) do { PHASE_LOCALS const int _n = (int)(n); for (int _iw = gw; _iw * 64 < _n; _iw += NGW) { const long it = _iw * 64 + lane; if (it < _n) { CALL; } } } while (0)
#ifndef PROF_A
#define PROF_A (-1)
#endif
#ifndef PROF_B
#define PROF_B (-1)
#endif
#define SYNC() do { xcd_barrier(bar, wave_s); if (PROF_A >= 0 && blockIdx.x == 0 && tid_from_wave(wave_s) == 0) { LAS unsigned long long* ts_ = (LAS unsigned long long*)(L + LDSCTL_OFF); const unsigned n_ = (unsigned)ts_[39]; if (n_ < 38) ts_[n_] = __builtin_amdgcn_s_memrealtime(); ts_[39] = n_ + 1; } } while (0)
#define VCU_ ((G % 8 == 0) ? (bx_ % 8) * (G / 8) + bx_ / 8 : bx_)
#define PREP_PHASE(l) do { PHASE_LOCALS prep_phase(P, (l), L, tid_, (G % 8 == 0) ? (bx_ % 8) * (G / 8) + bx_ / 8 : bx_, G); } while (0)
#define QK_PHASE(l) do { PHASE_LOCALS qk_phase(P, (l), lane, gw, NGW); } while (0)
#define ATTN_PHASE(l) do { PHASE_LOCALS attention_phase(P, (l), (char*)lds, G, bx_, wave_s); } while (0)
#define GEMM_INPROJ(l) do { PHASE_LOCALS pg8::Gemm g{(const pg8::bf16_t*)(P.ws + WS_XN), (const pg8::bf16_t*)(P.ws + WS_WIN), MT, NPL + 256, DM, DM}; pg8::RowOrder S; S.init(NPL + 256, G, bx_, 0); \
    pg8::EpiBf16A<0> E{(pg8::bf16_t*)(P.ws + WS_PL), NPL, (l) > 0 ? (const float*)(P.ws + WS_RS1) : nullptr, (const float*)(P.ws + WS_BIN), (float*)(P.ws + WS_DTP), NPL + 256};     pg8::gemm_phase<pg8::EpiBf16A<0>, pg8::RowOrder, true, true>(L, g, S, E, wave_s); } while (0)
#define GEMM_F1(l) do { PHASE_LOCALS pg8::Gemm g{(const pg8::bf16_t*)(P.ws + ws_xa2(l)), (const pg8::bf16_t*)(P.ws + WS_WF1), MT, FF, DM, DM}; pg8::RowOrder S; S.init(FF, G, bx_, (l) == NL - 1 ? 1 : 0); \
    pg8::EpiBf16A<2> E{(pg8::bf16_t*)(P.ws + ws_h(l)), FF, (const float*)(P.ws + WS_RS2), (const float*)(P.ws + WS_BF1) + (size_t)(l) * (NB + 1) * FF, nullptr, FF}; pg8::gemm_phase<pg8::EpiBf16A<2>, pg8::RowOrder, true, true>(L, g, S, E, wave_s); } while (0)
#define GEMM_RESID(l, which) do { PHASE_LOCALS const int KF = (which) ? FF : DM; const int npass = (l) == NL - 1 ? 1 : 2; \
    _Pragma("unroll 1") for (int pass = 0; pass < npass; ++pass) { \
        pg8::Gemm g{(const pg8::bf16_t*)(P.ws + ((which) ? ws_h(l) : WS_XN)), (const pg8::bf16_t*)(P.ws + ((which) ? WS_WF2 : WS_WOUT)), MT, DM, pass ? KF / pg8::RowOrder::KSPLIT : KF, KF}; \
        pg8::RowOrder S; S.init(DM, G, bx_, pass ? 2 : 1, KF / pg8::RowOrder::KSPLIT); \
        void* x1b_ = (l) == NL - 1 ? (void*)(P.ws + WS_X1L) : (void*)P.out;     \
        pg8::EpiResid E{(which) ? (const void*)x1b_ : ((l) == 0 ? (const void*)P.x : (const void*)P.out), (which) ? (void*)P.out : x1b_, ((which) || (l) > 0) ? 1 : 0, ((which) && (l) == NL - 1) ? 0 : 1, (const float*)(P.ws + WS_MOD) + (size_t)(l) * (NB + 1) * NMOD, (which) ? 5120 : 2048, pass ? KF / pg8::RowOrder::KSPLIT : 0, (float*)(P.ws + WS_SLAB), \
            (which) == 0 ? (pg8::bf16_t*)(P.ws + ws_xa2(l)) : ((l) + 1 < NL ? (pg8::bf16_t*)(P.ws + WS_XN) : nullptr), (which) == 0 ? P.g_ffn + (size_t)(l) * DM : P.g_mix + (size_t)((l) + 1 < NL ? (l) + 1 : (l)) * DM, \
            (const float*)(P.ws + WS_MOD) + (size_t)((which) == 0 ? (l) : ((l) + 1 < NL ? (l) + 1 : (l))) * (NB + 1) * NMOD, (which) == 0 ? 4096 : 1024, (float*)(P.ws + ((which) == 0 ? WS_RS2 : WS_RS1))};     \
        pg8::gemm_phase<pg8::EpiResid, pg8::RowOrder, true, true>(L, g, S, E, wave_s); } } while (0)
#define GEMM_OUT(l) GEMM_RESID(l, 0)
#define GEMM_F2(l) GEMM_RESID(l, 1)

#define M1_PHASE(l) do { PHASE_LOCALS const int vcu = VCU_; constexpr int NIT_ = NB * NCH * 8; \
      \
    const int NC1_ = 8 * G - NIT_ <= 0 ? 0 : (8 * G - NIT_ < 4 * G ? 8 * G - NIT_ : 4 * G), NX_ = 4 * G - NC1_, N2_ = 8 * G - NC1_; \
    const int t_ = wave_s * G + vcu; const bool c2_ = wave_s >= 4 || t_ < NX_; const int s2_ = wave_s >= 4 ? (wave_s - 4) * G + vcu : 4 * G + t_; \
    if (c2_) { _Pragma("unroll 1") for (int i_ = s2_; i_ < NIT_; i_ += N2_) { const int ti_ = tid_from_wave(wave_s); ssdk::ssd_state_item(P, (l), L, ti_, i_ >> 3, (i_ >> 1) & 3, i_ & 1); } } \
    { int h_, he_, hs_;        \
        if (!c2_) { const int u_ = t_ - NX_; h_ = 2 * u_; he_ = u_ < NIT_ ? 2 * u_ + 2 : 0; hs_ = 1; } \
        else { h_ = 2 * NC1_ + s2_; he_ = 2 * NIT_; hs_ = N2_; } \
        _Pragma("unroll 1") for (; h_ < he_; h_ += hs_) { const int ti_ = tid_from_wave(wave_s); const int u_ = h_ >> 1; lruk::lru_gate_half(P, (l), ti_, u_ >> 3, (u_ >> 1) & 3, u_ & 1, h_ & 1); } } \
    __syncthreads(); attention_phase(P, (l), (char*)lds, G, bx_, wave_s); if (REP_MASK & 4096) attention_phase(P, (l), (char*)lds, G, bx_, wave_s); } while (0)
#define M2_PHASE(l) do { RUN(0, (long)NB * 65536, st_ssd_carry(P, it)); RUN(0, (long)NB * 512, st_lru_carry(P, it)); } while (0)
#define M3_PHASE(l) do { PHASE_LOCALS const int vcu = VCU_; \
    if (REP_MASK & 256) { ssdk::ssd_out_phase<ABL_SSD>(P, (l), L, wave_s, vcu, G); __syncthreads(); } ssdk::ssd_out_phase<0>(P, (l), L, wave_s, vcu, G); \
      \
    { const int ntile_ = (l) == NL - 1 ? NB * (NCH - NCC) * 4 : NB * NCH * 4; const int flo_ = ntile_ > 2 * G ? (ntile_ - 2 * G + 1) / 2 : 0, fhi_ = G - NB * NCH; const int parts_ = (l) == 0 ? 14 : 8; \
      if (fhi_ > flo_) { if (vcu >= flo_ && vcu < fhi_) { __syncthreads(); wconv_phase(P, (l), parts_, L, wave, lane, wave * (fhi_ - flo_) + (vcu - flo_), 8 * (fhi_ - flo_)); } } \
      else { __syncthreads(); wconv_phase(P, (l), parts_, L, wave, lane, gw, NGW); } } \
    lruk::lru_final_phase(P, L, tid_, G - 1 - vcu, G, (l) == NL - 1); if (REP_MASK & 512) { __syncthreads(); lruk::lru_final_phase(P, L, tid_, G - 1 - vcu, G, (l) == NL - 1); } } while (0)
#define FREE_LOCALS const int fo_ = G > 64 ? 64 : 0, nf_ = G - fo_;
#define GPU_PROGRAM() do { \
    REP(0, { PHASE_LOCALS mod_phase(P, L, tid_, VCU_, G); wconv_phase(P, 0, 17, L, wave, lane, gw, NGW); \
        for (int i = gw * 64 + lane; i < NB * CTX * DM / 4; i += NGW * 64) ((f32x4*)(P.ws + WS_XRC))[i] = ((const f32x4*)P.ctx)[i]; }); SYNC(); \
    _Pragma("unroll 1") for (int l = 0; l < NL; ++l) { \
          \
        if (l == 0) { PHASE_LOCALS norm1_phase(P, l, 0, L, tid_, lane, gw, NGW); } \
        else { PHASE_LOCALS norm_phase(P, l, 0, 1, 1, lane, gw, NGW); } \
        SYNC(); \
        REP(2, GEMM_INPROJ(l)); SYNC(); \
        REP(3, { PREP_PHASE(l); }); QK_PHASE(l); SYNC(); \
        REP(4, M1_PHASE(l)); SYNC(); \
        M2_PHASE(l); SYNC(); \
        REP(5, M3_PHASE(l)); SYNC(); \
          \
        GEMM_OUT(l); if (l == 0 && l + 1 < NL) { PHASE_LOCALS FREE_LOCALS if (bx_ >= fo_) { __syncthreads(); bias_phase(P, L, tid_, bx_ - fo_, nf_); } } else if (l == 0) { PHASE_LOCALS bias_phase(P, L, tid_, VCU_, G); } SYNC(); \
        if (l + 1 < NL) { { PHASE_LOCALS norm_phase(P, l, 1, 1, 1, lane, gw, NGW); } SYNC(); }     \
        REP(7, GEMM_F1(l)); if (l + 1 < NL) { PHASE_LOCALS FREE_LOCALS if (bx_ >= fo_) { __syncthreads(); wconv_phase(P, l + 1, 19, L, wave, lane, wave * nf_ + (bx_ - fo_), 8 * nf_); __syncthreads(); bin_phase(P, l + 1, L, tid_, nf_ - 1 - (bx_ - fo_), nf_); } } SYNC(); \
        GEMM_F2(l); if (l + 1 < NL) { { PHASE_LOCALS FREE_LOCALS if (bx_ >= fo_) { __syncthreads(); wconv_phase(P, l + 1, 4, L, wave, lane, wave * nf_ + (bx_ - fo_), 8 * nf_); } } SYNC(); } \
    } } while (0)

__global__ void __launch_bounds__(NTHREADS, 2) fwd_kernel(Params P0) {
    extern __shared__ __attribute__((aligned(16))) unsigned char lds[];
    LAS unsigned char* L = (LAS unsigned char*)lds;
    const int wave_s = __builtin_amdgcn_readfirstlane((int)(threadIdx.x >> 6));
    for (int u = threadIdx.x; u < (LDS_BYTES - LDSCTL_OFF) / 4; u += NTHREADS) ((LAS unsigned*)(L + LDSCTL_OFF))[u] = 0u;
    __syncthreads();
    XcdBarrier bar = xcd_barrier_post((unsigned*)(P0.ws + WS_CTL) + CW_BAR, (volatile LAS unsigned*)(L + MISC_OFF) + 8);
    GPU_PROGRAM();
    if (PROF_A >= 0) {
        SYNC();
        if (blockIdx.x == 0) { LAS unsigned long long* ts_ = (LAS unsigned long long*)(L + LDSCTL_OFF); __syncthreads();
            const float ta = (float)(ts_[PROF_A + 1] - ts_[PROF_A]) * 0.01f, tb = (float)(ts_[(PROF_B < 0 ? PROF_A : PROF_B) + 1] - ts_[PROF_B < 0 ? PROF_A : PROF_B]) * 0.01f;
            const int t = tid_from_wave(wave_s);
            if (t == 0) P0.out[0] += ta;
            for (int i = t; i < (1 << 20); i += NTHREADS) P0.out[4096 + i] += tb * 0.001f; } }
}

extern "C" void kernel_launch(void* const* d_in, const int* in_sizes, int n_in, void* d_out, int out_size, void* d_ws, size_t ws_size, hipStream_t stream) {
    static int grid_blocks = 0;
    if (!grid_blocks) {
        int dev = 0, cus = 0, per_cu = 0;
        (void)hipGetDevice(&dev); (void)hipDeviceGetAttribute(&cus, hipDeviceAttributeMultiprocessorCount, dev);
        (void)hipFuncSetAttribute((const void*)fwd_kernel, hipFuncAttributeMaxDynamicSharedMemorySize, LDS_BYTES);
        (void)hipOccupancyMaxActiveBlocksPerMultiprocessor(&per_cu, fwd_kernel, NTHREADS, LDS_BYTES);
        if (per_cu < 1) { fprintf(stderr, "kernel_launch: occupancy query reports %d blocks per CU\n", per_cu); per_cu = 1; }
        grid_blocks = cus;
        if (n_in != 30 || out_size != NB * SEQ * DM || ws_size < WS_END) fprintf(stderr, "kernel_launch: unexpected shapes n_in %d out %d ws %zu\n", n_in, out_size, ws_size);
    }
    (void)hipMemsetAsync((char*)d_ws + WS_CTL, 0, CTL_ZERO_BYTES, stream);
    Params p{};
    const float** pp = (const float**)&p;
    for (int i = 0; i < 30; ++i) pp[i] = (const float*)d_in[i];
    p.out = (float*)d_out; p.ws = (unsigned char*)d_ws;
    void* args[] = {&p};
    hipError_t e = hipLaunchCooperativeKernel((void*)fwd_kernel, dim3(grid_blocks), dim3(NTHREADS), args, LDS_BYTES, stream);
    if (e != hipSuccess) fprintf(stderr, "cooperative launch failed: %s (grid %d)\n", hipGetErrorString(e), grid_blocks);
}
#endif
```

```cpp
#ifndef CPU_EMU
#include <hip/hip_runtime.h>
#include <hip/hip_cooperative_groups.h>
#include <cstdio>
namespace cg = cooperative_groups;
#define DEV __device__ __forceinline__
#define DEVM __device__ __forceinline__
#else
#define DEV static inline
#define DEVM inline
#endif
#include <stdint.h>
#include <stddef.h>
#include <math.h>
#include <string.h>

#ifndef CFG_BATCH
#define CFG_BATCH 4
#endif
#ifndef CFG_SEQ
#define CFG_SEQ 4096
#endif
constexpr int NB = CFG_BATCH, SEQ = CFG_SEQ, CTX = 256, DM = 1024, SB = CTX + SEQ, MT = NB * SB;
constexpr int NPL = 2560, FF = 4096, NMOD = 6144, NL = 2, GRIDW = 64;
constexpr int CHK = 128, NCH = SB / CHK, NCC = CTX / CHK;
constexpr float EPS = 1e-6f, LOG2E = 1.4426950408889634f, QSCALE = 0.125f * 1.4426950408889634f;
constexpr int PL_Z = 0, PL_XBC = 256, PL_LG = 1024, PL_LX = 1280, PL_C = 1536, PL_D = 2048;
constexpr int MIX_A = 0, MIX_B = 256, MIX_C = 512, MIX_D = 768;
constexpr size_t MiB = 1u << 20;
constexpr size_t WS_CTL = 0, WS_MOD = 1 * MiB, WS_WDT = WS_MOD + 256 * 1024, WS_WIN = 1 * MiB + 512 * 1024, WS_WOUT = 7 * MiB, WS_WF1 = 9 * MiB, WS_WF2 = 17 * MiB, WS_XRC = 25 * MiB, WS_DTP = 29 * MiB;
constexpr size_t WS_LWT = WS_CTL + 576 * 1024;
constexpr size_t WS_XN = 30 * MiB;
constexpr size_t WS_B = 64 * MiB;
constexpr size_t WS_PL = WS_B, WS_XBC = 149 * MiB, WS_TAIL = 243 * MiB, WS_END = 256 * MiB;
constexpr size_t WS_XA2 = WS_B;
constexpr size_t WS_H = 98 * MiB;
__host__ __device__ constexpr size_t ws_h(int l) { return l == NL - 1 ? 30 * MiB : WS_H; }
__host__ __device__ constexpr size_t ws_xa2(int l) { return l == NL - 1 ? 200 * MiB : WS_XA2; }
constexpr size_t WS_X1L = 166 * MiB;
constexpr size_t WS_RS1 = WS_CTL + 448 * 1024, WS_BIN = WS_CTL + 768 * 1024;
constexpr size_t WS_RS2 = WS_CTL + 128 * 1024, WS_BF1 = WS_CTL + 256 * 1024;
constexpr int XBP = 512;
constexpr size_t TR_BYTES = (size_t)MT * 256 * 2;
constexpr size_t WS_XT = 166 * MiB, WS_BT = WS_XT + TR_BYTES, WS_ZT = WS_BT + TR_BYTES;
constexpr size_t WS_SST = WS_ZT + TR_BYTES;
constexpr size_t WS_LAB = WS_SST + 2 * TR_BYTES;
constexpr size_t WS_GB = WS_LAB, WS_YG = WS_LAB + TR_BYTES;
constexpr size_t WS_XLC = WS_TAIL;
constexpr size_t WS_SLAB = 234 * MiB;
constexpr size_t WS_SC4 = WS_TAIL + 9 * MiB, WS_DEC = WS_SC4 + (size_t)MT * 64 + 65536;
constexpr size_t WS_LHE = WS_TAIL + 11 * MiB, WS_LCP = WS_LHE + 512 * 1024, WS_LCI = WS_LCP + 512 * 1024;
static_assert((size_t)MT * NPL * 2 <= WS_XBC - WS_PL && (size_t)MT * XBP * 2 <= WS_XT - WS_XBC && (size_t)MT * FF * 2 <= WS_END - WS_H && (size_t)MT * DM * 2 <= WS_B - WS_XN, "ws map");
static_assert(TR_BYTES <= 9 * MiB && WS_LAB + 4 * TR_BYTES <= WS_TAIL && WS_DEC + 65536 <= WS_LHE && (size_t)NB * NCH * 512 * 4 <= 512 * 1024 && WS_LCI + 512 * 1024 <= WS_END, "ws map 3");
static_assert((size_t)NB * CTX * DM * 4 <= WS_DTP - WS_XRC && (size_t)MT * 8 * 4 <= WS_XN - WS_DTP && (size_t)NL * (NB + 1) * NMOD * 4 <= 256 * 1024, "ws map 2");

struct Params {
    const float *x, *c, *ctx, *c_ctx, *w_mod, *b_mod, *g_mix, *w_in, *ssd_conv_w, *ssd_conv_b, *ssd_a_log, *ssd_dt_bias, *ssd_d, *ssd_norm_g, *lru_conv_w, *lru_conv_b, *lru_lambda,
        *lru_w_a, *lru_b_a, *lru_w_i, *lru_b_i, *gqa_q_norm, *gqa_k_norm, *swa_q_norm, *swa_k_norm, *swa_sink, *w_out, *g_ffn, *w_ffn1, *w_ffn2;
    float* out; unsigned char* ws;
};
typedef uint16_t bf16_t;
struct U4 { uint32_t x, y, z, w; };
struct U2 { uint32_t x, y; };

DEV float u2f(uint32_t u) { float f; memcpy(&f, &u, 4); return f; }
DEV uint32_t f2u(float f) { uint32_t u; memcpy(&u, &f, 4); return u; }
DEV float bf2f(bf16_t h) { return u2f((uint32_t)h << 16); }
DEV bf16_t f2bf(float f) { uint32_t u = f2u(f); return (bf16_t)((u + 0x7fffu + ((u >> 16) & 1u)) >> 16); }
DEV float bflo(uint32_t w) { return u2f(w << 16); }
DEV float bfhi(uint32_t w) { return u2f(w & 0xffff0000u); }
DEV float silu_f(float x) { return x / (1.f + expf(-x)); }
DEV float sigmoid_f(float x) { return 1.f / (1.f + expf(-x)); }
DEV float softplus_f(float x) { return fmaxf(x, 0.f) + log1pf(expf(-fabsf(x))); }
DEV float gelu_tanh_f(float x) { return 0.5f * x * (1.f + tanhf(0.7978845608028654f * (x + 0.044715f * x * x * x))); }

DEV float* resid_row(const Params& P, int r) { const int b = r / SB, s = r % SB; return s < CTX ? (float*)(P.ws + WS_XRC) + ((size_t)b * CTX + s) * DM : P.out + ((size_t)b * SEQ + (s - CTX)) * DM; }
DEV const float* xin_row(const Params& P, int l, int r) { const int b = r / SB, s = r % SB; if (l == 0) return s < CTX ? P.ctx + ((size_t)b * CTX + s) * DM : P.x + ((size_t)b * SEQ + (s - CTX)) * DM; return resid_row(P, r); }
DEV const float* mod_row(const Params& P, int l, int r) { const int b = r / SB, s = r % SB; const int bm = s < CTX ? NB : b; return (const float*)(P.ws + WS_MOD) + ((size_t)l * (NB + 1) + bm) * NMOD; }
DEV int chunk_at(int dir, int k) { return dir == 0 ? k : (k < NCC ? NCC - 1 - k : NCH - 1 - (k - NCC)); }
DEV int scan_pos(int dir, int step) { return dir == 0 ? step : (step < CTX ? CTX - 1 - step : SB - 1 - (step - CTX)); }

DEV void st_mod(const Params& P, long it) {
    const int n = (int)(it % NMOD); const int rb = (int)(it / NMOD); const int bm = rb % (NB + 1), l = rb / (NB + 1);
    const float* cv = bm < NB ? P.c + (size_t)bm * DM : P.c_ctx;
    float acc = P.b_mod[(size_t)l * NMOD + n];
    for (int k = 0; k < DM; ++k) acc += silu_f(cv[k]) * P.w_mod[((size_t)l * DM + k) * NMOD + n];
    ((float*)(P.ws + WS_MOD))[it] = acc;
}
constexpr long WC_R0 = (long)NPL * DM, WC_R1 = WC_R0 + 8 * DM, WC_R2 = WC_R1 + (long)DM * DM, WC_R3 = WC_R2 + (long)FF * DM, WC_R4 = WC_R3 + (long)DM * FF;
DEV void st_wconv(const Params& P, long it, int l) {
    if (it < WC_R0) { const int n = (int)(it / DM), k = (int)(it % DM); const int no = n < 1024 ? n : n + 8; ((bf16_t*)(P.ws + WS_WIN))[it] = f2bf(P.w_in[((size_t)l * DM + k) * 2568 + no]); return; }
    if (it < WC_R1) { const long i = it - WC_R0; const int j = (int)(i / DM), k = (int)(i % DM); ((float*)(P.ws + WS_WDT))[i] = P.w_in[((size_t)l * DM + k) * 2568 + 1024 + j]; return; }
    if (it < WC_R2) { const long i = it - WC_R1; const int n = (int)(i / DM), k = (int)(i % DM); ((bf16_t*)(P.ws + WS_WOUT))[i] = f2bf(P.w_out[((size_t)l * DM + k) * DM + n]); return; }
    if (it < WC_R3) { const long i = it - WC_R2; const int n = (int)(i / DM), k = (int)(i % DM); ((bf16_t*)(P.ws + WS_WF1))[i] = f2bf(P.w_ffn1[((size_t)l * DM + k) * FF + n]); return; }
    { const long i = it - WC_R3; const int n = (int)(i / FF), k = (int)(i % FF); ((bf16_t*)(P.ws + WS_WF2))[i] = f2bf(P.w_ffn2[((size_t)l * FF + k) * DM + n]); }
}
DEV void st_norm(const Params& P, long it, int l, int which) {
    const int r = (int)it; const float* xr = which == 0 ? xin_row(P, l, r) : resid_row(P, r); const float* md = mod_row(P, l, r);
    const float* g = (which == 0 ? P.g_mix : P.g_ffn) + (size_t)l * DM; const float* sh = md + (which == 0 ? 0 : 3072); const float* sc = sh + 1024;
    float ss = 0.f; for (int k = 0; k < DM; ++k) ss += xr[k] * xr[k];
    const float rs = 1.0f / sqrtf(ss * (1.0f / DM) + EPS);
    bf16_t* o = (bf16_t*)(P.ws + WS_XN) + (size_t)r * DM; const float* wdt = (const float*)(P.ws + WS_WDT);
    float dt[8]; for (int j = 0; j < 8; ++j) dt[j] = 0.f;
    for (int k = 0; k < DM; ++k) { const float v = (xr[k] * rs * g[k]) * (1.f + sc[k]) + sh[k]; o[k] = f2bf(v);
        if (which == 0) { for (int j = 0; j < 8; ++j) dt[j] += v * wdt[j * DM + k]; } }
    if (which == 0) { float* d = (float*)(P.ws + WS_DTP) + (size_t)r * 8; for (int j = 0; j < 8; ++j) d[j] = dt[j]; }
}
template <class Epi> DEV void st_gemm(long it, const bf16_t* A, int lda, const bf16_t* Bt, int N, int K, const Epi& E) {
    const int ntn = N / 4; const int r0 = (int)(it / ntn) * 8, n0 = (int)(it % ntn) * 4;
    float acc[8][4];
#pragma unroll
    for (int i = 0; i < 8; ++i)
#pragma unroll
        for (int j = 0; j < 4; ++j) acc[i][j] = 0.f;
#pragma unroll 1
    for (int k = 0; k < K; k += 4) {
        U2 a[8], b[4];
#pragma unroll
        for (int i = 0; i < 8; ++i) a[i] = *(const U2*)(A + (size_t)(r0 + i) * lda + k);
#pragma unroll
        for (int j = 0; j < 4; ++j) b[j] = *(const U2*)(Bt + (size_t)(n0 + j) * K + k);
#pragma unroll
        for (int kk = 0; kk < 2; ++kk) {
            float al[8], ah[8], bl[4], bh[4];
#pragma unroll
            for (int i = 0; i < 8; ++i) { const uint32_t wa = kk == 0 ? a[i].x : a[i].y; al[i] = bflo(wa); ah[i] = bfhi(wa); }
#pragma unroll
            for (int j = 0; j < 4; ++j) { const uint32_t wb = kk == 0 ? b[j].x : b[j].y; bl[j] = bflo(wb); bh[j] = bfhi(wb); }
#pragma unroll
            for (int i = 0; i < 8; ++i)
#pragma unroll
                for (int j = 0; j < 4; ++j) acc[i][j] += al[i] * bl[j] + ah[i] * bh[j];
        }
    }
    E(r0, n0, acc);
}
struct EpiPL { const Params& P; DEVM void operator()(int r0, int n0, const float (&acc)[8][4]) const { bf16_t* pl = (bf16_t*)(P.ws + WS_PL);
#pragma unroll
    for (int i = 0; i < 8; ++i)
#pragma unroll
        for (int j = 0; j < 4; ++j) pl[(size_t)(r0 + i) * NPL + n0 + j] = f2bf(acc[i][j]); } };
struct EpiOut { const Params& P; int l; DEVM void operator()(int r0, int n0, const float (&acc)[8][4]) const {
#pragma unroll
    for (int i = 0; i < 8; ++i) { const int r = r0 + i; const float* md = mod_row(P, l, r) + 2048; const float* xi = xin_row(P, l, r); float* xo = resid_row(P, r);
#pragma unroll
        for (int j = 0; j < 4; ++j) xo[n0 + j] = xi[n0 + j] + md[n0 + j] * acc[i][j]; } } };
struct EpiF1 { const Params& P; DEVM void operator()(int r0, int n0, const float (&acc)[8][4]) const { bf16_t* h = (bf16_t*)(P.ws + WS_H);
#pragma unroll
    for (int i = 0; i < 8; ++i)
#pragma unroll
        for (int j = 0; j < 4; ++j) { const float v = fmaxf(acc[i][j], 0.f); h[(size_t)(r0 + i) * FF + n0 + j] = f2bf(v * v); } } };
struct EpiF2 { const Params& P; int l; DEVM void operator()(int r0, int n0, const float (&acc)[8][4]) const {
#pragma unroll
    for (int i = 0; i < 8; ++i) { const int r = r0 + i; const float* md = mod_row(P, l, r) + 5120; float* xo = resid_row(P, r);
#pragma unroll
        for (int j = 0; j < 4; ++j) xo[n0 + j] = xo[n0 + j] + md[n0 + j] * acc[i][j]; } } };

DEV void st_prep(const Params& P, long it, int l) {
    const int r = (int)(it / 1280), c = (int)(it % 1280); const int b = r / SB, s = r % SB; const int lo = s < CTX ? 0 : CTX, hi = s < CTX ? CTX : SB;
    const bf16_t* pl = (const bf16_t*)(P.ws + WS_PL); const size_t tro = ((size_t)(b * NCH + s / CHK) * 256) * CHK + (s % CHK);
    if (c < 768) { float acc = P.ssd_conv_b[l * 768 + c];
        for (int t = 0; t < 4; ++t) { const int ss = s + t - 2; if (ss >= lo && ss < hi) acc += P.ssd_conv_w[(l * 4 + t) * 768 + c] * bf2f(pl[(size_t)(b * SB + ss) * NPL + PL_XBC + c]); }
        const bf16_t v = f2bf(silu_f(acc)); if (c >= 256) ((bf16_t*)(P.ws + WS_XBC))[(size_t)r * XBP + c - 256] = v;
        if (c < 256) ((bf16_t*)(P.ws + WS_XT))[tro + (size_t)c * CHK] = v; else if (c < 512) ((bf16_t*)(P.ws + WS_BT))[tro + (size_t)(c - 256) * CHK] = v; }
    else if (c < 1024) { const int ch = c - 768; float acc = P.lru_conv_b[l * 256 + ch];
        for (int t = 0; t < 4; ++t) { const int ss = s + t - 2; if (ss >= lo && ss < hi) acc += P.lru_conv_w[(l * 4 + t) * 256 + ch] * bf2f(pl[(size_t)(b * SB + ss) * NPL + PL_LX + ch]); }
        ((bf16_t*)(P.ws + WS_XLC))[(size_t)r * 256 + ch] = f2bf(acc); }
    else { const int ch = c - 1024; ((bf16_t*)(P.ws + WS_ZT))[tro + (size_t)ch * CHK] = pl[(size_t)r * NPL + PL_Z + ch]; }
}
DEV void st_qk(const Params& P, long it, int l) {
    const int r = (int)(it / 12), slot = (int)(it % 12); const int t = slot / 6, hs = slot % 6; const int s = r % SB;
    const int col = (t ? PL_D : PL_C) + (hs < 4 ? hs * 64 : 256 + (hs - 4) * 64);
    const float *g0 = P.gqa_q_norm, *g1 = P.swa_q_norm, *g2 = P.gqa_k_norm, *g3 = P.swa_k_norm;
#ifndef CPU_EMU
    asm volatile("" : "+s"(g0), "+s"(g1), "+s"(g2), "+s"(g3));
#endif
    const float* g = (hs < 4 ? (t ? g1 : g0) : (t ? g3 : g2)) + l * 64;
    bf16_t* p = (bf16_t*)(P.ws + WS_PL) + (size_t)r * NPL + col;
    float ss = 0.f;
    for (int d = 0; d < 64; ++d) { const float v = bf2f(p[d]); ss += v * v; }
    const float rs = 1.0f / sqrtf(ss * (1.0f / 64) + EPS); const float qs = hs < 4 ? QSCALE : 1.f;
    const bool lat = s >= CTX; const int pos = s - CTX; const float pr = (float)(pos / GRIDW), pc = (float)(pos % GRIDW);
#pragma unroll 1
    for (int pi = 0; pi < 32; ++pi) { const int a = pi >> 4, i = pi & 15; const int d1 = a * 32 + i, d2 = d1 + 16;
        const float x1 = bf2f(p[d1]) * rs * g[d1], x2 = bf2f(p[d2]) * rs * g[d2]; float cs = 1.f, sn = 0.f;
        if (lat) { const float inv = expf(-(float)i * (9.210340371976184f / 16.f)); const float ang = (a ? pc : pr) * inv; cs = cosf(ang); sn = sinf(ang); }
        p[d1] = f2bf((x1 * cs - x2 * sn) * qs); p[d2] = f2bf((x2 * cs + x1 * sn) * qs); }
}
DEV void st_lru_gate(const Params& P, long it, int l) {
    const int r = (int)(it >> 8), ch = (int)(it & 255); const int k = ch >> 6, j = ch & 63;
    const bf16_t* xr = (const bf16_t*)(P.ws + WS_XLC) + (size_t)r * 256 + k * 64; uint32_t* lab = (uint32_t*)(P.ws + WS_LAB);
    for (int dir = 0; dir < 2; ++dir) {
        const float* wa = P.lru_w_a + ((((size_t)l * 2 + dir) * 4 + k) * 64) * 64 + j; const float* wi = P.lru_w_i + ((((size_t)l * 2 + dir) * 4 + k) * 64) * 64 + j;
        float da = P.lru_b_a[(l * 2 + dir) * 256 + ch], di = P.lru_b_i[(l * 2 + dir) * 256 + ch];
        for (int i = 0; i < 64; ++i) { const float xv = bf2f(xr[i]); da += xv * wa[i * 64]; di += xv * wi[i * 64]; }
        const float sp = softplus_f(-P.lru_lambda[(l * 2 + dir) * 256 + ch]);
        const float la = -8.0f * sigmoid_f(da) * sp; const float bb = sqrtf(-expm1f(2.f * la)) * (sigmoid_f(di) * bf2f(xr[j]));
        lab[((size_t)dir * MT + r) * 256 + ch] = (uint32_t)f2bf(la * LOG2E) | ((uint32_t)f2bf(bb) << 16); }
}
DEV void st_lru_local(const Params& P, long it) {
    const int ch = (int)(it & 255), dir = (int)((it >> 8) & 1); const int bc = (int)(it >> 9); const int c = bc % NCH, b = bc / NCH;
    const uint32_t* lab = (const uint32_t*)(P.ws + WS_LAB) + ((size_t)dir * MT + (size_t)b * SB + c * CHK) * 256 + ch;
    float h = 0.f, cp = 1.f;
#pragma unroll 16
    for (int i = 0; i < CHK; ++i) { const uint32_t w = lab[(size_t)(dir ? CHK - 1 - i : i) * 256]; const float a = exp2f(bflo(w)); h = a * h + bfhi(w); cp *= a; }
    ((float*)(P.ws + WS_LHE))[it] = h; ((float*)(P.ws + WS_LCP))[it] = cp;
}
DEV void st_lru_carry(const Params& P, long it) {
    const int ch = (int)(it & 255), dir = (int)((it >> 8) & 1), b = (int)(it >> 9);
    const float* he = (const float*)(P.ws + WS_LHE); const float* cpv = (const float*)(P.ws + WS_LCP); float* ci = (float*)(P.ws + WS_LCI);
    float hv[NCH], cv[NCH];
#pragma unroll
    for (int k = 0; k < NCH; ++k) { const size_t idx = (((size_t)b * NCH + chunk_at(dir, k)) * 2 + dir) * 256 + ch; hv[k] = he[idx]; cv[k] = cpv[idx]; }
    float carry = 0.f;
#pragma unroll
    for (int k = 0; k < NCH; ++k) { const size_t idx = (((size_t)b * NCH + chunk_at(dir, k)) * 2 + dir) * 256 + ch; ci[idx] = carry; carry = carry * cv[k] + hv[k]; }
}
DEV void st_lru_final(const Params& P, long it, int l, int dir) {
    const int ch = (int)(it & 255); const int bc = (int)(it >> 8); const int c = bc % NCH, b = bc / NCH; const size_t r0 = (size_t)b * SB + c * CHK;
    const uint32_t* lab = (const uint32_t*)(P.ws + WS_LAB) + ((size_t)dir * MT + r0) * 256 + ch;
    bf16_t* mix = (bf16_t*)(P.ws + WS_XN) + r0 * DM + MIX_B + ch; const bf16_t* pl = (const bf16_t*)(P.ws + WS_PL) + r0 * NPL + PL_LG + ch;
    float h = ((const float*)(P.ws + WS_LCI))[(((size_t)b * NCH + c) * 2 + dir) * 256 + ch];
#pragma unroll 8
    for (int i = 0; i < CHK; ++i) { const int ii = dir ? CHK - 1 - i : i; const uint32_t w = lab[(size_t)ii * 256]; h = exp2f(bflo(w)) * h + bfhi(w);
        if (dir == 0) mix[(size_t)ii * DM] = f2bf(h);
        else mix[(size_t)ii * DM] = f2bf((bf2f(mix[(size_t)ii * DM]) + h) * gelu_tanh_f(bf2f(pl[(size_t)ii * NPL]))); }
}
DEV void st_ssd_dt(const Params& P, long it, int l) {
    const int dir = (int)(it & 1), hd = (int)((it >> 1) & 3); const int bc = (int)(it >> 3);
    const float a2 = -expf(P.ssd_a_log[(l * 2 + dir) * 4 + hd]) * LOG2E, dtb = P.ssd_dt_bias[(l * 2 + dir) * 4 + hd];
    const float* dtp = (const float*)(P.ws + WS_DTP); float* sc4 = (float*)(P.ws + WS_SC4);
    float acc = 0.f;
    for (int k = 0; k < CHK; ++k) { const size_t r = (size_t)bc * CHK + (dir ? CHK - 1 - k : k); const float dt = softplus_f(dtp[r * 8 + dir * 4 + hd] + dtb); acc += dt * a2;
        sc4[(r * 4 + hd) * 4 + dir * 2] = acc; sc4[(r * 4 + hd) * 4 + dir * 2 + 1] = dt; }
    ((float*)(P.ws + WS_DEC))[it] = exp2f(acc);
}
DEV void st_ssd_state(const Params& P, long it) {
    const int n = (int)(it & 127), p = (int)((it >> 7) & 63), dir = (int)((it >> 13) & 1), hd = (int)((it >> 14) & 3); const int bc = (int)(it >> 16);
    const float* sc4 = (const float*)(P.ws + WS_SC4); const size_t r0 = (size_t)bc * CHK;
    const bf16_t* xt = (const bf16_t*)(P.ws + WS_XT) + ((size_t)bc * 256 + hd * 64 + p) * CHK; const bf16_t* bt = (const bf16_t*)(P.ws + WS_BT) + ((size_t)bc * 256 + (hd >> 1) * 128 + n) * CHK;
    const float aend = sc4[((r0 + (dir ? 0 : CHK - 1)) * 4 + hd) * 4 + dir * 2];
    float acc = 0.f;
    for (int j = 0; j < CHK; ++j) { const float* sj = sc4 + ((r0 + j) * 4 + hd) * 4 + dir * 2; acc += exp2f(aend - sj[0]) * sj[1] * bf2f(xt[j]) * bf2f(bt[j]); }
    ((bf16_t*)(P.ws + WS_SST))[it] = f2bf(acc);
}
DEV void st_ssd_carry(const Params& P, long it) {
    const int pn = (int)(it & 8191), dir = (int)((it >> 13) & 1), hd = (int)((it >> 14) & 3), b = (int)(it >> 16);
    bf16_t* sst = (bf16_t*)(P.ws + WS_SST); const float* dec = (const float*)(P.ws + WS_DEC);
    bf16_t sv[NCH]; float dv[NCH];
#pragma unroll
    for (int k = 0; k < NCH; ++k) { const size_t cd = (((size_t)b * NCH + chunk_at(dir, k)) * 4 + hd) * 2 + dir; sv[k] = sst[cd * 8192 + pn]; dv[k] = dec[cd]; }
    float run = 0.f;
#pragma unroll
    for (int k = 0; k < NCH; ++k) { const size_t cd = (((size_t)b * NCH + chunk_at(dir, k)) * 4 + hd) * 2 + dir; sst[cd * 8192 + pn] = f2bf(run); run = run * dv[k] + bf2f(sv[k]); }
}
DEV void st_ssd_g(const Params& P, long it) {
    const int j = (int)(it & 127), i = (int)((it >> 7) & 127), g = (int)((it >> 14) & 1); const int bc = (int)(it >> 15);
    const bf16_t* xbc = (const bf16_t*)(P.ws + WS_XBC); const bf16_t* cp = xbc + ((size_t)bc * CHK + i) * XBP + 256 + g * 128; const bf16_t* bp = xbc + ((size_t)bc * CHK + j) * XBP + g * 128;
    float acc = 0.f;
    for (int n8 = 0; n8 < 16; ++n8) { const U4 cw = *(const U4*)(cp + n8 * 8), bw = *(const U4*)(bp + n8 * 8);
        acc += bflo(cw.x) * bflo(bw.x) + bfhi(cw.x) * bfhi(bw.x) + bflo(cw.y) * bflo(bw.y) + bfhi(cw.y) * bfhi(bw.y) + bflo(cw.z) * bflo(bw.z) + bfhi(cw.z) * bfhi(bw.z) + bflo(cw.w) * bflo(bw.w) + bfhi(cw.w) * bfhi(bw.w); }
    ((bf16_t*)(P.ws + WS_GB))[it] = f2bf(acc);
}
DEV void st_ssd_y(const Params& P, long it, int l) {
    const int p = (int)(it & 63), i = (int)((it >> 6) & 127), hd = (int)((it >> 13) & 3); const int bc = (int)(it >> 15); const size_t r0 = (size_t)bc * CHK, r = r0 + i;
    const float* sc4 = (const float*)(P.ws + WS_SC4); const float acf = sc4[(r * 4 + hd) * 4], acb = sc4[(r * 4 + hd) * 4 + 2];
    const bf16_t* gb = (const bf16_t*)(P.ws + WS_GB) + (((size_t)bc * 2 + (hd >> 1)) * 128 + i) * 128; const bf16_t* xt = (const bf16_t*)(P.ws + WS_XT) + ((size_t)bc * 256 + hd * 64 + p) * CHK;
    float y = 0.f;
    for (int j = 0; j < CHK; ++j) { const float* sj = sc4 + ((r0 + j) * 4 + hd) * 4; float w = 0.f;
        if (j <= i) w += exp2f(acf - sj[0]) * sj[1];
        if (j >= i) w += exp2f(acb - sj[2]) * sj[3];
        y += bf2f(gb[j]) * w * bf2f(xt[j]); }
    const bf16_t* cp = (const bf16_t*)(P.ws + WS_XBC) + r * XBP + 256 + (hd >> 1) * 128;
    for (int dir = 0; dir < 2; ++dir) { const bf16_t* hs = (const bf16_t*)(P.ws + WS_SST) + ((((size_t)bc * 4 + hd) * 2 + dir) * 64 + p) * 128; float t = 0.f;
        for (int n = 0; n < 128; ++n) t += bf2f(cp[n]) * bf2f(hs[n]);
        y += exp2f(dir ? acb : acf) * t; }
    const float xv = bf2f(xt[i]), zv = bf2f(((const bf16_t*)(P.ws + WS_ZT))[((size_t)bc * 256 + hd * 64 + p) * CHK + i]);
    ((float*)(P.ws + WS_YG))[r * 256 + hd * 64 + p] = (y + P.ssd_d[l * 4 + hd] * xv) * silu_f(zv);
}
DEV void st_ssd_norm(const Params& P, long it, int l) {
    const int r = (int)it; const float* yg = (const float*)(P.ws + WS_YG) + (size_t)r * 256; bf16_t* mix = (bf16_t*)(P.ws + WS_XN) + (size_t)r * DM + MIX_A;
    float ss = 0.f;
    for (int c = 0; c < 256; ++c) ss += yg[c] * yg[c];
    const float rs = 1.0f / sqrtf(ss * (1.0f / 256) + EPS);
    for (int c = 0; c < 256; ++c) mix[c] = f2bf(yg[c] * rs * P.ssd_norm_g[l * 256 + c]);
}
DEV void st_attn(const Params& P, long it, int l, int type) {
    const int hq = (int)(it / MT), r = (int)(it % MT); const int b = r / SB, s = r % SB; const bool isctx = s < CTX;
    if (isctx && l == NL - 1) return;
    const bf16_t* pl = (const bf16_t*)(P.ws + WS_PL); const int cb = type ? PL_D : PL_C; const int kcol = cb + 256 + (hq >> 1) * 64, vcol = kcol + 128;
    float q[64], o[64];
#pragma unroll
    for (int d = 0; d < 64; ++d) { q[d] = bf2f(pl[(size_t)r * NPL + cb + hq * 64 + d]); o[d] = 0.f; }
    float m = -INFINITY, ls = 0.f;
    for (int seg = 0; seg < 2; ++seg) {
        int lo, hi;
        if (seg == 0) { lo = 0; hi = CTX; }
        else { if (isctx) break; if (type == 0) { lo = CTX; hi = SB; } else { lo = s - 128 < CTX ? CTX : s - 128; hi = s + 129 > SB ? SB : s + 129; } }
        for (int sk = lo; sk < hi; ++sk) { const bf16_t* kp = pl + (size_t)(b * SB + sk) * NPL + kcol; const bf16_t* vp = pl + (size_t)(b * SB + sk) * NPL + vcol;
            float sc = 0.f;
#pragma unroll
            for (int d8 = 0; d8 < 8; ++d8) { const U4 w = *(const U4*)(kp + d8 * 8);
                sc += q[d8 * 8 + 0] * bflo(w.x) + q[d8 * 8 + 1] * bfhi(w.x) + q[d8 * 8 + 2] * bflo(w.y) + q[d8 * 8 + 3] * bfhi(w.y) + q[d8 * 8 + 4] * bflo(w.z) + q[d8 * 8 + 5] * bfhi(w.z) + q[d8 * 8 + 6] * bflo(w.w) + q[d8 * 8 + 7] * bfhi(w.w); }
            const float mn = fmaxf(m, sc); const float al = exp2f(m - mn), pe = exp2f(sc - mn); m = mn; ls = ls * al + pe;
#pragma unroll
            for (int d8 = 0; d8 < 8; ++d8) { const U4 w = *(const U4*)(vp + d8 * 8);
                o[d8 * 8 + 0] = o[d8 * 8 + 0] * al + pe * bflo(w.x); o[d8 * 8 + 1] = o[d8 * 8 + 1] * al + pe * bfhi(w.x); o[d8 * 8 + 2] = o[d8 * 8 + 2] * al + pe * bflo(w.y); o[d8 * 8 + 3] = o[d8 * 8 + 3] * al + pe * bfhi(w.y);
                o[d8 * 8 + 4] = o[d8 * 8 + 4] * al + pe * bflo(w.z); o[d8 * 8 + 5] = o[d8 * 8 + 5] * al + pe * bfhi(w.z); o[d8 * 8 + 6] = o[d8 * 8 + 6] * al + pe * bflo(w.w); o[d8 * 8 + 7] = o[d8 * 8 + 7] * al + pe * bfhi(w.w); } }
    }
    if (type == 1) { const float sk = P.swa_sink[l * 4 + hq] * LOG2E; const float mn = fmaxf(m, sk); const float al = exp2f(m - mn); ls = ls * al + exp2f(sk - mn);
#pragma unroll
        for (int d = 0; d < 64; ++d) o[d] *= al; }
    const float inv = 1.0f / ls; bf16_t* mix = (bf16_t*)(P.ws + WS_XN) + (size_t)r * DM + (type ? MIX_D : MIX_C) + hq * 64;
#pragma unroll
    for (int d = 0; d < 64; ++d) mix[d] = f2bf(o[d] * inv);
}

#ifndef CPU_EMU
__device__ __forceinline__ int tid_from_wave(int wave_s) { int z = 0; asm volatile("" : "+v"(z)); return (wave_s << 6) | (int)__builtin_amdgcn_mbcnt_hi(~0u, __builtin_amdgcn_mbcnt_lo(~0u, (unsigned)z)); }
namespace pg8 {
#define PG8_LAS __attribute__((address_space(3)))
typedef unsigned short bf16_t;
typedef short bf16x8 __attribute__((ext_vector_type(8)));
typedef float f32x4 __attribute__((ext_vector_type(4)));
typedef unsigned u32x4 __attribute__((ext_vector_type(4)));
constexpr int BM = 256, BK = 64, HALF = 128, HTB = HALF * BK * 2  , STAGE_BYTES = 8 * HTB, NXCD = 8, WGM = 4;

__host__ __device__ __forceinline__ int lds_byte(int r, int c) { const int st = (r >> 4) * 2 + (c >> 5), rr = r & 15, cc = c & 31, ob = rr * 64 + cc * 2; return st * 1024 + (ob ^ (((ob >> 9) & 1) << 5)); }
__host__ __device__ __forceinline__ void stage_rc(int b, int& R, int& C) { const int st = b / 1024, sb = b % 1024, swz = sb ^ (((sb >> 9) & 1) << 5); R = (st >> 1) * 16 + swz / 64; C = (st & 1) * 32 + (swz % 64) / 2; }
__host__ __device__ __forceinline__ int perm32(int rho) { const int n = rho >> 4, i = rho & 15; return 8 * (i >> 2) + 4 * n + (i & 3); }

struct Unit { int pm, pn, ko; };
struct Gemm { const bf16_t* A; const bf16_t* Bt; int M, N, K, ldk; };

struct StaticOrder {
    int nM, nN, nwg, G, c;
    __host__ __device__ void init(int M, int N, int G_, int c_) { nM = M / BM; nN = N / BM; nwg = nM * nN; G = G_; c = c_; }
    __host__ __device__ bool next(int i, Unit& u) const {
        const long L = (long)i * G + c; if (L >= nwg) return false;
        int wgid = (int)L; { const int q = nwg / NXCD, r = nwg % NXCD, xcd = wgid % NXCD, off = wgid / NXCD; wgid = (xcd < r ? xcd * (q + 1) : r * (q + 1) + (xcd - r) * q) + off; }
        const int nig = WGM * nN, gid = wgid / nig, fm = gid * WGM, gsz = (nM - fm) < WGM ? (nM - fm) : WGM;
        u.pm = fm + ((wgid % nig) % gsz); u.pn = (wgid % nig) / gsz; u.ko = 0; return true;
    }
    __device__ __forceinline__ void a_ready(const Unit&) const {}
    __device__ __forceinline__ void done(const Unit&) const {}
};

__device__ __forceinline__ unsigned cvt_pk_bf16(float lo, float hi) { unsigned r; asm volatile("v_cvt_pk_bf16_f32 %0, %1, %2" : "=v"(r) : "v"(lo), "v"(hi)); return r; }
typedef float f32x2 __attribute__((ext_vector_type(2)));

typedef unsigned u32x4 __attribute__((ext_vector_type(4)));
template <int ACT> struct EpiBf16A {
    static constexpr bool PERM = true, AFTER_DRAIN = false;
    bf16_t* O; int ldc; const float* rsq; const float* bias; float* dtp; int bpitch;
    __device__ __forceinline__ void operator()(const f32x4 (&acc)[2][2][4][2], const Unit& u, int wr, int wc, int fr_, int fq_) const {
        int fr = fr_, fq = fq_; asm volatile("" : "+v"(fr), "+v"(fq));
        const int row0 = u.pm * BM + wr * 64 + fr; const int col0 = u.pn * BM + wc * 32 + 8 * fq;
        if (dtp && u.pn * BM >= ldc) {
            if (wc == 0 && fq == 0) { f32x4 b0 = {0.f, 0.f, 0.f, 0.f}, b1 = b0;
                if (rsq) { constexpr int PPB = SB / 256; const float* bp_ = bias + (size_t)((u.pm % PPB) == 0 ? NB : u.pm / PPB) * bpitch + col0; b0 = *(const f32x4*)bp_; b1 = *(const f32x4*)(bp_ + 4); }
#pragma unroll
                for (int ai = 0; ai < 2; ++ai)
#pragma unroll
                    for (int m = 0; m < 4; ++m) { float* d = dtp + (size_t)(row0 + ai * HALF + m * 16) * 8; const float rsv = rsq ? __builtin_amdgcn_rsqf(rsq[row0 + ai * HALF + m * 16] * (1.0f / DM) + EPS) : 1.f;
                        *(f32x4*)d = acc[ai][0][m][0] * rsv + b0; *(f32x4*)(d + 4) = acc[ai][0][m][1] * rsv + b1; } }
            return; }
        f32x4 bv[2][2];
        if (rsq) { constexpr int PPB = SB / 256; const float* bp_ = bias + (size_t)((u.pm % PPB) == 0 ? NB : u.pm / PPB) * bpitch + col0;
#pragma unroll
            for (int bj = 0; bj < 2; ++bj) { bv[bj][0] = *(const f32x4*)(bp_ + bj * HALF); bv[bj][1] = *(const f32x4*)(bp_ + bj * HALF + 4); } }
#pragma unroll
        for (int ai = 0; ai < 2; ++ai)
#pragma unroll
            for (int m = 0; m < 4; ++m) { bf16_t* rowp = O + (size_t)(row0 + ai * HALF + m * 16) * ldc + col0;
                float rsv = 1.f; if (rsq) rsv = __builtin_amdgcn_rsqf(rsq[row0 + ai * HALF + m * 16] * (1.0f / DM) + EPS);
#pragma unroll
                for (int bj = 0; bj < 2; ++bj) { f32x4 v0 = acc[ai][bj][m][0], v1 = acc[ai][bj][m][1];
                    if (rsq) { v0 = v0 * rsv + bv[bj][0]; v1 = v1 * rsv + bv[bj][1]; }
                    if (ACT == 2) {
#pragma unroll
                        for (int e = 0; e < 4; ++e) { const float a = fmaxf(v0[e], 0.f), b = fmaxf(v1[e], 0.f); v0[e] = a * a; v1[e] = b * b; } }
                    u32x4 w; w.x = cvt_pk_bf16(v0[0], v0[1]); w.y = cvt_pk_bf16(v0[2], v0[3]); w.z = cvt_pk_bf16(v1[0], v1[1]); w.w = cvt_pk_bf16(v1[2], v1[3]);
                    *(u32x4*)(rowp + bj * HALF) = w; } }
    }
};
struct EpiResid {
    static constexpr bool PERM = true, AFTER_DRAIN = false;
    const void* in_lat; void* out_lat; int in_bf, out_bf; const float* mod; int goff; int kslice; float* slab; bf16_t* xa; const float* gn; const float* modn; int scoff; float* rsq;
    __device__ __forceinline__ void operator()(const f32x4 (&acc)[2][2][4][2], const Unit& u, int wr, int wc, int fr_, int fq_) const {
        int fr = fr_, fq = fq_; asm volatile("" : "+v"(fr), "+v"(fq) :: "memory");
        constexpr int PPB = SB / 256; const int b = u.pm / PPB, j = u.pm % PPB;
        const size_t lrow = ((size_t)b * SEQ + (size_t)(j - 1) * 256) * DM;
        const float* g = mod + (size_t)(j == 0 ? NB : b) * NMOD + goff;
        const int col0 = u.pn * BM + wc * 32 + 8 * fq;
        f32x4 gv[2][2], Gn[2][2];
#pragma unroll
        for (int bj = 0; bj < 2; ++bj)
#pragma unroll
            for (int n = 0; n < 2; ++n) { gv[bj][n] = *(const f32x4*)(g + col0 + bj * HALF + n * 4);
                if (xa) Gn[bj][n] = *(const f32x4*)(gn + col0 + bj * HALF + n * 4) * (1.f + *(const f32x4*)(modn + (size_t)(j == 0 ? NB : b) * NMOD + scoff + col0 + bj * HALF + n * 4)); }
        const int lane_ = fq * 16 + fr;
        u32x4 xr[2][4][2];
#define XR_LOAD(ai_) do { if (!kslice && in_bf) { _Pragma("unroll") for (int m_ = 0; m_ < 4; ++m_) _Pragma("unroll") for (int bj_ = 0; bj_ < 2; ++bj_) \
            xr[ai_][m_][bj_] = *(const u32x4*)((const bf16_t*)in_lat + lrow + (size_t)((ai_) * HALF + wr * 64 + m_ * 16 + fr) * DM + col0 + bj_ * HALF); } } while (0)
        XR_LOAD(0);
#pragma unroll
        for (int ai = 0; ai < 2; ++ai)
#pragma unroll
            for (int m = 0; m < 4; ++m) { const int rl = ai * HALF + wr * 64 + m * 16 + fr; const size_t off = (size_t)rl * DM + col0; float sq = 0.f;
                if (ai == 0 && m == 2) XR_LOAD(1);
#pragma unroll
                for (int bj = 0; bj < 2; ++bj) { const f32x4 t0 = gv[bj][0] * acc[ai][bj][m][0], t1 = gv[bj][1] * acc[ai][bj][m][1];
                    if (kslice) { float* sp = slab + ((size_t)(u.ko / kslice) * NB + b) * CTX * DM + off + bj * HALF; *(f32x4*)sp = t0; *(f32x4*)(sp + 4) = t1; }
                    else { f32x4 x0, x1;
                        if (in_bf) { const u32x4 w = xr[ai][m][bj];
                            x0 = f32x4{__uint_as_float(w.x << 16), __uint_as_float(w.x & 0xffff0000u), __uint_as_float(w.y << 16), __uint_as_float(w.y & 0xffff0000u)}; x1 = f32x4{__uint_as_float(w.z << 16), __uint_as_float(w.z & 0xffff0000u), __uint_as_float(w.w << 16), __uint_as_float(w.w & 0xffff0000u)}; }
                        else { x0 = *(const f32x4*)((const float*)in_lat + lrow + off + bj * HALF); x1 = *(const f32x4*)((const float*)in_lat + lrow + off + bj * HALF + 4); }
                        x0 += t0; x1 += t1;
                        if (out_bf) { u32x4 w; w.x = cvt_pk_bf16(x0[0], x0[1]); w.y = cvt_pk_bf16(x0[2], x0[3]); w.z = cvt_pk_bf16(x1[0], x1[1]); w.w = cvt_pk_bf16(x1[2], x1[3]); *(u32x4*)((bf16_t*)out_lat + lrow + off + bj * HALF) = w; }
                        else { *(f32x4*)((float*)out_lat + lrow + off + bj * HALF) = x0; *(f32x4*)((float*)out_lat + lrow + off + bj * HALF + 4) = x1; }
                        if (xa) { const f32x4 a0 = x0 * Gn[bj][0], a1 = x1 * Gn[bj][1]; u32x4 w; w.x = cvt_pk_bf16(a0[0], a0[1]); w.y = cvt_pk_bf16(a0[2], a0[3]); w.z = cvt_pk_bf16(a1[0], a1[1]); w.w = cvt_pk_bf16(a1[2], a1[3]);
                            *(u32x4*)(xa + ((size_t)u.pm * BM + rl) * DM + col0 + bj * HALF) = w;
                            sq += ((x0[0] * x0[0] + x0[1] * x0[1]) + (x0[2] * x0[2] + x0[3] * x0[3])) + ((x1[0] * x1[0] + x1[1] * x1[1]) + (x1[2] * x1[2] + x1[3] * x1[3])); } } }
                if (xa && !kslice) { sq += __int_as_float(__builtin_amdgcn_ds_bpermute((lane_ ^ 16) << 2, __float_as_int(sq))); sq += __int_as_float(__builtin_amdgcn_ds_bpermute((lane_ ^ 32) << 2, __float_as_int(sq)));
                    if (fq == 0) atomicAdd(rsq + (size_t)u.pm * BM + rl, sq); }
                if (m & 1) asm volatile("" ::: "memory"); }
#undef XR_LOAD
    }
};
struct RowOrder {
    static constexpr int KSPLIT = 4;
    StaticOrder S; int mode, nN, G, c, kslice;
    __device__ void init(int N, int G_, int c_, int mode_, int kslice_ = 0) { mode = mode_; nN = N / BM; G = G_; c = c_; kslice = kslice_; S.init(mode_ == 1 ? NB * SEQ : MT, N, G_, c_); }
    __device__ bool next(int i, Unit& u) const {
        if (mode == 2) { const int Lx = i * G + c; if (Lx >= NB * nN * KSPLIT) return false; const int ks = Lx % KSPLIT, t = Lx / KSPLIT; u.pn = t % nN; u.pm = (t / nN) * (SB / 256); u.ko = ks * kslice; return true; }
        if (!S.next(i, u)) return false; if (mode == 1) u.pm = u.pm + u.pm / (SEQ / 256) + 1; return true; }
    __device__ __forceinline__ void a_ready(const Unit&) const {}
    __device__ __forceinline__ void done(const Unit&) const {}
};
template <class Epi, class Sched, bool ALIGN_EPI = false, bool SP2 = false>
__device__ __forceinline__ void gemm_phase(PG8_LAS unsigned char* lds, const Gemm g, const Sched& S, const Epi& E, int wave_s) {
    const int tid = tid_from_wave(wave_s);
    const int wid = __builtin_amdgcn_readfirstlane(tid >> 6), lane = tid & 63, wr = wid >> 2, wc = wid & 3, fr = lane & 15, fq = lane >> 4;
    const int K = g.ldk, nt = g.K / BK;
    unsigned voffA[2], voffB[2];
#pragma unroll
    for (int i = 0; i < 2; ++i) { int R, C; stage_rc(tid * 16 + i * 8192, R, C); const int Rb = Epi::PERM ? ((R & ~31) + perm32(R & 31)) : R;
        voffA[i] = (unsigned)(R * K + C) * 2u; voffB[i] = (unsigned)(Rb * K + C) * 2u; }
    const size_t kstep = (size_t)(BK * 2);
    const size_t hstep = (size_t)HALF * K * 2;
    const size_t tstep = 2 * hstep;
    const unsigned ldsw = (unsigned)wid * 1024u;
    const int aoff = lds_byte(wr * 64 + fr, fq * 8), boff = lds_byte(wc * 32 + fr, fq * 8);
#define PG8_SA(b, h) (((b) * 2 + (h)) * HTB)
#define PG8_SB(b, h) ((4 + (b) * 2 + (h)) * HTB)
#define PG8_STAGE(bufoff, gbase, voff) do { _Pragma("unroll") for (int _i = 0; _i < 2; ++_i) \
        __builtin_amdgcn_global_load_lds((const unsigned*)((const char*)(gbase) + (voff)[_i]), (PG8_LAS unsigned*)(lds + (bufoff) + ldsw + _i * 8192), 16, 0, 0); } while (0)
#define PG8_LDA(dst, b, h) do { _Pragma("unroll") for (int m = 0; m < 4; ++m) _Pragma("unroll") for (int k = 0; k < 2; ++k) dst[m][k] = *(const PG8_LAS bf16x8*)(lds + PG8_SA(b, h) + aoff + m * 2048 + k * 1024); } while (0)
#define PG8_LDB(dst, b, h) do { _Pragma("unroll") for (int n = 0; n < 2; ++n) _Pragma("unroll") for (int k = 0; k < 2; ++k) dst[n][k] = *(const PG8_LAS bf16x8*)(lds + PG8_SB(b, h) + boff + n * 2048 + k * 1024); } while (0)
#define PG8_MMA(ai, bj, At, Bt) do { __builtin_amdgcn_s_setprio(1); _Pragma("unroll") for (int m = 0; m < 4; ++m) _Pragma("unroll") for (int n = 0; n < 2; ++n) _Pragma("unroll") for (int k = 0; k < 2; ++k) \
        acc[ai][bj][m][n] = __builtin_amdgcn_mfma_f32_16x16x32_bf16(Bt[n][k], At[m][k], acc[ai][bj][m][n], 0, 0, 0); __builtin_amdgcn_s_setprio(0); } while (0)
#define PG8_WAIT_V(n) asm volatile("s_waitcnt vmcnt(" #n ")" ::: "memory")
#define PG8_WAIT_L(n) asm volatile("s_waitcnt lgkmcnt(" #n ")" ::: "memory")
#define PG8_BAR __builtin_amdgcn_s_barrier()
#define PG8_SCHED __builtin_amdgcn_sched_barrier(0)
    Unit cur, nxt; int ui = 0;
    if (!S.next(0, cur)) return;
    f32x4 acc[2][2][4][2];
#pragma unroll
    for (int a = 0; a < 2; ++a)
#pragma unroll
        for (int b = 0; b < 2; ++b)
#pragma unroll
            for (int m = 0; m < 4; ++m)
#pragma unroll
                for (int n = 0; n < 2; ++n) acc[a][b][m][n] = (f32x4){0.f, 0.f, 0.f, 0.f};
    bf16x8 At[4][2], B0[2][2], B1[2][2];
    const char* cA = (const char*)g.A + (size_t)cur.pm * tstep + (size_t)cur.ko * 2; const char* cB = (const char*)g.Bt + (size_t)cur.pn * tstep + (size_t)cur.ko * 2;
    S.a_ready(cur);
    if constexpr (SP2) {
        PG8_STAGE(PG8_SB(0, 0), cB, voffB); PG8_STAGE(PG8_SB(0, 1), cB + hstep, voffB); PG8_STAGE(PG8_SA(0, 0), cA, voffA); PG8_STAGE(PG8_SA(0, 1), cA + hstep, voffA);
        if (wr == 1) PG8_BAR;
        PG8_WAIT_V(2); PG8_BAR;
        PG8_STAGE(PG8_SB(1, 0), cB + kstep, voffB); PG8_STAGE(PG8_SA(1, 0), cA + kstep, voffA); PG8_STAGE(PG8_SB(1, 1), cB + hstep + kstep, voffB);
        PG8_WAIT_V(6); PG8_BAR;
    } else {
        PG8_STAGE(PG8_SB(0, 0), cB, voffB); PG8_STAGE(PG8_SA(0, 0), cA, voffA); PG8_STAGE(PG8_SB(0, 1), cB + hstep, voffB); PG8_STAGE(PG8_SA(0, 1), cA + hstep, voffA);
        if (wr == 1) PG8_BAR;
        PG8_WAIT_V(4); PG8_BAR;
        PG8_STAGE(PG8_SB(1, 0), cB + kstep, voffB); PG8_STAGE(PG8_SA(1, 0), cA + kstep, voffA); PG8_STAGE(PG8_SB(1, 1), cB + hstep + kstep, voffB);
        PG8_WAIT_V(6); PG8_BAR;
    }
    for (;;) {
        const bool has_next = S.next(ui + 1, nxt);
        const char* nA = has_next ? (const char*)g.A + (size_t)nxt.pm * tstep + (size_t)nxt.ko * 2 : cA; const char* nB = has_next ? (const char*)g.Bt + (size_t)nxt.pn * tstep + (size_t)nxt.ko * 2 : cB;
        for (int t = 0; t < nt; t += 2) {
            const bool last = (t == nt - 2);
            const char* a1 = cA + (size_t)(t + 1) * kstep;
            const char* a2 = last ? nA : cA + (size_t)(t + 2) * kstep; const char* b2 = last ? nB : cB + (size_t)(t + 2) * kstep;
            const char* a3 = a2 + kstep; const char* b3 = b2 + kstep;
            if (last && has_next) S.a_ready(nxt);
            if constexpr (SP2) {
            PG8_LDB(B0, 0, 0); PG8_LDB(B1, 0, 1); PG8_SCHED; PG8_LDA(At, 0, 0); PG8_STAGE(PG8_SA(1, 1), a1 + hstep, voffA);
            PG8_WAIT_V(8); PG8_WAIT_L(0); PG8_BAR; PG8_MMA(0, 0, At, B0); PG8_MMA(0, 1, At, B1); PG8_BAR; PG8_SCHED;
            PG8_LDA(At, 0, 1); PG8_STAGE(PG8_SB(0, 0), b2, voffB); PG8_STAGE(PG8_SB(0, 1), b2 + hstep, voffB); PG8_STAGE(PG8_SA(0, 0), a2, voffA);
            PG8_WAIT_V(8); PG8_WAIT_L(0); PG8_BAR; PG8_MMA(1, 0, At, B0); PG8_MMA(1, 1, At, B1); PG8_BAR; PG8_SCHED;
            PG8_LDB(B0, 1, 0); PG8_LDB(B1, 1, 1); PG8_SCHED; PG8_LDA(At, 1, 0); PG8_STAGE(PG8_SA(0, 1), a2 + hstep, voffA);
            PG8_WAIT_V(8); PG8_WAIT_L(0); PG8_BAR; PG8_MMA(0, 0, At, B0); PG8_MMA(0, 1, At, B1); PG8_BAR; PG8_SCHED;
            PG8_LDA(At, 1, 1); PG8_STAGE(PG8_SB(1, 0), b3, voffB); PG8_STAGE(PG8_SB(1, 1), b3 + hstep, voffB); PG8_STAGE(PG8_SA(1, 0), a3, voffA);
            PG8_WAIT_V(8); PG8_WAIT_L(0); PG8_BAR; PG8_MMA(1, 0, At, B0); PG8_MMA(1, 1, At, B1); PG8_BAR; PG8_SCHED;
            } else {
            PG8_LDB(B0, 0, 0); PG8_SCHED; PG8_LDA(At, 0, 0); PG8_STAGE(PG8_SA(1, 1), a1 + hstep, voffA);
            PG8_WAIT_L(8); PG8_BAR; PG8_WAIT_L(0); PG8_MMA(0, 0, At, B0); PG8_BAR; PG8_SCHED;
            PG8_LDB(B1, 0, 1); PG8_STAGE(PG8_SB(0, 0), b2, voffB);
            PG8_BAR; PG8_WAIT_L(0); PG8_MMA(0, 1, At, B1); PG8_BAR;
            PG8_LDA(At, 0, 1); PG8_STAGE(PG8_SA(0, 0), a2, voffA);
            PG8_BAR; PG8_WAIT_L(0); PG8_MMA(1, 0, At, B0); PG8_BAR; PG8_SCHED;
            PG8_STAGE(PG8_SB(0, 1), b2 + hstep, voffB);
            PG8_WAIT_V(6); PG8_BAR; PG8_MMA(1, 1, At, B1); PG8_BAR;
            PG8_LDB(B0, 1, 0); PG8_SCHED; PG8_LDA(At, 1, 0); PG8_STAGE(PG8_SA(0, 1), a2 + hstep, voffA);
            PG8_WAIT_L(8); PG8_BAR; PG8_WAIT_L(0); PG8_MMA(0, 0, At, B0); PG8_BAR; PG8_SCHED;
            PG8_LDB(B1, 1, 1); PG8_STAGE(PG8_SB(1, 0), b3, voffB);
            PG8_BAR; PG8_WAIT_L(0); PG8_MMA(0, 1, At, B1); PG8_BAR;
            PG8_LDA(At, 1, 1); PG8_STAGE(PG8_SA(1, 0), a3, voffA);
            PG8_BAR; PG8_WAIT_L(0); PG8_MMA(1, 0, At, B0); PG8_BAR; PG8_SCHED;
            PG8_STAGE(PG8_SB(1, 1), b3 + hstep, voffB);
            PG8_WAIT_V(6); PG8_BAR; PG8_MMA(1, 1, At, B1); PG8_BAR;
            }
        }
        if constexpr (ALIGN_EPI) { if (wr == 0) PG8_BAR; }
        if constexpr (!Epi::AFTER_DRAIN) { E(acc, cur, wr, wc, fr, fq); S.done(cur); }
        if (!has_next) break;
#pragma unroll
        for (int a = 0; a < 2; ++a)
#pragma unroll
            for (int b = 0; b < 2; ++b)
#pragma unroll
                for (int m = 0; m < 4; ++m)
#pragma unroll
                    for (int n = 0; n < 2; ++n) acc[a][b][m][n] = (f32x4){0.f, 0.f, 0.f, 0.f};
        cur = nxt; cA = nA; cB = nB; ++ui;
        if constexpr (ALIGN_EPI) { if (wr == 1) PG8_BAR; }
    }
    PG8_WAIT_V(0);
    if constexpr (!ALIGN_EPI) { if (wr == 0) PG8_BAR; }
    PG8_BAR;
    if constexpr (Epi::AFTER_DRAIN) { E.fused(acc, cur, wr, wc, fr, fq, lds, wid, lane); S.done(cur); }
#undef PG8_SA
#undef PG8_SB
#undef PG8_STAGE
#undef PG8_LDA
#undef PG8_LDB
#undef PG8_MMA
#undef PG8_WAIT_V
#undef PG8_WAIT_L
#undef PG8_BAR
#undef PG8_SCHED
}
}

#include <hip/hip_bf16.h>
#include <cmath>
namespace attn_body {
using bf16=__hip_bfloat16;
using bf16x8=__attribute__((ext_vector_type(8)))short;
using s16x4=__attribute__((ext_vector_type(4)))short;
using f32x16=__attribute__((ext_vector_type(16)))float;
using u32x4=__attribute__((ext_vector_type(4)))unsigned;
constexpr int D=64,PP=NPL,OP=::DM;
constexpr int NW=8,QBLK=32,QB=QBLK*NW,KVBLK=64;
__device__ __forceinline__ int crow(int r,int hi){return (r&3)+8*(r>>2)+4*hi;}
#define SBAR() __builtin_amdgcn_sched_barrier(0)
__device__ __forceinline__ void wmask(f32x16&p0,f32x16&p1,int dk,int hi){
  const float NEG=-INFINITY; const int kb=dk+4*hi;
  #pragma unroll
  for(int r=0;r<16;++r){const int d=kb+(r&3)+8*(r>>2); if(d>128||d<-128)p0[r]=NEG; if(d+32>128||d+32<-128)p1[r]=NEG;}
}
struct AttnDesc { int qrow,qcol,kcol,vcol,ocol,rowA,rowB,NT,masked,qpos0,kpos4,has_sink; float sinkl2; };

constexpr int NSLOT=3, SLOTB=8192;
constexpr int LDS_K=0, LDS_V=NSLOT*SLOTB, LDS_WS=2*NSLOT*SLOTB, LDS_OST=LDS_WS+NW*64*4, LDS_BYTES=LDS_OST+NW*4096;
constexpr float C2=0.125f*1.4426950408889634f;
__device__ __forceinline__ void glds16(const void*gsrc,unsigned lds_dst){unsigned keep;
  asm volatile("s_mov_b32 %0, m0\n\ts_mov_b32 m0, %2\n\ts_nop 0\n\tglobal_load_lds_dwordx4 %1, off\n\ts_mov_b32 m0, %0":"=&s"(keep):"v"(gsrc),"s"(lds_dst):"memory");}
__device__ __forceinline__ float max3f(float a,float b,float c){float r;asm("v_max3_f32 %0, %1, %2, %3":"=v"(r):"v"(a),"v"(b),"v"(c));return r;}
__device__ __forceinline__ float max2f(float a,float b){float r;asm("v_max_f32_e32 %0, %1, %2":"=v"(r):"v"(a),"v"(b));return r;}
__device__ __forceinline__ float fadd_s(float a,float b){float r;asm("v_add_f32_e32 %0, %1, %2":"=v"(r):"v"(a),"v"(b));return r;}
__device__ __forceinline__ float fsub_s(float a,float b){float r;asm("v_sub_f32_e32 %0, %1, %2":"=v"(r):"v"(a),"v"(b));return r;}
typedef float f32x2_t __attribute__((ext_vector_type(2))); typedef __bf16 bf16x2_t __attribute__((ext_vector_type(2)));
__device__ __forceinline__ unsigned cvtpk_s(float lo,float hi){f32x2_t v={lo,hi};bf16x2_t b=__builtin_convertvector(v,bf16x2_t);return __builtin_bit_cast(unsigned,b);}
#define WAIT_BAR(N) asm volatile("s_waitcnt vmcnt(" #N ") lgkmcnt(0)\n\ts_barrier":::"memory")

__device__ __forceinline__ void qkt(f32x16&p0,f32x16&p1,const char*Kslot,const bf16x8*qr,const f32x16&negm,int r32,int hi){
  const char*kb=Kslot+hi*1024+r32*16;
  #pragma unroll
  for(int d0=0;d0<4;++d0){
    const bf16x8 b0=*reinterpret_cast<const bf16x8*>(kb+d0*2048);
    const bf16x8 b1=*reinterpret_cast<const bf16x8*>(kb+d0*2048+512);
    if(d0==0){p0=__builtin_amdgcn_mfma_f32_32x32x16_bf16(b0,qr[0],negm,0,0,0);p1=__builtin_amdgcn_mfma_f32_32x32x16_bf16(b1,qr[0],negm,0,0,0);}
    else{p0=__builtin_amdgcn_mfma_f32_32x32x16_bf16(b0,qr[d0],p0,0,0,0);p1=__builtin_amdgcn_mfma_f32_32x32x16_bf16(b1,qr[d0],p1,0,0,0);}}
}
typedef __attribute__((address_space(3))) const char* lds_cptr;
typedef short v4i16_t __attribute__((ext_vector_type(4)));
__device__ __forceinline__ void kload8(bf16x8*kf,lds_cptr kp){
  kf[0]=*(const __attribute__((address_space(3))) bf16x8*)(kp);      kf[1]=*(const __attribute__((address_space(3))) bf16x8*)(kp+512);
  kf[2]=*(const __attribute__((address_space(3))) bf16x8*)(kp+2048); kf[3]=*(const __attribute__((address_space(3))) bf16x8*)(kp+2560);
  kf[4]=*(const __attribute__((address_space(3))) bf16x8*)(kp+4096); kf[5]=*(const __attribute__((address_space(3))) bf16x8*)(kp+4608);
  kf[6]=*(const __attribute__((address_space(3))) bf16x8*)(kp+6144); kf[7]=*(const __attribute__((address_space(3))) bf16x8*)(kp+6656);
}
__device__ __forceinline__ void kload2(bf16x8*kf,lds_cptr kp,int j){ kf[2*j]=*(const __attribute__((address_space(3))) bf16x8*)(kp+j*2048); kf[2*j+1]=*(const __attribute__((address_space(3))) bf16x8*)(kp+j*2048+512); }
__device__ __forceinline__ s16x4 vtr(lds_cptr p){ return __builtin_bit_cast(s16x4,__builtin_amdgcn_ds_read_tr16_b64_v4i16((__attribute__((address_space(3))) v4i16_t*)p)); }
__device__ __forceinline__ float rowmax(const f32x16&p0,const f32x16&p1){
  float a=max3f(p0[0],p0[1],p1[0]),b=max3f(p0[2],p0[3],p1[1]);a=max3f(a,p1[2],p1[3]);
  #pragma unroll
  for(int r=4;r<16;r+=4){a=max3f(a,p0[r],p0[r+1]);b=max3f(b,p0[r+2],p0[r+3]);a=max3f(a,p1[r],p1[r+1]);b=max3f(b,p1[r+2],p1[r+3]);}
  const float m=max2f(a,b);
  auto rr=__builtin_amdgcn_permlane32_swap(__float_as_uint(m),__float_as_uint(m),false,false);
  return max2f(__uint_as_float(rr[0]),__uint_as_float(rr[1]));
}
__device__ __forceinline__ void pv(f32x16*o,int vb,bf16x8 pa0,bf16x8 pa1,bf16x8 pa2,bf16x8 pa3){
  #pragma unroll
  for(int d0=0;d0<2;++d0){s16x4 lo[4],hi[4];
    #pragma unroll
    for(int ks=0;ks<4;++ks){
      asm volatile("ds_read_b64_tr_b16 %0,%1 offset:%c2":"=&v"(lo[ks]):"v"(vb),"i"(d0*4096+ks*1024):"memory");
      asm volatile("ds_read_b64_tr_b16 %0,%1 offset:%c2":"=&v"(hi[ks]):"v"(vb),"i"(d0*4096+ks*1024+512):"memory");}
    asm volatile("s_waitcnt lgkmcnt(0)":::"memory");SBAR();
    #define PK(k) (bf16x8){lo[k][0],lo[k][1],lo[k][2],lo[k][3],hi[k][0],hi[k][1],hi[k][2],hi[k][3]}
    o[d0]=__builtin_amdgcn_mfma_f32_32x32x16_bf16(pa0,PK(0),o[d0],0,0,0);
    o[d0]=__builtin_amdgcn_mfma_f32_32x32x16_bf16(pa1,PK(1),o[d0],0,0,0);
    o[d0]=__builtin_amdgcn_mfma_f32_32x32x16_bf16(pa2,PK(2),o[d0],0,0,0);
    o[d0]=__builtin_amdgcn_mfma_f32_32x32x16_bf16(pa3,PK(3),o[d0],0,0,0);
    #undef PK
  }
}

#ifndef ATTN_STORE16
#define ATTN_STORE16(p,v) (*(u32x4*)(p)=(v))
#endif
template<int THRL> __device__ __forceinline__ void attn_unit(const AttnDesc u,const bf16*__restrict__ PLb,bf16*__restrict__ MIXb,char*shm,int wave_s){
  const int tid=tid_from_wave(wave_s);
  const int lane=tid&63,r32=lane&31,hi=lane>>5; const int wid=__builtin_amdgcn_readfirstlane(tid>>6);
  const bf16*Qw=PLb+(long)(u.qrow+wid*QBLK)*PP+u.qcol;
  const bf16*Kh=PLb+u.kcol,*Vh=PLb+u.vcol;
  const unsigned lds0=(unsigned)(uintptr_t)shm;
  float*wsf=(float*)(shm+LDS_WS)+wid*64;
  const bf16*ksrc=Kh+(long)lane*PP+wid*8;
  const bf16*vsrc=Vh+(long)(16*(wid&3)+(lane>>2))*PP+(wid>>2)*32+(lane&3)*8;
  #define TROW(t) ((t)<4 ? u.rowA+64*(t) : u.rowB+64*((t)-4))
  const unsigned kdst=lds0+LDS_K+wid*1024, vdst=lds0+LDS_V+wid*1024;
  #define DMA_K(t,slot) glds16(ksrc+(long)TROW(t)*PP,(unsigned)__builtin_amdgcn_readfirstlane(kdst+(slot)))
  #define DMA_V(t,slot) glds16(vsrc+(long)TROW(t)*PP,(unsigned)__builtin_amdgcn_readfirstlane(vdst+(slot)))
  const int vb0=(int)(lds0+LDS_V)+((lane>>4)&1)*32+(lane&3)*8+(4*hi+((lane&15)>>2))*64;
  const char*Kbase=shm+LDS_K; bf16x8 kf[8];
  const lds_cptr shm3=(lds_cptr)shm; const lds_cptr kp0=shm3+LDS_K+hi*1024+r32*16; const lds_cptr vp0=shm3+LDS_V+((lane>>4)&1)*32+(lane&3)*8+(4*hi+((lane&15)>>2))*64;
  const int NT=u.NT;
  DMA_K(0,0);DMA_V(0,0);DMA_K(1,SLOTB);
  bf16x8 qr[4];
  #pragma unroll
  for(int d0=0;d0<4;++d0)qr[d0]=*reinterpret_cast<const bf16x8*>(&Qw[(long)r32*PP+d0*16+hi*8]);
  float mhat=0.f,l_reg=0.f;f32x16 o[2];o[0]=f32x16{};o[1]=f32x16{};f32x16 negm=f32x16{};asm volatile("":"+v"(negm));
  const int qpos=u.qpos0+wid*QBLK+r32;
  #define CMASK(P0,P1,t) do{ if(u.masked && (t)>=4) wmask(P0,P1,u.kpos4+64*((t)-4)-qpos,hi); }while(0)
  bool resc=false;
  #define START(P0,P1) do{ const float rm=rowmax(P0,P1); resc=false; \
    { const float dl=rm; mhat=fadd_s(mhat,dl); \
      _Pragma("unroll") for(int r=0;r<16;++r){P0[r]=fsub_s(P0[r],dl);P1[r]=fsub_s(P1[r],dl);} \
      _Pragma("unroll") for(int r=0;r<16;++r)negm[r]=-mhat; asm volatile("":"+v"(negm)); } \
    _Pragma("unroll") for(int r=0;r<16;++r)P0[r]=__builtin_amdgcn_exp2f(P0[r]); }while(0)
  #define RESC() do{ if(resc){ asm volatile("s_waitcnt lgkmcnt(0)":::"memory"); \
      _Pragma("unroll") for(int d_=0;d_<2;++d_) _Pragma("unroll") for(int r=0;r<16;++r)o[d_][r]*=wsf[crow(r,hi)]; } }while(0)
  f32x16 pA0,pA1,pB0,pB1;
  int sl_prev=0,sl_cur=0,sl_next=SLOTB;
  #define ROT() do{sl_prev=sl_cur;sl_cur=sl_next;sl_next=(sl_next==(NSLOT-1)*SLOTB)?0:sl_next+SLOTB;}while(0)
  DMA_K(2,2*SLOTB);
  WAIT_BAR(3);
  qkt(pA0,pA1,Kbase,qr,negm,r32,hi);asm volatile("s_nop 15\n\ts_nop 7":"+v"(pA0),"+v"(pA1));CMASK(pA0,pA1,0);
  START(pA0,pA1);
  _Pragma("unroll") for(int r=0;r<16;++r)pA1[r]=__builtin_amdgcn_exp2f(pA1[r]);
  WAIT_BAR(0);
  DMA_K(3,0);DMA_V(1,SLOTB);
  ROT();
  kload8(kf,kp0+sl_cur);
  WAIT_BAR(2);
  s16x4 vlo[8],vhi[8]; u32x4 pw0,pw1,pw2,pw3;
  #define PKW(P,B) cvtpk_s(P[B],P[B+1])
  #define PAF(k) __builtin_bit_cast(bf16x8,pw##k)
  #define VFR(i) (bf16x8){vlo[i][0],vlo[i][1],vlo[i][2],vlo[i][3],vhi[i][0],vhi[i][1],vhi[i][2],vhi[i][3]}
  #define PIN(x) asm volatile("":"+v"(x))
  #define MX3(a,b,c) __builtin_fmaxf(__builtin_fmaxf((a),(b)),(c))
  #define GAPA(MF,A0,A1,A2,A3,W0,W1,PW) do{ MF; sacc+=A0; sacc+=A1; sacc+=A2; sacc+=A3; PIN(sacc); W0; W1; PIN(PW); SBAR(); }while(0)
  #define EX(v) __builtin_amdgcn_exp2f(v)
  #define GAPB(MF,X,B) do{ MF; X[B]=EX(X[B]); X[B+1]=EX(X[B+1]); X[B+2]=EX(X[B+2]); X[B+3]=EX(X[B+3]); PIN(X); SBAR(); }while(0)
  #define VRD(i) do{ vlo[i]=vtr(vp_+(((i)>>2)*4096+((i)&3)*1024)); vhi[i]=vtr(vp_+(((i)>>2)*4096+((i)&3)*1024+512)); }while(0)
  #define KRD(G,j) do{ if(G){ kload2(kf,kp0+sl_next,j); SBAR(); } }while(0)
  #define STEP(C0,C1,P0,P1,t,GK,GV,GL) do{ SBAR(); \
    const lds_cptr vp_=vp0+sl_prev; \
    VRD(0); SBAR(); float sacc=(P0[0]+P0[1]); \
    GAPA(C0=__builtin_amdgcn_mfma_f32_32x32x16_bf16(kf[0],qr[0],negm,0,0,0), P0[2],P0[3],P0[4],P0[5],     pw0[0]=PKW(P0,0), pw0[1]=PKW(P0,2), pw0); \
    VRD(4); SBAR(); GAPA(C1=__builtin_amdgcn_mfma_f32_32x32x16_bf16(kf[1],qr[0],negm,0,0,0), P0[6],P0[7],P0[8],P0[9],     pw0[2]=PKW(P0,4), pw0[3]=PKW(P0,6), pw0); \
    VRD(1); SBAR(); GAPA(C0=__builtin_amdgcn_mfma_f32_32x32x16_bf16(kf[2],qr[1],C0,0,0,0),   P0[10],P0[11],P0[12],P0[13], pw1[0]=PKW(P0,8), pw1[1]=PKW(P0,10), pw1); \
    VRD(5); SBAR(); GAPA(C1=__builtin_amdgcn_mfma_f32_32x32x16_bf16(kf[3],qr[1],C1,0,0,0),   P0[14],P0[15],P1[0],P1[1],   pw1[2]=PKW(P0,12),pw1[3]=PKW(P0,14), pw1); \
    VRD(2); SBAR(); GAPA(C0=__builtin_amdgcn_mfma_f32_32x32x16_bf16(kf[4],qr[2],C0,0,0,0),   P1[2],P1[3],P1[4],P1[5],     pw2[0]=PKW(P1,0), pw2[1]=PKW(P1,2), pw2); \
    VRD(6); SBAR(); GAPA(C1=__builtin_amdgcn_mfma_f32_32x32x16_bf16(kf[5],qr[2],C1,0,0,0),   P1[6],P1[7],P1[8],P1[9],     pw2[2]=PKW(P1,4), pw2[3]=PKW(P1,6), pw2); \
    VRD(3); SBAR(); GAPA(C0=__builtin_amdgcn_mfma_f32_32x32x16_bf16(kf[6],qr[3],C0,0,0,0),   P1[10],P1[11],P1[12],P1[13], pw3[0]=PKW(P1,8), pw3[1]=PKW(P1,10), pw3); \
    VRD(7); SBAR(); GAPA(C1=__builtin_amdgcn_mfma_f32_32x32x16_bf16(kf[7],qr[3],C1,0,0,0),   P1[14],P1[15],0.f,0.f,       pw3[2]=PKW(P1,12),pw3[3]=PKW(P1,14), pw3); \
    l_reg+=sacc; \
    if(GK){DMA_K((t)+3,sl_cur);} if(GV){DMA_V((t)+1,sl_next);} \
    CMASK(C0,C1,t); \
    { float a=MX3(C0[0],C0[1],C1[0]),b=MX3(C0[2],C0[3],C1[1]); a=MX3(a,C1[2],C1[3]); \
      _Pragma("unroll") for(int r=4;r<16;r+=4){a=MX3(a,C0[r],C0[r+1]);b=MX3(b,C0[r+2],C0[r+3]);a=MX3(a,C1[r],C1[r+1]);b=MX3(b,C1[r+2],C1[r+3]);} \
      float rm=__builtin_fmaxf(a,b); { auto rr=__builtin_amdgcn_permlane32_swap(__float_as_uint(rm),__float_as_uint(rm),false,false); rm=__builtin_fmaxf(__uint_as_float(rr[0]),__uint_as_float(rr[1])); } \
      resc=false; \
      if(__builtin_expect(__any(rm>(float)THRL),0)){ const float dl=__builtin_fmaxf(rm,0.f); mhat+=dl; \
        _Pragma("unroll") for(int r=0;r<16;++r){C0[r]-=dl;C1[r]-=dl;} \
        _Pragma("unroll") for(int r=0;r<16;++r)negm[r]=-mhat; asm volatile("":"+v"(negm)); \
        const float f=__builtin_amdgcn_exp2f(-dl); l_reg*=f; if(hi==0)wsf[r32]=f; resc=true; } } \
    SBAR(); \
    GAPB(o[0]=__builtin_amdgcn_mfma_f32_32x32x16_bf16(PAF(0),VFR(0),o[0],0,0,0), C0,0); \
    GAPB(o[1]=__builtin_amdgcn_mfma_f32_32x32x16_bf16(PAF(0),VFR(4),o[1],0,0,0), C0,4); \
    KRD(GL,0); GAPB(o[0]=__builtin_amdgcn_mfma_f32_32x32x16_bf16(PAF(1),VFR(1),o[0],0,0,0), C0,8); \
    KRD(GL,1); GAPB(o[1]=__builtin_amdgcn_mfma_f32_32x32x16_bf16(PAF(1),VFR(5),o[1],0,0,0), C0,12); \
    KRD(GL,2); GAPB(o[0]=__builtin_amdgcn_mfma_f32_32x32x16_bf16(PAF(2),VFR(2),o[0],0,0,0), C1,0); \
    KRD(GL,3); GAPB(o[1]=__builtin_amdgcn_mfma_f32_32x32x16_bf16(PAF(2),VFR(6),o[1],0,0,0), C1,4); \
    GAPB(o[0]=__builtin_amdgcn_mfma_f32_32x32x16_bf16(PAF(3),VFR(3),o[0],0,0,0), C1,8); \
    GAPB(o[1]=__builtin_amdgcn_mfma_f32_32x32x16_bf16(PAF(3),VFR(7),o[1],0,0,0), C1,12); \
    }while(0)
  int t=1;
  for(;t+5<NT;t+=2){
    STEP(pB0,pB1,pA0,pA1,t,true,true,true);     WAIT_BAR(2); RESC(); ROT();
    STEP(pA0,pA1,pB0,pB1,t+1,true,true,true);   WAIT_BAR(2); RESC(); ROT();
  }
  #define ENDW(tt) do{ if((tt)+3<NT){WAIT_BAR(2);} else if((tt)+2<NT){WAIT_BAR(1);} else {WAIT_BAR(0);} }while(0)
  for(;t+1<NT;t+=2){
    STEP(pB0,pB1,pA0,pA1,t,(t+3<NT),(t+1<NT),(t+1<NT));       ENDW(t);   RESC(); ROT();
    STEP(pA0,pA1,pB0,pB1,t+1,(t+4<NT),(t+2<NT),(t+2<NT));     ENDW(t+1); RESC(); ROT();
  }
  STEP(pB0,pB1,pA0,pA1,NT-1,false,false,false); RESC();
  { float sacc=pB0[0]+pB0[1]; _Pragma("unroll") for(int r=2;r<16;++r)sacc+=pB0[r]; _Pragma("unroll") for(int r=0;r<16;++r)sacc+=pB1[r]; l_reg+=sacc;
    pw0=(u32x4){PKW(pB0,0),PKW(pB0,2),PKW(pB0,4),PKW(pB0,6)};pw1=(u32x4){PKW(pB0,8),PKW(pB0,10),PKW(pB0,12),PKW(pB0,14)};pw2=(u32x4){PKW(pB1,0),PKW(pB1,2),PKW(pB1,4),PKW(pB1,6)};pw3=(u32x4){PKW(pB1,8),PKW(pB1,10),PKW(pB1,12),PKW(pB1,14)};
    SBAR(); pv(o,vb0+sl_cur,PAF(0),PAF(1),PAF(2),PAF(3)); }
  #undef PKW
  #undef PAF
  #undef VFR
  #undef PIN
  #undef MX3
  #undef GAPA
  #undef GAPB
  #undef EX
  #undef VRD
  #undef KRD
  #undef STEP
  #undef ENDW
  {auto rr=__builtin_amdgcn_permlane32_swap(__float_as_uint(l_reg),__float_as_uint(l_reg),false,false);l_reg=__uint_as_float(rr[0])+__uint_as_float(rr[1]);}
  if(u.has_sink)l_reg+=__builtin_amdgcn_exp2f(u.sinkl2-mhat);
  if(hi==0)wsf[32+r32]=l_reg;asm volatile("s_waitcnt lgkmcnt(0)":::"memory");
  float rli[16];
  #pragma unroll
  for(int r=0;r<16;++r)rli[r]=__builtin_amdgcn_rcpf(wsf[32+crow(r,hi)]);
  bf16*Ow=MIXb+(long)(u.qrow+wid*QBLK)*OP+u.ocol;
  { bf16*stg=(bf16*)(shm+LDS_OST)+wid*2048;
    #pragma unroll
    for(int r=0;r<16;++r){const int orow=crow(r,hi);
      #pragma unroll
      for(int d0=0;d0<2;++d0)stg[orow*64+d0*32+r32]=__float2bfloat16(o[d0][r]*rli[r]);}
    asm volatile("s_waitcnt lgkmcnt(0)":::"memory");
    #pragma unroll
    for(int i=0;i<4;++i){const int row=i*8+(lane>>3),ch=lane&7; const u32x4 v=*(const u32x4*)(stg+row*64+ch*8); ATTN_STORE16(Ow+(long)row*OP+ch*8,v);} }
  asm volatile("s_waitcnt lgkmcnt(0)\n\ts_barrier":::"memory");
  #undef TROW
  #undef DMA_K
  #undef DMA_V
  #undef CMASK
  #undef START
  #undef RESC
  #undef ROT
}
constexpr int ATTN_LDS_BYTES=LDS_BYTES;
#undef SBAR
#undef WAIT_BAR
}

__device__ __forceinline__ void attention_phase(const Params& P, int l, char* lds, int G, int bx, int wave_s) {
    using namespace attn_body;
    const int vcu = (G % 8 == 0) ? (bx % 8) * (G / 8) + bx / 8 : bx;
    const bf16* PLb = (const bf16*)(P.ws + WS_PL); bf16* MIXb = (bf16*)(P.ws + WS_XN);
    constexpr int NQB = SEQ / 256, NU = NB * 4 * NQB; const int ntot = 2 * NU + (l < NL - 1 ? NB * 8 : 0);
    for (int idx = vcu; idx < ntot; idx += G) {
        AttnDesc d; int type, b, hq, kvh;
        if (idx < 2 * NU) { type = idx >= NU ? 1 : 0; const int u = idx - type * NU; const int bk = u / (2 * NQB), g = (u / NQB) & 1, qb = u % NQB; b = bk >> 1; kvh = bk & 1; hq = kvh * 2 + g;
            d.qrow = b * SB + CTX + qb * 256; d.qpos0 = qb * 256; d.rowA = b * SB;
            if (type == 0) { d.rowB = b * SB + CTX; d.NT = SB / 64; d.masked = 0; d.kpos4 = 0; }
            else { const int lat0 = qb * 256 - 128 < 0 ? 0 : qb * 256 - 128, lat1 = qb * 256 + 384 > SEQ ? SEQ : qb * 256 + 384; d.rowB = b * SB + CTX + lat0; d.NT = 4 + (lat1 - lat0) / 64; d.masked = 1; d.kpos4 = lat0; } }
        else { const int u = idx - 2 * NU; type = u & 1; hq = (u >> 1) & 3; kvh = hq >> 1; b = u >> 3; d.qrow = b * SB; d.qpos0 = 0; d.rowA = b * SB; d.rowB = b * SB; d.NT = 4; d.masked = 0; d.kpos4 = 0; }
        const int cb = type ? PL_D : PL_C;
        d.qcol = cb + hq * 64; d.kcol = cb + 256 + kvh * 64; d.vcol = cb + 384 + kvh * 64; d.ocol = (type ? MIX_D : MIX_C) + hq * 64;
        d.has_sink = type; d.sinkl2 = type ? P.swa_sink[l * 4 + hq] * LOG2E : 0.f;
        attn_unit<8>(d, PLb, MIXb, lds, wave_s);
    }
}

#define GAS __attribute__((address_space(1)))
#define LAS __attribute__((address_space(3)))
typedef unsigned short bf16;
typedef unsigned v4u __attribute__((ext_vector_type(4)));
typedef float f32x4 __attribute__((ext_vector_type(4)));
typedef short bf16x8 __attribute__((ext_vector_type(8)));
typedef GAS unsigned gu32;
typedef GAS unsigned long long gu64;
#define RLX_AGENT __ATOMIC_RELAXED, __HIP_MEMORY_SCOPE_AGENT
#define LDS_WAIT() asm volatile("s_waitcnt lgkmcnt(0)" ::: "memory")
#define VM_WAIT() asm volatile("s_waitcnt vmcnt(0)" ::: "memory")
__device__ __forceinline__ unsigned long long rt() { return __builtin_amdgcn_s_memrealtime(); }
__device__ __forceinline__ unsigned pk2(float lo, float hi) { return (unsigned)f2bf(lo) | ((unsigned)f2bf(hi) << 16); }

#define XB_TMO      128
#define XB_XCNT(j)  (256  + 64 * (j))
#define XB_XSUB(j)  (1280 + 64 * (j))
#define XB_XGEN(j)  (2304 + 64 * (j))
#define XB_TOP      3328
#define XB_TOPGEN   3392
#define XCD_BAR_WORDS 3456
#define XB_SPIN_CAP (1u << 27)

__device__ __forceinline__ unsigned xb_ld(unsigned* p)              { return __hip_atomic_load(p, __ATOMIC_RELAXED, __HIP_MEMORY_SCOPE_AGENT); }
__device__ __forceinline__ unsigned xb_add(unsigned* p, unsigned v) { return __hip_atomic_fetch_add(p, v, __ATOMIC_RELAXED, __HIP_MEMORY_SCOPE_AGENT); }
__device__ __forceinline__ unsigned xb_xcc_id() { return (unsigned)__builtin_amdgcn_s_getreg((3 << 11) | 20) & 0xFu; }
#define XB_SPIN(cond, bar) do { unsigned _sp = 0; while (cond) { __builtin_amdgcn_s_sleep(1); \
    if ((++_sp & 255u) == 0u) { if (xb_ld(&(bar)[XB_TMO])) break; if (_sp > XB_SPIN_CAP) { atomicAdd(&(bar)[XB_TMO], 1u); break; } } } } while (0)

struct XcdBarrier {
    unsigned* bar; unsigned x;
    volatile LAS unsigned* st;
};

__device__ __forceinline__ XcdBarrier xcd_barrier_post(unsigned* bar, volatile LAS unsigned* st) {
    XcdBarrier b; b.bar = bar; b.x = xb_xcc_id(); b.st = st;
    if (threadIdx.x == 0) (void)xb_add(&bar[XB_XCNT(b.x)], 1u);
    return b;
}
__device__ __forceinline__ void xcd_barrier_complete(unsigned* bar, unsigned x, unsigned& nloc, unsigned& nx) {
    const unsigned G = gridDim.x * gridDim.y * gridDim.z;
    unsigned sum, cnt, mine, sp = 0u;
    for (;;) {
        sum = 0u; cnt = 0u; mine = 0u;
#pragma unroll
        for (unsigned j = 0; j < 16; ++j) { const unsigned c = xb_ld(&bar[XB_XCNT(j)]); sum += c; cnt += (c > 0u) ? 1u : 0u; mine = (j == x) ? c : mine; }
        if (sum == G) break;
        __builtin_amdgcn_s_sleep(1);
        if ((++sp & 255u) == 0u) { if (xb_ld(&bar[XB_TMO])) break; if (sp > XB_SPIN_CAP) { atomicAdd(&bar[XB_TMO], 1u); break; } }
    }
    nloc = mine > 0u ? mine : 1u; nx = cnt > 0u ? cnt : 1u;
}

__device__ __forceinline__ void xcd_barrier(const XcdBarrier& b, int wave_s) {
    asm volatile("s_waitcnt vmcnt(0)" ::: "memory");
    __syncthreads();
    if (tid_from_wave(wave_s) == 0) {
        unsigned* bar = b.bar; unsigned bx = b.x; asm volatile("" : "+s"(bar), "+s"(bx));
        __builtin_amdgcn_s_waitcnt(0);
        unsigned nloc = b.st[0], nx = b.st[1];
        if (nloc == 0u) { xcd_barrier_complete(bar, bx, nloc, nx); b.st[0] = nloc; b.st[1] = nx; }
        const unsigned old = xb_add(&bar[XB_XSUB(bx)], 1u);
        const unsigned gen = old / nloc;
        if (old + 1u == (gen + 1u) * nloc) {
            __builtin_amdgcn_fence(__ATOMIC_RELEASE, "agent");
            asm volatile("s_waitcnt vmcnt(0)" ::: "memory");
            const unsigned og = xb_add(&bar[XB_TOP], 1u);
            const unsigned tg = og / nx;
            if (og + 1u == (tg + 1u) * nx) xb_add(&bar[XB_TOPGEN], 1u);
            else XB_SPIN(xb_ld(&bar[XB_TOPGEN]) == tg, bar);
            __builtin_amdgcn_fence(__ATOMIC_ACQUIRE, "agent");
            xb_add(&bar[XB_XGEN(bx)], 1u);
            asm volatile("s_waitcnt vmcnt(0)" ::: "memory");
        } else {
            XB_SPIN(xb_ld(&bar[XB_XGEN(bx)]) == gen, bar);
            __builtin_amdgcn_fence(__ATOMIC_ACQUIRE, "agent");
            asm volatile("s_waitcnt vmcnt(0)" ::: "memory");
        }
    }
    __syncthreads();
}

__device__ __forceinline__ float frcp(float x) { return __builtin_amdgcn_rcpf(x); }
__device__ __forceinline__ float frsq(float x) { return __builtin_amdgcn_rsqf(x); }
__device__ __forceinline__ float fsqrt(float x) { return __builtin_amdgcn_sqrtf(x); }
__device__ __forceinline__ float shfl_idx_l(float v, int src) { return __int_as_float(__builtin_amdgcn_ds_bpermute(src << 2, __float_as_int(v))); }
__device__ __forceinline__ float shfl_xor_l(float v, int m, int lane) { return shfl_idx_l(v, lane ^ m); }
__device__ __forceinline__ float wave_sum(float v, int lane) {
#pragma unroll
    for (int o = 1; o < 64; o <<= 1) v += shfl_xor_l(v, o, lane);
    return v;
}
__device__ __forceinline__ void transpose_item(const float* W, int ldw, int K, bf16_t* WT, int k0, int ns, int nd, LAS float* scr, int lane) {
    const float* wp_ = W + (size_t)(k0 + (lane >> 5)) * ldw + ns + (lane & 31);
    float wv_[32];
#pragma unroll
    for (int i = 0; i < 32; ++i) { wv_[i] = *wp_; wp_ += 2 * (size_t)ldw; }
#pragma unroll
    for (int i = 0; i < 32; ++i) scr[(2 * i + (lane >> 5)) * 33 + (lane & 31)] = wv_[i];
    LDS_WAIT(); asm volatile("" ::: "memory");
    const int c = lane & 7;
#pragma unroll
    for (int j = 0; j < 4; ++j) { const int n = (lane >> 3) + 8 * j; const LAS float* s = scr + (8 * c) * 33 + n;
        v4u o; o.x = pk2(s[0 * 33], s[1 * 33]); o.y = pk2(s[2 * 33], s[3 * 33]); o.z = pk2(s[4 * 33], s[5 * 33]); o.w = pk2(s[6 * 33], s[7 * 33]);
        *(GAS v4u*)(WT + (size_t)(nd + n) * K + k0 + 8 * c) = o; }
    LDS_WAIT(); asm volatile("" ::: "memory");
}
__device__ __forceinline__ void wconv_phase(const Params& P, int l, int parts, LAS unsigned char* L, int wave, int lane, int gw, int NGW) {
    LAS float* scr = (LAS float*)(L + wave * 16384);
    constexpr int I_IN = (DM / 64) * (NPL / 32), I_OUT = (DM / 64) * (DM / 32), I_F1 = (DM / 64) * (FF / 32), I_F2 = (FF / 64) * (DM / 32);
    if (parts & 1) { for (int r = gw; r < I_IN; r += NGW) { const int nb = r % (NPL / 32), kb = r / (NPL / 32); const int nd = 32 * nb; transpose_item(P.w_in + (size_t)l * DM * 2568, 2568, DM, (bf16_t*)(P.ws + WS_WIN), 64 * kb, nd < 1024 ? nd : nd + 8, nd, scr, lane); }
        for (int i = gw * 64 + lane; i < 256 * DM / 2; i += NGW * 64) { const int j = i / (DM / 2), kx = 2 * (i % (DM / 2));
            ((uint32_t*)(P.ws + WS_WIN))[(size_t)NPL * DM / 2 + i] = j < 8 ? pk2(P.w_in[((size_t)l * DM + kx) * 2568 + 1024 + j], P.w_in[((size_t)l * DM + kx + 1) * 2568 + 1024 + j]) : 0u; } }
    if (parts & 2) for (int r = gw; r < I_OUT; r += NGW) { const int nb = r % (DM / 32), kb = r / (DM / 32); transpose_item(P.w_out + (size_t)l * DM * DM, DM, DM, (bf16_t*)(P.ws + WS_WOUT), 64 * kb, 32 * nb, 32 * nb, scr, lane); }
    if (parts & 4) for (int r = gw; r < I_F1; r += NGW) { const int nb = r % (FF / 32), kb = r / (FF / 32); transpose_item(P.w_ffn1 + (size_t)l * DM * FF, FF, DM, (bf16_t*)(P.ws + WS_WF1), 64 * kb, 32 * nb, 32 * nb, scr, lane); }
    if (parts & 8) for (int r = gw; r < I_F2; r += NGW) { const int nb = r % (DM / 32), kb = r / (DM / 32); transpose_item(P.w_ffn2 + (size_t)l * FF * DM, DM, FF, (bf16_t*)(P.ws + WS_WF2), 64 * kb, 32 * nb, 32 * nb, scr, lane); }
    if (parts & 16) { bf16_t* lwt = (bf16_t*)(P.ws + WS_LWT);
        for (int idx = gw * 64 + lane; idx < 32768; idx += NGW * 64) { const int i = idx & 63, j = (idx >> 6) & 63, kb = (idx >> 12) & 3, dir = idx >> 14; const size_t src = ((((size_t)l * 2 + dir) * 4 + kb) * 64 + i) * 64 + j;
            lwt[(size_t)(((dir * 2 + 0) * 4 + kb) * 64 + j) * 64 + i] = f2bf(P.lru_w_a[src]); lwt[(size_t)(((dir * 2 + 1) * 4 + kb) * 64 + j) * 64 + i] = f2bf(P.lru_w_i[src]); } }
}
__device__ __forceinline__ void norm_phase(const Params& P, int l, int which, int slabs, int fmt, int lane, int gw, int NGW) {
    const float* g = (which == 0 ? P.g_mix : P.g_ffn) + (size_t)l * DM; const float* wdt = (const float*)(P.ws + WS_WDT);
    for (int rb = gw; rb < MT; rb += 2 * NGW) {
        f32x4 v[2][4]; bool act[2]; int rr[2];
#pragma unroll
        for (int h = 0; h < 2; ++h) { const int r = rb + h * NGW; rr[h] = r;
            if (which == 0 && fmt == 1 && r < MT && (r % SB) >= CTX && lane == 0) ((float*)(P.ws + WS_RS2))[r] = 0.f;
            act[h] = r < MT && !(which == 1 && l == NL - 1 && (r % SB) < CTX) && !(fmt == 1 && (r % SB) >= CTX);
            if (act[h]) { const float* xr = which == 0 ? xin_row(P, l, r) : resid_row(P, r);
#pragma unroll
                for (int j = 0; j < 4; ++j) v[h][j] = *(const f32x4*)(xr + 4 * lane + 256 * j);
                if (slabs && (r % SB) < CTX) {
                    const size_t cro = ((size_t)(r / SB) * CTX + (r % SB)) * DM;
#pragma unroll
                    for (int ks = 0; ks < 4; ++ks)
#pragma unroll
                        for (int j = 0; j < 4; ++j) v[h][j] += *(const f32x4*)((const float*)(P.ws + WS_SLAB) + (size_t)ks * NB * CTX * DM + cro + 4 * lane + 256 * j);
#pragma unroll
                    for (int j = 0; j < 4; ++j) *(f32x4*)((float*)(P.ws + WS_XRC) + cro + 4 * lane + 256 * j) = v[h][j]; } } }
#pragma unroll
        for (int h = 0; h < 2; ++h) if (act[h]) { const int r = rr[h]; const float* md = mod_row(P, l, r); const float* sh = md + (which == 0 ? 0 : 3072); const float* sc = sh + 1024;
            float s = 0.f;
#pragma unroll
            for (int j = 0; j < 4; ++j) s += (v[h][j].x * v[h][j].x + v[h][j].y * v[h][j].y) + (v[h][j].z * v[h][j].z + v[h][j].w * v[h][j].w);
            const float ssum = wave_sum(s, lane); const float rs = fmt == 1 ? 1.f : frsq(ssum * (1.0f / DM) + EPS);
            if (fmt == 1 && lane == 0) ((float*)(P.ws + (which == 0 ? WS_RS1 : WS_RS2)))[r] = ssum;
            float dt[8];
#pragma unroll
            for (int jj = 0; jj < 8; ++jj) dt[jj] = 0.f;
#pragma unroll
            for (int j = 0; j < 4; ++j) { const int idx = 4 * lane + 256 * j; const f32x4 gv = *(const f32x4*)(g + idx), sv = *(const f32x4*)(sc + idx), hv = *(const f32x4*)(sh + idx);
                const f32x4 o = fmt == 1 ? (v[h][j] * gv) * (1.f + sv) : (v[h][j] * rs * gv) * (1.f + sv) + hv;
                *(unsigned long long*)((bf16_t*)(P.ws + (fmt == 1 && which == 1 ? WS_XA2 : WS_XN)) + (size_t)r * DM + idx) = (unsigned long long)pk2(o.x, o.y) | ((unsigned long long)pk2(o.z, o.w) << 32);
                if (which == 0 && fmt != 1) {
#pragma unroll
                    for (int jj = 0; jj < 8; ++jj) { const f32x4 w = *(const f32x4*)(wdt + jj * DM + idx); dt[jj] += (o.x * w.x + o.y * w.y) + (o.z * w.z + o.w * w.w); } } }
            if (which == 0 && fmt != 1) {
#pragma unroll
                for (int jj = 0; jj < 8; ++jj) dt[jj] = wave_sum(dt[jj], lane);
                if (lane == 0) { ((float*)(P.ws + WS_RS2))[r] = 0.f;
                    float* d = (float*)(P.ws + WS_DTP) + (size_t)r * 8;
#pragma unroll
                    for (int jj = 0; jj < 8; ++jj) d[jj] = dt[jj]; } } }
    }
}
__device__ __forceinline__ void norm1_phase(const Params& P, int l, int slabs, LAS unsigned char* L, int tid, int lane, int gw, int NGW) {
    LAS float* scl = (LAS float*)(L + 32768); LAS float* shl = (LAS float*)(L + 32768 + (NB + 1) * DM * 4); LAS float* gl = (LAS float*)(L + 32768 + 2 * (NB + 1) * DM * 4);
    __syncthreads();
    for (int i = tid; i < DM; i += 512) gl[i] = P.g_mix[(size_t)l * DM + i];
    for (int i = tid; i < (NB + 1) * DM; i += 512) { const float* md = (const float*)(P.ws + WS_MOD) + ((size_t)l * (NB + 1) + i / DM) * NMOD + (i % DM); shl[i] = md[0]; scl[i] = md[1024]; }
    __syncthreads();
    f32x4 vn[2][4];
#define N1_LOAD(dst, rb_) do { _Pragma("unroll") for (int h_ = 0; h_ < 2; ++h_) { const int r_ = (rb_) + h_ * NGW; if (r_ < MT) { \
        if (l > 0 && (r_ % SB) >= CTX) { const bf16_t* xb_ = (const bf16_t*)P.out + ((size_t)(r_ / SB) * SEQ + (r_ % SB - CTX)) * DM; \
            _Pragma("unroll") for (int j_ = 0; j_ < 4; ++j_) { const U2 w_ = *(const U2*)(xb_ + 4 * lane + 256 * j_); dst[h_][j_].x = __uint_as_float(w_.x); dst[h_][j_].y = __uint_as_float(w_.y); } } \
        else { const float* xr_ = xin_row(P, l, r_); \
            _Pragma("unroll") for (int j_ = 0; j_ < 4; ++j_) dst[h_][j_] = *(const f32x4*)(xr_ + 4 * lane + 256 * j_); } } } } while (0)
    N1_LOAD(vn, gw);
    for (int rb = gw; rb < MT; rb += 2 * NGW) {
        f32x4 v[2][4];
#pragma unroll
        for (int h = 0; h < 2; ++h)
#pragma unroll
            for (int j = 0; j < 4; ++j) v[h][j] = vn[h][j];
        if (rb + 2 * NGW < MT) N1_LOAD(vn, rb + 2 * NGW);
#pragma unroll
        for (int h = 0; h < 2; ++h) { const int r = rb + h * NGW; if (r < MT) { const int b_ = r / SB, s_ = r % SB; const int bm = s_ < CTX ? NB : b_;
            if (l > 0 && s_ >= CTX) {
#pragma unroll
                for (int j = 0; j < 4; ++j) { const unsigned w0 = __float_as_uint(v[h][j].x), w1 = __float_as_uint(v[h][j].y); v[h][j] = f32x4{__uint_as_float(w0 << 16), __uint_as_float(w0 & 0xffff0000u), __uint_as_float(w1 << 16), __uint_as_float(w1 & 0xffff0000u)}; } }
            if (slabs && s_ < CTX) {
                const size_t cro = ((size_t)b_ * CTX + s_) * DM;
#pragma unroll
                for (int ks = 0; ks < 4; ++ks)
#pragma unroll
                    for (int j = 0; j < 4; ++j) v[h][j] += *(const f32x4*)((const float*)(P.ws + WS_SLAB) + (size_t)ks * NB * CTX * DM + cro + 4 * lane + 256 * j);
#pragma unroll
                for (int j = 0; j < 4; ++j) *(f32x4*)((float*)(P.ws + WS_XRC) + cro + 4 * lane + 256 * j) = v[h][j]; }
            float sq = 0.f;
#pragma unroll
            for (int j = 0; j < 4; ++j) sq += (v[h][j].x * v[h][j].x + v[h][j].y * v[h][j].y) + (v[h][j].z * v[h][j].z + v[h][j].w * v[h][j].w);
            const float rs = frsq(wave_sum(sq, lane) * (1.0f / DM) + EPS);
#pragma unroll
            for (int j = 0; j < 4; ++j) { const int idx = 4 * lane + 256 * j; const f32x4 sv = *(const LAS f32x4*)(scl + bm * DM + idx), hv = *(const LAS f32x4*)(shl + bm * DM + idx);
                const f32x4 o = (v[h][j] * rs * *(const LAS f32x4*)(gl + idx)) * (1.f + sv) + hv;
                *(unsigned long long*)((bf16_t*)(P.ws + WS_XN) + (size_t)r * DM + idx) = (unsigned long long)pk2(o.x, o.y) | ((unsigned long long)pk2(o.z, o.w) << 32);
                __builtin_amdgcn_sched_barrier(0); }
            if (lane == 0) { ((float*)(P.ws + WS_RS2))[r] = 0.f; ((float*)(P.ws + WS_RS1))[r] = 0.f; }
            } }
    }
#undef N1_LOAD
    __syncthreads();
}
__device__ __forceinline__ void qk_phase(const Params& P, int l, int lane, int gw, int NGW) {
    const int l16 = lane & 15, ax = l16 >> 3, second = (l16 >> 2) & 1, tk = lane >> 5;
    f32x4 gA, gB, gC, inv;
    { const float* gq0 = P.gqa_q_norm + l * 64 + 4 * l16; const float* gq1 = P.swa_q_norm + l * 64 + 4 * l16; const float* gk0 = P.gqa_k_norm + l * 64 + 4 * l16; const float* gk1 = P.swa_k_norm + l * 64 + 4 * l16;
        gA = *(const f32x4*)gq0 * QSCALE; gB = *(const f32x4*)gq1 * QSCALE; const f32x4 k0 = *(const f32x4*)gk0, k1 = *(const f32x4*)gk1; gC = tk ? k1 : k0;
#pragma unroll
        for (int e = 0; e < 4; ++e) inv[e] = expf(-(float)(4 * (l16 & 3) + e) * (9.210340371976184f / 16.f)) * 0.15915494309189535f; }
    const int offA = PL_C + 4 * lane, offB = PL_D + 4 * lane, offC = (tk ? PL_D : PL_C) + 256 + 4 * (lane & 31);
    U2 wn[2][3];
#define QK_LOAD(dst, rb_) do { _Pragma("unroll") for (int h_ = 0; h_ < 2; ++h_) { const int r_ = (rb_) + h_ * NGW; if (r_ < MT) { const bf16_t* p_ = (const bf16_t*)(P.ws + WS_PL) + (size_t)r_ * NPL; \
        dst[h_][0] = *(const U2*)(p_ + offA); dst[h_][1] = *(const U2*)(p_ + offB); dst[h_][2] = *(const U2*)(p_ + offC); } } } while (0)
    QK_LOAD(wn, gw);
    for (int rb = gw; rb < MT; rb += 2 * NGW) {
        U2 w[2][3];
#pragma unroll
        for (int h = 0; h < 2; ++h)
#pragma unroll
            for (int c = 0; c < 3; ++c) w[h][c] = wn[h][c];
        if (rb + 2 * NGW < MT) QK_LOAD(wn, rb + 2 * NGW);
#pragma unroll
        for (int h = 0; h < 2; ++h) { const int r = rb + h * NGW; if (r < MT) { const int s = r % SB; bf16_t* p = (bf16_t*)(P.ws + WS_PL) + (size_t)r * NPL;
            f32x4 cs = {1.f, 1.f, 1.f, 1.f}, sn = {0.f, 0.f, 0.f, 0.f};
            if (s >= CTX) { const int pos = s - CTX; const float pc = (float)(ax ? pos % GRIDW : pos / GRIDW);
#pragma unroll
                for (int e = 0; e < 4; ++e) { const float rev = pc * inv[e]; cs[e] = __builtin_amdgcn_cosf(rev); sn[e] = __builtin_amdgcn_sinf(rev); } }
            if (!second) sn = -sn;
#pragma unroll
            for (int c = 0; c < 3; ++c) { const f32x4 g = c == 0 ? gA : (c == 1 ? gB : gC);
                f32x4 x = {__uint_as_float(w[h][c].x << 16), __uint_as_float(w[h][c].x & 0xffff0000u), __uint_as_float(w[h][c].y << 16), __uint_as_float(w[h][c].y & 0xffff0000u)};
                float ss = (x.x * x.x + x.y * x.y) + (x.z * x.z + x.w * x.w);
#pragma unroll
                for (int o = 1; o < 16; o <<= 1) ss += shfl_xor_l(ss, o, lane);
                const float rs = frsq(ss * (1.0f / 64) + EPS);
                x = x * rs * g;
                f32x4 pt; pt.x = shfl_xor_l(x.x, 4, lane); pt.y = shfl_xor_l(x.y, 4, lane); pt.z = shfl_xor_l(x.z, 4, lane); pt.w = shfl_xor_l(x.w, 4, lane);
                x = x * cs + pt * sn;
                U2 o2; o2.x = pk2(x.x, x.y); o2.y = pk2(x.z, x.w);
                *(U2*)(p + (c == 0 ? offA : (c == 1 ? offB : offC))) = o2; } } }
    }
#undef QK_LOAD
}
__device__ __forceinline__ void prep_phase(const Params& P, int l, LAS unsigned char* L, int tid, int vcu, int G) {
    constexpr int TP = 136;
    LAS bf16_t* OT = (LAS bf16_t*)L;
    const int cp = tid & 127, tq = tid >> 7;
    for (int u = vcu; u < NB * NCH * 5; u += G) {
        const int bc = u / 5, part = u % 5; const int b = bc / NCH, c = bc % NCH; const int s0 = c * CHK; const int lo = s0 < CTX ? 0 : CTX, hi = s0 < CTX ? CTX : SB;
        const bf16_t* pl = (const bf16_t*)(P.ws + WS_PL) + (size_t)b * SB * NPL + (part < 3 ? PL_XBC + 256 * part : part == 3 ? PL_LX : PL_Z) + 2 * cp;
        float w0[4], w1[4], b0 = 0.f, b1 = 0.f;
#pragma unroll
        for (int t = 0; t < 4; ++t) { w0[t] = 0.f; w1[t] = 0.f; }
        if (part < 3) { const int ch = 256 * part + 2 * cp;
#pragma unroll
            for (int t = 0; t < 4; ++t) { w0[t] = P.ssd_conv_w[(l * 4 + t) * 768 + ch]; w1[t] = P.ssd_conv_w[(l * 4 + t) * 768 + ch + 1]; }
            b0 = P.ssd_conv_b[l * 768 + ch]; b1 = P.ssd_conv_b[l * 768 + ch + 1]; }
        else if (part == 3) {
#pragma unroll
            for (int t = 0; t < 4; ++t) { w0[t] = P.lru_conv_w[(l * 4 + t) * 256 + 2 * cp]; w1[t] = P.lru_conv_w[(l * 4 + t) * 256 + 2 * cp + 1]; }
            b0 = P.lru_conv_b[l * 256 + 2 * cp]; b1 = P.lru_conv_b[l * 256 + 2 * cp + 1]; }
        else { w0[2] = 1.f; w1[2] = 1.f; }
        const int sA = s0 + 32 * tq;
        auto ldrow = [&](int ss) -> unsigned { return (ss >= lo && ss < hi) ? *(const unsigned*)(pl + (size_t)ss * NPL) : 0u; };
        unsigned xr[35];
#pragma unroll
        for (int i = 0; i < 35; ++i) xr[i] = ldrow(sA - 2 + i);
        const bool tr = (part == 0 || part == 1 || part == 4);
#pragma unroll
        for (int i = 0; i < 32; ++i) { const int ss = sA + i; const unsigned xm2 = xr[i], xm1 = xr[i + 1], x0 = xr[i + 2], xp1 = xr[i + 3];
            float a0 = b0 + w0[0] * bflo(xm2) + w0[1] * bflo(xm1) + w0[2] * bflo(x0) + w0[3] * bflo(xp1);
            float a1 = b1 + w1[0] * bfhi(xm2) + w1[1] * bfhi(xm1) + w1[2] * bfhi(x0) + w1[3] * bfhi(xp1);
            if (part < 3) { a0 = a0 * frcp(1.f + __expf(-a0)); a1 = a1 * frcp(1.f + __expf(-a1)); }
            const unsigned o = part == 4 ? x0 : pk2(a0, a1); const size_t r = (size_t)b * SB + ss;
            if (part == 1 || part == 2) *(unsigned*)((bf16_t*)(P.ws + WS_XBC) + r * XBP + 256 * (part - 1) + 2 * cp) = o;
            else if (part == 3) *(unsigned*)((bf16_t*)(P.ws + WS_XLC) + r * 256 + 2 * cp) = o;
            if (tr) { OT[(2 * cp) * TP + 32 * tq + i] = (bf16_t)(o & 0xffffu); OT[(2 * cp + 1) * TP + 32 * tq + i] = (bf16_t)(o >> 16); } }
        if (tr) { __syncthreads();
            bf16_t* dst = (bf16_t*)(P.ws + (part == 0 ? WS_XT : part == 1 ? WS_BT : WS_ZT)) + (size_t)bc * 256 * CHK;
#pragma unroll
            for (int k = 0; k < 8; ++k) { const int piece = tid + 512 * k; const int ch = piece >> 4, q = piece & 15; *(GAS v4u*)(dst + (size_t)ch * CHK + 8 * q) = *(const LAS v4u*)(OT + ch * TP + 8 * q); }
            __syncthreads(); }
    }
}

namespace ssdk {
typedef short bf16x8 __attribute__((ext_vector_type(8)));
typedef float f32x16 __attribute__((ext_vector_type(16)));
typedef float f32x2_t __attribute__((ext_vector_type(2))); typedef __bf16 bf16x2_t __attribute__((ext_vector_type(2)));
typedef unsigned u32x2 __attribute__((ext_vector_type(2)));
__device__ __forceinline__ unsigned cvtpk(float lo, float hi) { f32x2_t v = {lo, hi}; bf16x2_t b = __builtin_convertvector(v, bf16x2_t); return __builtin_bit_cast(unsigned, b); }
#define SSD_MFMA(a, b, c) __builtin_amdgcn_mfma_f32_32x32x16_bf16(a, b, c, 0, 0, 0)
__device__ __forceinline__ int drow(int q, int hh) { return (q & 3) + 8 * (q >> 2) + 4 * hh; }

__device__ __forceinline__ void ssd_state_item(const Params& P, int l, LAS unsigned char* L, int tid, int bc, int hd, int dir) {
    const int lane = tid & 63, wid = __builtin_amdgcn_readfirstlane(tid >> 6), r32 = lane & 31, hh = lane >> 5;
    LAS float* wl = (LAS float*)(L + wid * 512);
    float* sc4w = (float*)(P.ws + WS_SC4); const float* dtp = (const float*)(P.ws + WS_DTP);
    const float a2 = -expf(P.ssd_a_log[(l * 2 + dir) * 4 + hd]) * LOG2E, dtb = P.ssd_dt_bias[(l * 2 + dir) * 4 + hd];
    {
        const size_t r0 = (size_t)bc * CHK;
        const bf16_t* xt = (const bf16_t*)(P.ws + WS_XT) + ((size_t)bc * 256 + hd * 64 + r32) * CHK + 8 * hh;
        const bf16_t* bt = (const bf16_t*)(P.ws + WS_BT) + ((size_t)bc * 256 + (hd >> 1) * 128 + r32) * CHK + 8 * hh;
        v4u xq[8][2]; bf16x8 bq[8][2];
        float dtv[2], cum[2]; int tk[2]; float carry = 0.f;
#pragma unroll
        for (int jj = 0; jj < 2; ++jj) { const int idx = lane + 64 * jj; tk[jj] = dir ? CHK - 1 - idx : idx; dtv[jj] = dtp[(r0 + tk[jj]) * 8 + dir * 4 + hd]; }
#pragma unroll
        for (int s = 0; s < 8; ++s) {
#pragma unroll
            for (int pt = 0; pt < 2; ++pt) xq[s][pt] = *(const GAS v4u*)(xt + (size_t)pt * 32 * CHK + 16 * s);
#pragma unroll
            for (int nt = 0; nt < 2; ++nt) bq[s][nt] = *(const GAS bf16x8*)(bt + (size_t)nt * 32 * CHK + 16 * s); }
#pragma unroll
        for (int jj = 0; jj < 2; ++jj) { dtv[jj] = softplus_f(dtv[jj] + dtb); float v = dtv[jj] * a2;
#pragma unroll
            for (int o = 1; o < 64; o <<= 1) { const float t = shfl_idx_l(v, (lane - o) & 63); if (lane >= o) v += t; }
            cum[jj] = v + carry; carry = shfl_idx_l(cum[jj], 63); }
        const float aend = carry;
#pragma unroll
        for (int jj = 0; jj < 2; ++jj) { float* so4 = sc4w + ((r0 + tk[jj]) * 4 + hd) * 4 + dir * 2; so4[0] = cum[jj]; so4[1] = dtv[jj]; wl[tk[jj]] = __builtin_amdgcn_exp2f(aend - cum[jj]) * dtv[jj]; }
        if (lane == 0) ((float*)(P.ws + WS_DEC))[((size_t)bc * 4 + hd) * 2 + dir] = __builtin_amdgcn_exp2f(aend);
        LDS_WAIT(); asm volatile("" ::: "memory");
        bf16_t* so = (bf16_t*)(P.ws + WS_SST) + (((size_t)bc * 4 + hd) * 2 + dir) * 8192 + (size_t)r32 * 128 + 4 * hh;
#pragma unroll
        for (int pass = 0; pass < 2; ++pass) {
            f32x16 acc[2][2];
#pragma unroll
            for (int a = 0; a < 2; ++a)
#pragma unroll
                for (int b = 0; b < 2; ++b) acc[a][b] = f32x16{};
#pragma unroll
            for (int s = 0; s < 8; ++s) {
                if (pass == 0) { const f32x4 w0 = *(const LAS f32x4*)(wl + 16 * s + 8 * hh), w1 = *(const LAS f32x4*)(wl + 16 * s + 8 * hh + 4);
#pragma unroll
                    for (int pt = 0; pt < 2; ++pt) { const v4u raw = xq[s][pt];
                        v4u o; o.x = cvtpk(bflo(raw.x) * w0.x, bfhi(raw.x) * w0.y); o.y = cvtpk(bflo(raw.y) * w0.z, bfhi(raw.y) * w0.w); o.z = cvtpk(bflo(raw.z) * w1.x, bfhi(raw.z) * w1.y); o.w = cvtpk(bflo(raw.w) * w1.z, bfhi(raw.w) * w1.w);
                        xq[s][pt] = o; } }
#pragma unroll
                for (int pt = 0; pt < 2; ++pt)
#pragma unroll
                    for (int nt = 0; nt < 2; ++nt) acc[pt][nt] = SSD_MFMA(bq[s][nt], __builtin_bit_cast(bf16x8, xq[s][pt]), acc[pt][nt]);
                __builtin_amdgcn_sched_barrier(0);
                if (pass == 0) {
#pragma unroll
                    for (int nt = 0; nt < 2; ++nt) bq[s][nt] = *(const GAS bf16x8*)(bt + (size_t)(2 + nt) * 32 * CHK + 16 * s); }
                __builtin_amdgcn_sched_barrier(0);
            }
#pragma unroll
            for (int pt = 0; pt < 2; ++pt)
#pragma unroll
                for (int nt = 0; nt < 2; ++nt)
#pragma unroll
                    for (int gq = 0; gq < 4; ++gq) { U2 w; w.x = cvtpk(acc[pt][nt][4 * gq], acc[pt][nt][4 * gq + 1]); w.y = cvtpk(acc[pt][nt][4 * gq + 2], acc[pt][nt][4 * gq + 3]);
                        *(U2*)(so + (size_t)(32 * pt) * 128 + 64 * pass + 32 * nt + 8 * gq) = w; }
        }
        LDS_WAIT(); asm volatile("" ::: "memory");
    }
}
template <int ABL = 0> __device__ __forceinline__ void ssd_out_phase(const Params& P, int l, LAS unsigned char* L, int wave_s, int vcu, int nssd) {
    const int wid = wave_s; const int hd = wid & 3, hb = wid >> 2, g = hd >> 1;
    LAS f32x4* sc = (LAS f32x4*)(L + hb * 8192);
    LAS float* SS = (LAS float*)(L + 16384 + hb * 512);
    constexpr int OP_ = 72;
    LAS bf16_t* OST = (LAS bf16_t*)(L + 32768 + wid * (32 * OP_ * 2));
    constexpr int CTP = 264;
    LAS bf16_t* CT = (LAS bf16_t*)(L + 73728 + hb * (32 * CTP * 2));
    const float dsk = P.ssd_d[l * 4 + hd];
    const float* sc4 = (const float*)(P.ws + WS_SC4); const bf16_t* xbc = (const bf16_t*)(P.ws + WS_XBC);
    const int nlat = l == NL - 1;
    const int ntile = nlat ? NB * (NCH - NCC) * 4 : NB * NCH * 4;
    const int extra = ntile - 2 * nssd; const bool paired = extra > 0 && (extra & 1) == 0 && (extra >> 1) <= nssd && 4 * (extra >> 1) + 2 * (nssd - (extra >> 1)) == ntile; const int nd = extra >> 1;
    const int ntl = vcu >= nssd ? 0 : (paired ? (vcu < nd ? 2 : 1) : (ntile - (2 * vcu + hb) + 2 * nssd - 1) / (2 * nssd));
    for (int it = 0; it < ntl; ++it) {
        int cq, ti;
        if (paired) { if (vcu < nd) { cq = vcu; ti = 2 * hb + it; } else { const int Tr = 2 * (vcu - nd) + hb; cq = nd + (Tr >> 2); ti = Tr & 3; } }
        else { const int T = 2 * vcu + hb + it * 2 * nssd; cq = T >> 2; ti = T & 3; }
        const int bc = nlat ? cq + NCC * (cq / (NCH - NCC) + 1) : cq; const size_t r0 = (size_t)bc * CHK;
        const int tid = tid_from_wave(wave_s); const int lane = tid & 63, r32 = lane & 31, hh = lane >> 5, th = tid & 255;
        __syncthreads();
#pragma unroll
        for (int k2 = 0; k2 < 2; ++k2) { const int e = th + 256 * k2; sc[(e & 3) * 128 + (e >> 2)] = *(const GAS f32x4*)(sc4 + ((r0 + (e >> 2)) * 4 + (e & 3)) * 4); }
#pragma unroll
        for (int k4 = 0; k4 < 4; ++k4) { const int e = th + 256 * k4; *(LAS v4u*)(CT + (e >> 5) * CTP + (e & 31) * 8) = *(const GAS v4u*)(xbc + (r0 + 32 * ti + (e >> 5)) * XBP + 256 + (e & 31) * 8); }
        __syncthreads();
        f32x16 val[2];
        {
            {
            const int il = 32 * ti + r32; const f32x4 sci = sc[hd * 128 + il]; const float acf = sci.x, acb = sci.z;
            const LAS bf16_t* cfp = CT + r32 * CTP + g * 128 + 8 * hh;
            const bf16_t* xt = (const bf16_t*)(P.ws + WS_XT) + ((size_t)bc * 256 + hd * 64 + r32) * CHK + 4 * hh;
            const bf16_t* bp0 = xbc + (r0 + r32) * XBP + g * 128 + 8 * hh;
#define SSD_CF(s_) (*(const LAS bf16x8*)(cfp + 16 * (s_)))
            bf16x8 bcur[8];
#pragma unroll
            for (int s = 0; s < 8; ++s) bcur[s] = *(const GAS bf16x8*)(bp0 + 16 * s);
            f32x16 yt[2]; yt[0] = f32x16{}; yt[1] = f32x16{};
            if (!(ABL & 1)) { bf16x8 hf[2][2][4]; f32x16 tt[2];
#define HF_LOAD(buf_, g_) do { const bf16_t* hs_ = (const bf16_t*)(P.ws + WS_SST) + ((((size_t)bc * 4 + hd) * 2 + ((g_) >> 1)) * 64 + r32) * 128 + 8 * hh; \
                _Pragma("unroll") for (int s_ = 0; s_ < 4; ++s_) _Pragma("unroll") for (int pt_ = 0; pt_ < 2; ++pt_) hf[buf_][pt_][s_] = *(const GAS bf16x8*)(hs_ + (size_t)pt_ * 32 * 128 + 16 * (4 * ((g_) & 1) + s_)); } while (0)
                HF_LOAD(0, 0); HF_LOAD(1, 1);
#pragma unroll
                for (int g4 = 0; g4 < 4; ++g4) { const int dir = g4 >> 1, sh = g4 & 1;
                    if (sh == 0) { tt[0] = f32x16{}; tt[1] = f32x16{}; }
#pragma unroll
                    for (int s = 0; s < 4; ++s)
#pragma unroll
                        for (int pt = 0; pt < 2; ++pt) tt[pt] = SSD_MFMA(hf[g4 & 1][pt][s], SSD_CF(4 * sh + s), tt[pt]);
                    __builtin_amdgcn_sched_barrier(0);
                    if (g4 + 2 < 4) HF_LOAD(g4 & 1, g4 + 2);
                    if (sh == 1) { const float e = __builtin_amdgcn_exp2f(dir ? acb : acf); yt[0] += tt[0] * e; yt[1] += tt[1] * e; }
                    __builtin_amdgcn_sched_barrier(0); }
#undef HF_LOAD
            }
#pragma unroll
            for (int jt = 0; jt < ((ABL & 2) ? 0 : 4); ++jt) {
                bf16x8 bnxt[8]; u32x2 xcur[8];
#pragma unroll
                for (int e = 0; e < 8; ++e) xcur[e] = *(const GAS u32x2*)(xt + (size_t)(e >> 2) * 32 * CHK + 32 * jt + 16 * ((e >> 1) & 1) + 8 * (e & 1));
                if (jt < 3) {
#pragma unroll
                    for (int s = 0; s < 8; ++s) bnxt[s] = *(const GAS bf16x8*)(bp0 + (size_t)(32 * (jt + 1)) * XBP + 16 * s); }
                f32x16 gt = f32x16{};
#pragma unroll
                for (int s = 0; s < 8; ++s) gt = SSD_MFMA(bcur[s], SSD_CF(s), gt);
#pragma unroll
                for (int q4 = 0; q4 < 4; ++q4) {
#pragma unroll
                    for (int e = 0; e < 4; ++e) { const int q = 4 * q4 + e; const int j = 32 * jt + drow(q, hh); const f32x4 sj = sc[hd * 128 + j];
                        const float af_ = j <= il ? acf - sj.x : -INFINITY, ab_ = j >= il ? acb - sj.z : -INFINITY;
                        gt[q] *= __builtin_amdgcn_exp2f(af_) * sj.y + __builtin_amdgcn_exp2f(ab_) * sj.w; }
                    __builtin_amdgcn_sched_barrier(0); }
#pragma unroll
                for (int sp = 0; sp < 2; ++sp) { v4u o; o.x = cvtpk(gt[8 * sp + 0], gt[8 * sp + 1]); o.y = cvtpk(gt[8 * sp + 2], gt[8 * sp + 3]); o.z = cvtpk(gt[8 * sp + 4], gt[8 * sp + 5]); o.w = cvtpk(gt[8 * sp + 6], gt[8 * sp + 7]);
                    const bf16x8 wt = __builtin_bit_cast(bf16x8, o);
#pragma unroll
                    for (int pt = 0; pt < 2; ++pt) { const v4u a4 = {xcur[pt * 4 + sp * 2].x, xcur[pt * 4 + sp * 2].y, xcur[pt * 4 + sp * 2 + 1].x, xcur[pt * 4 + sp * 2 + 1].y}; yt[pt] = SSD_MFMA(__builtin_bit_cast(bf16x8, a4), wt, yt[pt]); } }
                __builtin_amdgcn_sched_barrier(0);
                if (jt < 3) {
#pragma unroll
                    for (int s = 0; s < 8; ++s) bcur[s] = bnxt[s]; }
            }
            float ss = 0.f; const bf16_t* xg = (const bf16_t*)(P.ws + WS_XT) + ((size_t)bc * 256 + hd * 64) * CHK + il; const bf16_t* zg = (const bf16_t*)(P.ws + WS_ZT) + ((size_t)bc * 256 + hd * 64) * CHK + il;
#pragma unroll
            for (int pt = 0; pt < 2; ++pt)
#pragma unroll
                for (int q = 0; q < 16; ++q) { const int p = 32 * pt + drow(q, hh); const float xv = (ABL & 4) ? 1.f : bf2f(xg[(size_t)p * CHK]), zv = (ABL & 4) ? 1.f : bf2f(zg[(size_t)p * CHK]);
                    const float v = (yt[pt][q] + dsk * xv) * (zv * frcp(1.f + __expf(-zv))); val[pt][q] = v; ss += v * v; }
            ss += shfl_xor_l(ss, 32, lane);
            if (hh == 0) SS[hd * 32 + r32] = ss;
            __syncthreads();
            }
            {
            const int tid = tid_from_wave(wave_s); const int lane = tid & 63, r32 = lane & 31, hh = lane >> 5;
            const float tot = (SS[r32] + SS[32 + r32]) + (SS[64 + r32] + SS[96 + r32]); const float rs = frsq(tot * (1.0f / 256) + EPS);
#pragma unroll
            for (int pt = 0; pt < 2; ++pt)
#pragma unroll
                for (int q4 = 0; q4 < 4; ++q4) { const int p0 = 32 * pt + 8 * q4 + 4 * hh; const f32x4 gn = *(const f32x4*)(P.ssd_norm_g + l * 256 + hd * 64 + p0);
                    u32x2 o; o.x = cvtpk(val[pt][4 * q4 + 0] * rs * gn.x, val[pt][4 * q4 + 1] * rs * gn.y); o.y = cvtpk(val[pt][4 * q4 + 2] * rs * gn.z, val[pt][4 * q4 + 3] * rs * gn.w);
                    *(LAS u32x2*)(OST + r32 * OP_ + p0) = o; }
            LDS_WAIT(); asm volatile("" ::: "memory");
            bf16_t* mixo = (bf16_t*)(P.ws + WS_XN) + (r0 + 32 * ti) * DM + MIX_A + hd * 64;
#pragma unroll
            for (int k = 0; k < 4; ++k) { const int piece = lane + 64 * k; const int tok = piece >> 3, q8 = piece & 7; *(GAS v4u*)(mixo + (size_t)tok * DM + q8 * 8) = *(const LAS v4u*)(OST + tok * OP_ + q8 * 8); }
            LDS_WAIT(); asm volatile("" ::: "memory");
            }
            __syncthreads();
        }
    }
}
}

namespace lruk {
using ssdk::bf16x8; using ssdk::f32x16; using ssdk::drow;
__device__ __forceinline__ void lru_gate_half(const Params& P, int l, int tid, int bc, int k, int dir, int ct) {
    const int lane = tid & 63, r32 = lane & 31, hh = lane >> 5;
    const bf16_t* lwt = (const bf16_t*)(P.ws + WS_LWT); const bf16_t* xlc = (const bf16_t*)(P.ws + WS_XLC); uint32_t* lab = (uint32_t*)(P.ws + WS_LAB);
    const int ch = k * 64 + 32 * ct + r32;
    const float ba = -LOG2E * P.lru_b_a[(l * 2 + dir) * 256 + ch], bi = -LOG2E * P.lru_b_i[(l * 2 + dir) * 256 + ch], c8 = -8.0f * LOG2E * softplus_f(-P.lru_lambda[(l * 2 + dir) * 256 + ch]);
    bf16x8 bw[2][4];
#pragma unroll
    for (int gate = 0; gate < 2; ++gate)
#pragma unroll
        for (int s = 0; s < 4; ++s) bw[gate][s] = *(const GAS bf16x8*)(lwt + ((size_t)(((dir * 2 + gate) * 4 + k) * 64 + 32 * ct + r32)) * 64 + 16 * s + 8 * hh);
    {
        const size_t r0 = (size_t)bc * CHK; float hrun = 0.f, cprun = 1.f;
        bf16x8 ax[4], axn[4]; uint32_t xq[16], xqn[16];
#define LRU_LOADA(AX, rt_) do { _Pragma("unroll") for (int s_ = 0; s_ < 4; ++s_) AX[s_] = *(const GAS bf16x8*)(xlc + (r0 + 32 * (rt_) + r32) * 256 + k * 64 + 16 * s_ + 8 * hh); } while (0)
#define LRU_LOADX(XQ, rt_) do { _Pragma("unroll") for (int q_ = 0; q_ < 16; ++q_) XQ[q_] = xlc[(r0 + 32 * (rt_) + 8 * (q_ >> 2) + 4 * hh + (q_ & 3)) * 256 + ch]; } while (0)
        LRU_LOADA(ax, dir ? 3 : 0); LRU_LOADX(xq, dir ? 3 : 0);
#pragma unroll
        for (int s = 0; s < 4; ++s) asm volatile("" : "+v"(ax[s]));
#pragma unroll
        for (int q = 0; q < 16; ++q) asm volatile("" : "+v"(xq[q]));
#pragma unroll 1
        for (int kk = 0; kk < 4; ++kk) { const int rt = dir ? 3 - kk : kk;
            f32x16 acc[2];
#pragma unroll
            for (int gate = 0; gate < 2; ++gate) { acc[gate] = f32x16{};
#pragma unroll
                for (int s = 0; s < 4; ++s) acc[gate] = SSD_MFMA(ax[s], bw[gate][s], acc[gate]); }
            if (kk < 3) { LRU_LOADA(axn, dir ? 2 - kk : kk + 1); LRU_LOADX(xqn, dir ? 2 - kk : kk + 1); }
            { float Ag[4], Bg[4];
#pragma unroll
                for (int m = 0; m < 4; ++m) { float a_[4], b_[4]; uint32_t* lrow = lab + ((size_t)dir * MT + r0 + 32 * rt + 8 * m + 4 * hh) * 256 + ch;
#pragma unroll
                    for (int e = 0; e < 4; ++e) { const int q = 4 * m + e;
                        const float sa = frcp(1.f + __builtin_amdgcn_exp2f(__builtin_fmaf(acc[0][q], -LOG2E, ba))), si = frcp(1.f + __builtin_amdgcn_exp2f(__builtin_fmaf(acc[1][q], -LOG2E, bi)));
                        const float la2 = c8 * sa, av = __builtin_amdgcn_exp2f(la2);
                        const float bb = fsqrt(__builtin_fmaxf(__builtin_fmaf(-av, av, 1.f), 0.f)) * (si * __uint_as_float(xq[q] << 16));
                        lrow[e * 256] = ssdk::cvtpk(la2, bb);
                        a_[e] = av; b_[e] = bb; }
                    Ag[m] = (a_[0] * a_[1]) * (a_[2] * a_[3]);
                    Bg[m] = dir ? ((b_[3] * a_[2] + b_[2]) * a_[1] + b_[1]) * a_[0] + b_[0] : ((b_[0] * a_[1] + b_[1]) * a_[2] + b_[2]) * a_[3] + b_[3]; }
                if (dir) { float t_; t_ = Ag[0]; Ag[0] = Ag[3]; Ag[3] = t_; t_ = Ag[1]; Ag[1] = Ag[2]; Ag[2] = t_; t_ = Bg[0]; Bg[0] = Bg[3]; Bg[3] = t_; t_ = Bg[1]; Bg[1] = Bg[2]; Bg[2] = t_; }
#pragma unroll
                for (int gs = 0; gs < 8; ++gs) { const int m = gs >> 1; const bool own = ((gs & 1) ^ dir) == hh;
                    const float Ap = shfl_xor_l(Ag[m], 32, lane), Bp = shfl_xor_l(Bg[m], 32, lane); const float A = own ? Ag[m] : Ap, B = own ? Bg[m] : Bp;
                    hrun = A * hrun + B; cprun *= A; } }
            if (kk < 3) {
#pragma unroll
                for (int s = 0; s < 4; ++s) ax[s] = axn[s];
#pragma unroll
                for (int q = 0; q < 16; ++q) xq[q] = xqn[q]; }
        }
#undef LRU_LOADA
#undef LRU_LOADX
        if (hh == 0) { const size_t idx = ((size_t)bc * 2 + dir) * 256 + ch; ((float*)(P.ws + WS_LHE))[idx] = hrun; ((float*)(P.ws + WS_LCP))[idx] = cprun; }
    }
}
__device__ __forceinline__ void lru_final_phase(const Params& P, LAS unsigned char* L, int tid, int u0, int ustep, int skip_ctx) {
    LAS bf16_t* HL = (LAS bf16_t*)L; const int ch = tid & 255, dir = tid >> 8;
    for (int bc = u0; bc < NB * NCH; bc += ustep) {
        if (skip_ctx && (bc % NCH) < NCC) continue;
        const size_t r0 = (size_t)bc * CHK; const uint32_t* lab = (const uint32_t*)(P.ws + WS_LAB) + ((size_t)dir * MT + r0) * 256 + ch;
        float h = ((const float*)(P.ws + WS_LCI))[((size_t)bc * 2 + dir) * 256 + ch];
        __syncthreads();
#pragma unroll 1
        for (int ib = 0; ib < CHK; ib += 32) { uint32_t wv[32];
#pragma unroll
            for (int k = 0; k < 32; ++k) wv[k] = lab[(size_t)(dir ? CHK - 1 - (ib + k) : ib + k) * 256];
#pragma unroll
            for (int k = 0; k < 32; ++k) { const int tok = dir ? CHK - 1 - (ib + k) : ib + k; h = __builtin_amdgcn_exp2f(bflo(wv[k])) * h + bfhi(wv[k]); HL[(dir * CHK + tok) * 256 + ch] = (bf16_t)ssdk::cvtpk(h, h); } }
        __syncthreads();
#pragma unroll
        for (int kq = 0; kq < 8; ++kq) { const int piece = tid + 512 * kq; const int tok = piece >> 5, q = piece & 31;
            const v4u hf = *(const LAS v4u*)(HL + tok * 256 + 8 * q), hb = *(const LAS v4u*)(HL + (CHK + tok) * 256 + 8 * q);
            const v4u gv = *(const GAS v4u*)((const bf16_t*)(P.ws + WS_PL) + (r0 + tok) * NPL + PL_LG + 8 * q);
            v4u o; const unsigned hfw[4] = {hf.x, hf.y, hf.z, hf.w}, hbw[4] = {hb.x, hb.y, hb.z, hb.w}, gw_[4] = {gv.x, gv.y, gv.z, gv.w}; unsigned ow[4];
#pragma unroll
            for (int e = 0; e < 4; ++e) { const float g0 = bflo(gw_[e]), g1 = bfhi(gw_[e]);
                const float t0 = 0.7978845608028654f * (g0 + 0.044715f * g0 * g0 * g0), t1 = 0.7978845608028654f * (g1 + 0.044715f * g1 * g1 * g1);
                const float ge0 = g0 * frcp(1.f + __expf(-2.f * t0)), ge1 = g1 * frcp(1.f + __expf(-2.f * t1));
                ow[e] = pk2((bflo(hfw[e]) + bflo(hbw[e])) * ge0, (bfhi(hfw[e]) + bfhi(hbw[e])) * ge1); }
            o.x = ow[0]; o.y = ow[1]; o.z = ow[2]; o.w = ow[3];
            *(GAS v4u*)((bf16_t*)(P.ws + WS_XN) + (r0 + tok) * DM + MIX_B + 8 * q) = o; }
    }
}
}
__device__ __forceinline__ void bias_phase(const Params& P, LAS unsigned char* L, int tid, int vcu, int G) {
    LAS float* SH = (LAS float*)L; LAS float* RED = (LAS float*)(L + 32768); const int lane = tid & 63, wid = tid >> 6;
    for (int u = vcu; u < NL * (FF / 64); u += G) { const int l = u / (FF / 64), n0 = (u % (FF / 64)) * 64;
        __syncthreads();
        for (int i = tid; i < (NB + 1) * DM; i += 512) SH[i] = ((const float*)(P.ws + WS_MOD))[((size_t)l * (NB + 1) + i / DM) * NMOD + 3072 + (i % DM)];
        __syncthreads();
        float acc[NB + 1];
#pragma unroll
        for (int r = 0; r <= NB; ++r) acc[r] = 0.f;
        const float* wp = P.w_ffn1 + ((size_t)l * DM + 128 * wid) * FF + n0 + lane;
#pragma unroll 1
        for (int kb = 0; kb < 128; kb += 32) { float wv[32];
#pragma unroll
            for (int kx = 0; kx < 32; ++kx) wv[kx] = wp[(size_t)(kb + kx) * FF];
#pragma unroll
            for (int kx = 0; kx < 32; ++kx)
#pragma unroll
                for (int r = 0; r <= NB; ++r) acc[r] += SH[r * DM + 128 * wid + kb + kx] * wv[kx]; }
#pragma unroll
        for (int r = 0; r <= NB; ++r) RED[(wid * (NB + 1) + r) * 64 + lane] = acc[r];
        __syncthreads();
        if (tid < (NB + 1) * 64) { const int r = tid >> 6; float sv = 0.f;
#pragma unroll
            for (int w = 0; w < 8; ++w) sv += RED[(w * (NB + 1) + r) * 64 + lane];
            ((float*)(P.ws + WS_BF1))[((size_t)l * (NB + 1) + r) * FF + n0 + lane] = sv; }
    }
    __syncthreads();
}
__device__ __forceinline__ void bin_phase(const Params& P, int l, LAS unsigned char* L, int tid, int vcu, int G) {
    LAS float* SH = (LAS float*)L; LAS float* RED = (LAS float*)(L + 32768); const int lane = tid & 63, wid = tid >> 6;
    for (int u = vcu; u < NPL / 64 + 1; u += G) { const int n0 = u * 64; const int n = n0 + lane; const bool ok = n < NPL + 8; const int col = n < 1024 ? n : (n < NPL ? n + 8 : 1024 + (n - NPL));
        __syncthreads();
        for (int i = tid; i < (NB + 1) * DM; i += 512) SH[i] = ((const float*)(P.ws + WS_MOD))[((size_t)l * (NB + 1) + i / DM) * NMOD + (i % DM)];
        __syncthreads();
        float acc[NB + 1];
#pragma unroll
        for (int r = 0; r <= NB; ++r) acc[r] = 0.f;
        const float* wp = P.w_in + ((size_t)l * DM + 128 * wid) * 2568 + (ok ? col : 0);
#pragma unroll 1
        for (int kb = 0; kb < 128; kb += 32) { float wv[32];
#pragma unroll
            for (int kx = 0; kx < 32; ++kx) wv[kx] = wp[(size_t)(kb + kx) * 2568];
#pragma unroll
            for (int kx = 0; kx < 32; ++kx)
#pragma unroll
                for (int r = 0; r <= NB; ++r) acc[r] += SH[r * DM + 128 * wid + kb + kx] * wv[kx]; }
#pragma unroll
        for (int r = 0; r <= NB; ++r) RED[(wid * (NB + 1) + r) * 64 + lane] = acc[r];
        __syncthreads();
        if (tid < (NB + 1) * 64) { const int r = tid >> 6; float sv = 0.f;
#pragma unroll
            for (int w = 0; w < 8; ++w) sv += RED[(w * (NB + 1) + r) * 64 + lane];
            ((float*)(P.ws + WS_BIN))[(size_t)r * (NPL + 256) + n0 + lane] = ok ? sv : 0.f; }
    }
    __syncthreads();
}
__device__ __forceinline__ void mod_phase(const Params& P, LAS unsigned char* L, int tid, int vcu, int G) {
    LAS float* SL = (LAS float*)L; LAS float* RED = (LAS float*)(L + 32768); const int lane = tid & 63, wid = tid >> 6;
    for (int i = tid; i < (NB + 1) * DM; i += 512) { const int r = i / DM, kx = i % DM; const float cv = r < NB ? P.c[(size_t)r * DM + kx] : P.c_ctx[kx]; SL[i] = cv * frcp(1.f + __expf(-cv)); }
    __syncthreads();
    for (int u = vcu; u < NL * (NMOD / 64); u += G) { const int l = u / (NMOD / 64), n0 = (u % (NMOD / 64)) * 64;
        float acc[NB + 1];
#pragma unroll
        for (int r = 0; r <= NB; ++r) acc[r] = 0.f;
        const float* wp = P.w_mod + ((size_t)l * DM + 128 * wid) * NMOD + n0 + lane;
#pragma unroll 1
        for (int kb = 0; kb < 128; kb += 32) { float wv[32];
#pragma unroll
            for (int kx = 0; kx < 32; ++kx) wv[kx] = wp[(size_t)(kb + kx) * NMOD];
#pragma unroll
            for (int kx = 0; kx < 32; ++kx)
#pragma unroll
                for (int r = 0; r <= NB; ++r) acc[r] += SL[r * DM + 128 * wid + kb + kx] * wv[kx]; }
#pragma unroll
        for (int r = 0; r <= NB; ++r) RED[(wid * (NB + 1) + r) * 64 + lane] = acc[r];
        __syncthreads();
        if (tid < (NB + 1) * 64) { const int r = tid >> 6; float sv = P.b_mod[(size_t)l * NMOD + n0 + lane];
#pragma unroll
            for (int w = 0; w < 8; ++w) sv += RED[(w * (NB + 1) + r) * 64 + lane];
            ((float*)(P.ws + WS_MOD))[((size_t)l * (NB + 1) + r) * NMOD + n0 + lane] = sv; }
        __syncthreads();
    }
}

#endif

#ifndef STAGE_MASK
#define STAGE_MASK 0xffff
#endif
#define SM(b) if (STAGE_MASK & (1 << (b)))
#ifndef REP_MASK
#define REP_MASK 0
#endif
#ifndef ABL_SSD
#define ABL_SSD 0
#endif
#define REP(b, X) do { X; if (REP_MASK & (1 << (b))) { SYNC(); X; } } while (0)
#define FORWARD_PROGRAM() do { \
    SM(0) REP(0, RUN(0, (long)NL * (NB + 1) * NMOD, st_mod(P, it))); \
    _Pragma("unroll 1") for (int l = 0; l < NL; ++l) { \
        SM(1) REP(9, WCONV_PHASE(l)); SYNC(); \
        SM(2) REP(10, NORM_PHASE(l, 0)); SYNC(); \
        SM(3) REP(6, GEMM_INPROJ(l)); SYNC(); \
        SM(4) REP(8, PREP_PHASE(l)); SM(5) QK_PHASE(l); SM(7) REP(1, RUN(0, (long)NB * NCH * 8, st_ssd_dt(P, it, l))); SYNC(); \
        SM(6) REP(2, RUN(0, (long)MT * 256, st_lru_gate(P, it, l))); SM(8) REP(5, ATTN_PHASE(l)); SYNC(); \
        SM(6) REP(3, RUN(0, (long)NB * NCH * 512, st_lru_local(P, it))); SYNC(); \
        SM(6) REP(3, RUN(0, (long)NB * 512, st_lru_carry(P, it))); SYNC(); \
        SM(6) REP(3, RUN(0, (long)NB * NCH * 256, st_lru_final(P, it, l, 0))); SYNC(); \
        SM(6) RUN(0, (long)NB * NCH * 256, st_lru_final(P, it, l, 1)); SYNC(); \
        SM(7) REP(4, SSD_STATE_PHASE(l)); SYNC(); \
        SM(7) RUN(0, (long)NB * 65536, st_ssd_carry(P, it)); SYNC(); \
        SM(10) REP(4, SSD_OUT_PHASE(l)); SYNC(); \
        SM(11) GEMM_OUT(l); SYNC(); \
        SM(2) NORM_PHASE(l, 1); SYNC(); \
        SM(12) REP(7, GEMM_F1(l)); SYNC(); \
        SM(13) GEMM_F2(l); SYNC(); \
    } } while (0)

#ifdef CPU_EMU
#define RUN(off, n, CALL) do { const long _n = (n); _Pragma("omp parallel for schedule(dynamic, 16)") for (long it = 0; it < _n; ++it) { CALL; } } while (0)
#define SYNC() do {} while (0)
#define SSD_STATE_PHASE(l) do { RUN(0, (long)NB * NCH * 65536, st_ssd_state(P, it)); RUN(0, (long)NB * NCH * 32768, st_ssd_g(P, it)); } while (0)
#define SSD_OUT_PHASE(l) do { RUN(0, (long)NB * NCH * 32768, st_ssd_y(P, it, l)); RUN(0, MT, st_ssd_norm(P, it, l)); } while (0)
#define WCONV_PHASE(l) RUN(960, WC_R4, st_wconv(P, it, l))
#define NORM_PHASE(l, w) RUN(0, MT, st_norm(P, it, l, w))
#define PREP_PHASE(l) RUN(0, (long)MT * 1280, st_prep(P, it, l))
#define QK_PHASE(l) RUN(0, (long)MT * 12, st_qk(P, it, l))
#define ATTN_PHASE(l) do { RUN(0, (long)MT * 4, st_attn(P, it, l, 0)); RUN(0, (long)MT * 4, st_attn(P, it, l, 1)); } while (0)
#define GEMM_INPROJ(l) RUN(0, (long)(MT / 8) * (NPL / 4), st_gemm(it, (const bf16_t*)(P.ws + WS_XN), DM, (const bf16_t*)(P.ws + WS_WIN), NPL, DM, EpiPL{P}))
#define GEMM_OUT(l) RUN(0, (long)(MT / 8) * (DM / 4), st_gemm(it, (const bf16_t*)(P.ws + WS_XN), DM, (const bf16_t*)(P.ws + WS_WOUT), DM, DM, EpiOut{P, l}))
#define GEMM_F1(l) RUN(0, (long)(MT / 8) * (FF / 4), st_gemm(it, (const bf16_t*)(P.ws + WS_XN), DM, (const bf16_t*)(P.ws + WS_WF1), FF, DM, EpiF1{P}))
#define GEMM_F2(l) RUN(0, (long)(MT / 8) * (DM / 4), st_gemm(it, (const bf16_t*)(P.ws + WS_H), FF, (const bf16_t*)(P.ws + WS_WF2), DM, FF, EpiF2{P, l}))
static void forward_emu(const Params& P) { FORWARD_PROGRAM(); }
#else
typedef const __attribute__((address_space(4))) unsigned long long* karg_u64p;
__device__ __forceinline__ Params load_params(const __attribute__((address_space(4))) Params* kp) { Params P; const karg_u64p q = (karg_u64p)kp;
    P.x = (const float*)(GAS const float*)q[0];    P.c = (const float*)(GAS const float*)q[1];    P.ctx = (const float*)(GAS const float*)q[2];    P.c_ctx = (const float*)(GAS const float*)q[3];    P.w_mod = (const float*)(GAS const float*)q[4];    P.b_mod = (const float*)(GAS const float*)q[5];
    P.g_mix = (const float*)(GAS const float*)q[6];    P.w_in = (const float*)(GAS const float*)q[7];    P.ssd_conv_w = (const float*)(GAS const float*)q[8];    P.ssd_conv_b = (const float*)(GAS const float*)q[9];    P.ssd_a_log = (const float*)(GAS const float*)q[10];    P.ssd_dt_bias = (const float*)(GAS const float*)q[11];
    P.ssd_d = (const float*)(GAS const float*)q[12];    P.ssd_norm_g = (const float*)(GAS const float*)q[13];    P.lru_conv_w = (const float*)(GAS const float*)q[14];    P.lru_conv_b = (const float*)(GAS const float*)q[15];    P.lru_lambda = (const float*)(GAS const float*)q[16];    P.lru_w_a = (const float*)(GAS const float*)q[17];
    P.lru_b_a = (const float*)(GAS const float*)q[18];    P.lru_w_i = (const float*)(GAS const float*)q[19];    P.lru_b_i = (const float*)(GAS const float*)q[20];    P.gqa_q_norm = (const float*)(GAS const float*)q[21];    P.gqa_k_norm = (const float*)(GAS const float*)q[22];    P.swa_q_norm = (const float*)(GAS const float*)q[23];
    P.swa_k_norm = (const float*)(GAS const float*)q[24];    P.swa_sink = (const float*)(GAS const float*)q[25];    P.w_out = (const float*)(GAS const float*)q[26];    P.g_ffn = (const float*)(GAS const float*)q[27];    P.w_ffn1 = (const float*)(GAS const float*)q[28];    P.w_ffn2 = (const float*)(GAS const float*)q[29];

    P.out = (float*)(GAS float*)q[30]; P.ws = (unsigned char*)(GAS unsigned char*)q[31];
    return P; }
constexpr int NTHREADS = 512;
constexpr int RING_BYTES = 131072, LDSCTL_OFF = RING_BYTES, MISC_OFF = LDSCTL_OFF + 320, LDS_BYTES = 147456;
constexpr int CW_BAR = 4096;
constexpr size_t CTL_ZERO_BYTES = 64 * 1024;
#define PHASE_LOCALS const __attribute__((address_space(4))) Params* kp_ = (const __attribute__((address_space(4))) Params*)__builtin_amdgcn_kernarg_segment_ptr(); asm volatile("" : "+s"(kp_)); \
    const Params P = load_params(kp_);     \
    const int tid_ = tid_from_wave(wave_s); \
    const int lane = tid_ & 63, wave = tid_ >> 6; const int G = (int)gridDim.x; int bx_ = (int)blockIdx.x; asm volatile("" : "+s"(bx_)); const int gw = wave * G + bx_, NGW = 8 * G; (void)lane; (void)gw; (void)NGW;
#define RUN(off, n, CALL) do { PHASE_LOCALS const int _n = (int)(n); for (int _iw = gw; _iw * 64 < _n; _iw += NGW) { const long it = _iw * 64 + lane; if (it < _n) { CALL; } } } while (0)
#ifndef PROF_A
#define PROF_A (-1)
#endif
#ifndef PROF_B
#define PROF_B (-1)
#endif
#define SYNC() do { xcd_barrier(bar, wave_s); if (PROF_A >= 0 && blockIdx.x == 0 && tid_from_wave(wave_s) == 0) { LAS unsigned long long* ts_ = (LAS unsigned long long*)(L + LDSCTL_OFF); const unsigned n_ = (unsigned)ts_[39]; if (n_ < 38) ts_[n_] = __builtin_amdgcn_s_memrealtime(); ts_[39] = n_ + 1; } } while (0)
#define VCU_ ((G % 8 == 0) ? (bx_ % 8) * (G / 8) + bx_ / 8 : bx_)
#define PREP_PHASE(l) do { PHASE_LOCALS prep_phase(P, (l), L, tid_, (G % 8 == 0) ? (bx_ % 8) * (G / 8) + bx_ / 8 : bx_, G); } while (0)
#define QK_PHASE(l) do { PHASE_LOCALS qk_phase(P, (l), lane, gw, NGW); } while (0)
#define ATTN_PHASE(l) do { PHASE_LOCALS attention_phase(P, (l), (char*)lds, G, bx_, wave_s); } while (0)
#define GEMM_INPROJ(l) do { PHASE_LOCALS pg8::Gemm g{(const pg8::bf16_t*)(P.ws + WS_XN), (const pg8::bf16_t*)(P.ws + WS_WIN), MT, NPL + 256, DM, DM}; pg8::RowOrder S; S.init(NPL + 256, G, bx_, 0); \
    pg8::EpiBf16A<0> E{(pg8::bf16_t*)(P.ws + WS_PL), NPL, (l) > 0 ? (const float*)(P.ws + WS_RS1) : nullptr, (const float*)(P.ws + WS_BIN), (float*)(P.ws + WS_DTP), NPL + 256};     pg8::gemm_phase<pg8::EpiBf16A<0>, pg8::RowOrder, true, true>(L, g, S, E, wave_s); } while (0)
#define GEMM_F1(l) do { PHASE_LOCALS pg8::Gemm g{(const pg8::bf16_t*)(P.ws + ws_xa2(l)), (const pg8::bf16_t*)(P.ws + WS_WF1), MT, FF, DM, DM}; pg8::RowOrder S; S.init(FF, G, bx_, (l) == NL - 1 ? 1 : 0); \
    pg8::EpiBf16A<2> E{(pg8::bf16_t*)(P.ws + ws_h(l)), FF, (const float*)(P.ws + WS_RS2), (const float*)(P.ws + WS_BF1) + (size_t)(l) * (NB + 1) * FF, nullptr, FF}; pg8::gemm_phase<pg8::EpiBf16A<2>, pg8::RowOrder, true, true>(L, g, S, E, wave_s); } while (0)
#define GEMM_RESID(l, which) do { PHASE_LOCALS const int KF = (which) ? FF : DM; const int npass = (l) == NL - 1 ? 1 : 2; \
    _Pragma("unroll 1") for (int pass = 0; pass < npass; ++pass) { \
        pg8::Gemm g{(const pg8::bf16_t*)(P.ws + ((which) ? ws_h(l) : WS_XN)), (const pg8::bf16_t*)(P.ws + ((which) ? WS_WF2 : WS_WOUT)), MT, DM, pass ? KF / pg8::RowOrder::KSPLIT : KF, KF}; \
        pg8::RowOrder S; S.init(DM, G, bx_, pass ? 2 : 1, KF / pg8::RowOrder::KSPLIT); \
        void* x1b_ = (l) == NL - 1 ? (void*)(P.ws + WS_X1L) : (void*)P.out;     \
        pg8::EpiResid E{(which) ? (const void*)x1b_ : ((l) == 0 ? (const void*)P.x : (const void*)P.out), (which) ? (void*)P.out : x1b_, ((which) || (l) > 0) ? 1 : 0, ((which) && (l) == NL - 1) ? 0 : 1, (const float*)(P.ws + WS_MOD) + (size_t)(l) * (NB + 1) * NMOD, (which) ? 5120 : 2048, pass ? KF / pg8::RowOrder::KSPLIT : 0, (float*)(P.ws + WS_SLAB), \
            (which) == 0 ? (pg8::bf16_t*)(P.ws + ws_xa2(l)) : ((l) + 1 < NL ? (pg8::bf16_t*)(P.ws + WS_XN) : nullptr), (which) == 0 ? P.g_ffn + (size_t)(l) * DM : P.g_mix + (size_t)((l) + 1 < NL ? (l) + 1 : (l)) * DM, \
            (const float*)(P.ws + WS_MOD) + (size_t)((which) == 0 ? (l) : ((l) + 1 < NL ? (l) + 1 : (l))) * (NB + 1) * NMOD, (which) == 0 ? 4096 : 1024, (float*)(P.ws + ((which) == 0 ? WS_RS2 : WS_RS1))};     \
        pg8::gemm_phase<pg8::EpiResid, pg8::RowOrder, true, true>(L, g, S, E, wave_s); } } while (0)
#define GEMM_OUT(l) GEMM_RESID(l, 0)
#define GEMM_F2(l) GEMM_RESID(l, 1)

#define M1_PHASE(l) do { PHASE_LOCALS const int vcu = VCU_; constexpr int NIT_ = NB * NCH * 8; \
      \
    const int NC1_ = 8 * G - NIT_ <= 0 ? 0 : (8 * G - NIT_ < 4 * G ? 8 * G - NIT_ : 4 * G), NX_ = 4 * G - NC1_, N2_ = 8 * G - NC1_; \
    const int t_ = wave_s * G + vcu; const bool c2_ = wave_s >= 4 || t_ < NX_; const int s2_ = wave_s >= 4 ? (wave_s - 4) * G + vcu : 4 * G + t_; \
    if (c2_) { _Pragma("unroll 1") for (int i_ = s2_; i_ < NIT_; i_ += N2_) { const int ti_ = tid_from_wave(wave_s); ssdk::ssd_state_item(P, (l), L, ti_, i_ >> 3, (i_ >> 1) & 3, i_ & 1); } } \
    { int h_, he_, hs_;        \
        if (!c2_) { const int u_ = t_ - NX_; h_ = 2 * u_; he_ = u_ < NIT_ ? 2 * u_ + 2 : 0; hs_ = 1; } \
        else { h_ = 2 * NC1_ + s2_; he_ = 2 * NIT_; hs_ = N2_; } \
        _Pragma("unroll 1") for (; h_ < he_; h_ += hs_) { const int ti_ = tid_from_wave(wave_s); const int u_ = h_ >> 1; lruk::lru_gate_half(P, (l), ti_, u_ >> 3, (u_ >> 1) & 3, u_ & 1, h_ & 1); } } \
    __syncthreads(); attention_phase(P, (l), (char*)lds, G, bx_, wave_s); if (REP_MASK & 4096) attention_phase(P, (l), (char*)lds, G, bx_, wave_s); } while (0)
#define M2_PHASE(l) do { RUN(0, (long)NB * 65536, st_ssd_carry(P, it)); RUN(0, (long)NB * 512, st_lru_carry(P, it)); } while (0)
#define M3_PHASE(l) do { PHASE_LOCALS const int vcu = VCU_; \
    if (REP_MASK & 256) { ssdk::ssd_out_phase<ABL_SSD>(P, (l), L, wave_s, vcu, G); __syncthreads(); } ssdk::ssd_out_phase<0>(P, (l), L, wave_s, vcu, G); \
      \
    { const int ntile_ = (l) == NL - 1 ? NB * (NCH - NCC) * 4 : NB * NCH * 4; const int flo_ = ntile_ > 2 * G ? (ntile_ - 2 * G + 1) / 2 : 0, fhi_ = G - NB * NCH; const int parts_ = (l) == 0 ? 14 : 8; \
      if (fhi_ > flo_) { if (vcu >= flo_ && vcu < fhi_) { __syncthreads(); wconv_phase(P, (l), parts_, L, wave, lane, wave * (fhi_ - flo_) + (vcu - flo_), 8 * (fhi_ - flo_)); } } \
      else { __syncthreads(); wconv_phase(P, (l), parts_, L, wave, lane, gw, NGW); } } \
    lruk::lru_final_phase(P, L, tid_, G - 1 - vcu, G, (l) == NL - 1); if (REP_MASK & 512) { __syncthreads(); lruk::lru_final_phase(P, L, tid_, G - 1 - vcu, G, (l) == NL - 1); } } while (0)
#define FREE_LOCALS const int fo_ = G > 64 ? 64 : 0, nf_ = G - fo_;
#define GPU_PROGRAM() do { \
    REP(0, { PHASE_LOCALS mod_phase(P, L, tid_, VCU_, G); wconv_phase(P, 0, 17, L, wave, lane, gw, NGW); \
        for (int i = gw * 64 + lane; i < NB * CTX * DM / 4; i += NGW * 64) ((f32x4*)(P.ws + WS_XRC))[i] = ((const f32x4*)P.ctx)[i]; }); SYNC(); \
    _Pragma("unroll 1") for (int l = 0; l < NL; ++l) { \
          \
        if (l == 0) { PHASE_LOCALS norm1_phase(P, l, 0, L, tid_, lane, gw, NGW); } \
        else { PHASE_LOCALS norm_phase(P, l, 0, 1, 1, lane, gw, NGW); } \
        SYNC(); \
        REP(2, GEMM_INPROJ(l)); SYNC(); \
        REP(3, { PREP_PHASE(l); }); QK_PHASE(l); SYNC(); \
        REP(4, M1_PHASE(l)); SYNC(); \
        M2_PHASE(l); SYNC(); \
        REP(5, M3_PHASE(l)); SYNC(); \
          \
        GEMM_OUT(l); if (l == 0 && l + 1 < NL) { PHASE_LOCALS FREE_LOCALS if (bx_ >= fo_) { __syncthreads(); bias_phase(P, L, tid_, bx_ - fo_, nf_); } } else if (l == 0) { PHASE_LOCALS bias_phase(P, L, tid_, VCU_, G); } SYNC(); \
        if (l + 1 < NL) { { PHASE_LOCALS norm_phase(P, l, 1, 1, 1, lane, gw, NGW); } SYNC(); }     \
        REP(7, GEMM_F1(l)); if (l + 1 < NL) { PHASE_LOCALS FREE_LOCALS if (bx_ >= fo_) { __syncthreads(); wconv_phase(P, l + 1, 19, L, wave, lane, wave * nf_ + (bx_ - fo_), 8 * nf_); __syncthreads(); bin_phase(P, l + 1, L, tid_, nf_ - 1 - (bx_ - fo_), nf_); } } SYNC(); \
        GEMM_F2(l); if (l + 1 < NL) { { PHASE_LOCALS FREE_LOCALS if (bx_ >= fo_) { __syncthreads(); wconv_phase(P, l + 1, 4, L, wave, lane, wave * nf_ + (bx_ - fo_), 8 * nf_); } } SYNC(); } \
    } } while (0)

__global__ void __launch_bounds__(NTHREADS, 2) fwd_kernel(Params P0) {
    extern __shared__ __attribute__((aligned(16))) unsigned char lds[];
    LAS unsigned char* L = (LAS unsigned char*)lds;
    const int wave_s = __builtin_amdgcn_readfirstlane((int)(threadIdx.x >> 6));
    for (int u = threadIdx.x; u < (LDS_BYTES - LDSCTL_OFF) / 4; u += NTHREADS) ((LAS unsigned*)(L + LDSCTL_OFF))[u] = 0u;
    __syncthreads();
    XcdBarrier bar = xcd_barrier_post((unsigned*)(P0.ws + WS_CTL) + CW_BAR, (volatile LAS unsigned*)(L + MISC_OFF) + 8);
    GPU_PROGRAM();
    if (PROF_A >= 0) {
        SYNC();
        if (blockIdx.x == 0) { LAS unsigned long long* ts_ = (LAS unsigned long long*)(L + LDSCTL_OFF); __syncthreads();
            const float ta = (float)(ts_[PROF_A + 1] - ts_[PROF_A]) * 0.01f, tb = (float)(ts_[(PROF_B < 0 ? PROF_A : PROF_B) + 1] - ts_[PROF_B < 0 ? PROF_A : PROF_B]) * 0.01f;
            const int t = tid_from_wave(wave_s);
            if (t == 0) P0.out[0] += ta;
            for (int i = t; i < (1 << 20); i += NTHREADS) P0.out[4096 + i] += tb * 0.001f; } }
}

extern "C" void kernel_launch(void* const* d_in, const int* in_sizes, int n_in, void* d_out, int out_size, void* d_ws, size_t ws_size, hipStream_t stream) {
    static int grid_blocks = 0;
    if (!grid_blocks) {
        int dev = 0, cus = 0, per_cu = 0;
        (void)hipGetDevice(&dev); (void)hipDeviceGetAttribute(&cus, hipDeviceAttributeMultiprocessorCount, dev);
        (void)hipFuncSetAttribute((const void*)fwd_kernel, hipFuncAttributeMaxDynamicSharedMemorySize, LDS_BYTES);
        (void)hipOccupancyMaxActiveBlocksPerMultiprocessor(&per_cu, fwd_kernel, NTHREADS, LDS_BYTES);
        if (per_cu < 1) { fprintf(stderr, "kernel_launch: occupancy query reports %d blocks per CU\n", per_cu); per_cu = 1; }
        grid_blocks = cus;
        if (n_in != 30 || out_size != NB * SEQ * DM || ws_size < WS_END) fprintf(stderr, "kernel_launch: unexpected shapes n_in %d out %d ws %zu\n", n_in, out_size, ws_size);
    }
    (void)hipMemsetAsync((char*)d_ws + WS_CTL, 0, CTL_ZERO_BYTES, stream);
    Params p{};
    const float** pp = (const float**)&p;
    for (int i = 0; i < 30; ++i) pp[i] = (const float*)d_in[i];
    p.out = (float*)d_out; p.ws = (unsigned char*)d_ws;
    void* args[] = {&p};
    hipError_t e = hipLaunchCooperativeKernel((void*)fwd_kernel, dim3(grid_blocks), dim3(NTHREADS), args, LDS_BYTES, stream);
    if (e != hipSuccess) fprintf(stderr, "cooperative launch failed: %s (grid %d)\n", hipGetErrorString(e), grid_blocks);
}
#endif
```

```cpp
#ifndef CPU_EMU
#include <hip/hip_runtime.h>
#include <hip/hip_cooperative_groups.h>
#include <cstdio>
namespace cg = cooperative_groups;
#define DEV __device__ __forceinline__
#define DEVM __device__ __forceinline__
#else
#define DEV static inline
#define DEVM inline
#endif
#include <stdint.h>
#include <stddef.h>
#include <math.h>
#include <string.h>

#ifndef CFG_BATCH
#define CFG_BATCH 4
#endif
#ifndef CFG_SEQ
#define CFG_SEQ 4096
#endif
constexpr int NB = CFG_BATCH, SEQ = CFG_SEQ, CTX = 256, DM = 1024, SB = CTX + SEQ, MT = NB * SB;
constexpr int NPL = 2560, FF = 4096, NMOD = 6144, NL = 2, GRIDW = 64;
constexpr int CHK = 128, NCH = SB / CHK, NCC = CTX / CHK;
constexpr float EPS = 1e-6f, LOG2E = 1.4426950408889634f, QSCALE = 0.125f * 1.4426950408889634f;
constexpr int PL_Z = 0, PL_XBC = 256, PL_LG = 1024, PL_LX = 1280, PL_C = 1536, PL_D = 2048;
constexpr int MIX_A = 0, MIX_B = 256, MIX_C = 512, MIX_D = 768;
constexpr size_t MiB = 1u << 20;
constexpr size_t WS_CTL = 0, WS_MOD = 1 * MiB, WS_WDT = WS_MOD + 256 * 1024, WS_WIN = 1 * MiB + 512 * 1024, WS_WOUT = 7 * MiB, WS_WF1 = 9 * MiB, WS_WF2 = 17 * MiB, WS_XRC = 25 * MiB, WS_DTP = 29 * MiB;
constexpr size_t WS_LWT = WS_CTL + 576 * 1024;
constexpr size_t WS_XN = 30 * MiB;
constexpr size_t WS_B = 64 * MiB;
constexpr size_t WS_PL = WS_B, WS_XBC = 149 * MiB, WS_TAIL = 243 * MiB, WS_END = 256 * MiB;
constexpr size_t WS_XA2 = WS_B;
constexpr size_t WS_H = 98 * MiB;
__host__ __device__ constexpr size_t ws_h(int l) { return l == NL - 1 ? 30 * MiB : WS_H; }
__host__ __device__ constexpr size_t ws_xa2(int l) { return l == NL - 1 ? 200 * MiB : WS_XA2; }
constexpr size_t WS_X1L = 166 * MiB;
constexpr size_t WS_RS1 = WS_CTL + 448 * 1024, WS_BIN = WS_CTL + 768 * 1024;
constexpr size_t WS_RS2 = WS_CTL + 128 * 1024, WS_BF1 = WS_CTL + 256 * 1024;
constexpr int XBP = 512;
constexpr size_t TR_BYTES = (size_t)MT * 256 * 2;
constexpr size_t WS_XT = 166 * MiB, WS_BT = WS_XT + TR_BYTES, WS_ZT = WS_BT + TR_BYTES;
constexpr size_t WS_SST = WS_ZT + TR_BYTES;
constexpr size_t WS_LAB = WS_SST + 2 * TR_BYTES;
constexpr size_t WS_GB = WS_LAB, WS_YG = WS_LAB + TR_BYTES;
constexpr size_t WS_XLC = WS_TAIL;
constexpr size_t WS_SLAB = 234 * MiB;
constexpr size_t WS_SC4 = WS_TAIL + 9 * MiB, WS_DEC = WS_SC4 + (size_t)MT * 64 + 65536;
constexpr size_t WS_LHE = WS_TAIL + 11 * MiB, WS_LCP = WS_LHE + 512 * 1024, WS_LCI = WS_LCP + 512 * 1024;
static_assert((size_t)MT * NPL * 2 <= WS_XBC - WS_PL && (size_t)MT * XBP * 2 <= WS_XT - WS_XBC && (size_t)MT * FF * 2 <= WS_END - WS_H && (size_t)MT * DM * 2 <= WS_B - WS_XN, "ws map");
static_assert(TR_BYTES <= 9 * MiB && WS_LAB + 4 * TR_BYTES <= WS_TAIL && WS_DEC + 65536 <= WS_LHE && (size_t)NB * NCH * 512 * 4 <= 512 * 1024 && WS_LCI + 512 * 1024 <= WS_END, "ws map 3");
static_assert((size_t)NB * CTX * DM * 4 <= WS_DTP - WS_XRC && (size_t)MT * 8 * 4 <= WS_XN - WS_DTP && (size_t)NL * (NB + 1) * NMOD * 4 <= 256 * 1024, "ws map 2");

struct Params {
    const float *x, *c, *ctx, *c_ctx, *w_mod, *b_mod, *g_mix, *w_in, *ssd_conv_w, *ssd_conv_b, *ssd_a_log, *ssd_dt_bias, *ssd_d, *ssd_norm_g, *lru_conv_w, *lru_conv_b, *lru_lambda,
        *lru_w_a, *lru_b_a, *lru_w_i, *lru_b_i, *gqa_q_norm, *gqa_k_norm, *swa_q_norm, *swa_k_norm, *swa_sink, *w_out, *g_ffn, *w_ffn1, *w_ffn2;
    float* out; unsigned char* ws;
};
typedef uint16_t bf16_t;
struct U4 { uint32_t x, y, z, w; };
struct U2 { uint32_t x, y; };

DEV float u2f(uint32_t u) { float f; memcpy(&f, &u, 4); return f; }
DEV uint32_t f2u(float f) { uint32_t u; memcpy(&u, &f, 4); return u; }
DEV float bf2f(bf16_t h) { return u2f((uint32_t)h << 16); }
DEV bf16_t f2bf(float f) { uint32_t u = f2u(f); return (bf16_t)((u + 0x7fffu + ((u >> 16) & 1u)) >> 16); }
DEV float bflo(uint32_t w) { return u2f(w << 16); }
DEV float bfhi(uint32_t w) { return u2f(w & 0xffff0000u); }
DEV float silu_f(float x) { return x / (1.f + expf(-x)); }
DEV float sigmoid_f(float x) { return 1.f / (1.f + expf(-x)); }
DEV float softplus_f(float x) { return fmaxf(x, 0.f) + log1pf(expf(-fabsf(x))); }
DEV float gelu_tanh_f(float x) { return 0.5f * x * (1.f + tanhf(0.7978845608028654f * (x + 0.044715f * x * x * x))); }

DEV float* resid_row(const Params& P, int r) { const int b = r / SB, s = r % SB; return s < CTX ? (float*)(P.ws + WS_XRC) + ((size_t)b * CTX + s) * DM : P.out + ((size_t)b * SEQ + (s - CTX)) * DM; }
DEV const float* xin_row(const Params& P, int l, int r) { const int b = r / SB, s = r % SB; if (l == 0) return s < CTX ? P.ctx + ((size_t)b * CTX + s) * DM : P.x + ((size_t)b * SEQ + (s - CTX)) * DM; return resid_row(P, r); }
DEV const float* mod_row(const Params& P, int l, int r) { const int b = r / SB, s = r % SB; const int bm = s < CTX ? NB : b; return (const float*)(P.ws + WS_MOD) + ((size_t)l * (NB + 1) + bm) * NMOD; }
DEV int chunk_at(int dir, int k) { return dir == 0 ? k : (k < NCC ? NCC - 1 - k : NCH - 1 - (k - NCC)); }
DEV int scan_pos(int dir, int step) { return dir == 0 ? step : (step < CTX ? CTX - 1 - step : SB - 1 - (step - CTX)); }

DEV void st_mod(const Params& P, long it) {
    const int n = (int)(it % NMOD); const int rb = (int)(it / NMOD); const int bm = rb % (NB + 1), l = rb / (NB + 1);
    const float* cv = bm < NB ? P.c + (size_t)bm * DM : P.c_ctx;
    float acc = P.b_mod[(size_t)l * NMOD + n];
    for (int k = 0; k < DM; ++k) acc += silu_f(cv[k]) * P.w_mod[((size_t)l * DM + k) * NMOD + n];
    ((float*)(P.ws + WS_MOD))[it] = acc;
}
constexpr long WC_R0 = (long)NPL * DM, WC_R1 = WC_R0 + 8 * DM, WC_R2 = WC_R1 + (long)DM * DM, WC_R3 = WC_R2 + (long)FF * DM, WC_R4 = WC_R3 + (long)DM * FF;
DEV void st_wconv(const Params& P, long it, int l) {
    if (it < WC_R0) { const int n = (int)(it / DM), k = (int)(it % DM); const int no = n < 1024 ? n : n + 8; ((bf16_t*)(P.ws + WS_WIN))[it] = f2bf(P.w_in[((size_t)l * DM + k) * 2568 + no]); return; }
    if (it < WC_R1) { const long i = it - WC_R0; const int j = (int)(i / DM), k = (int)(i % DM); ((float*)(P.ws + WS_WDT))[i] = P.w_in[((size_t)l * DM + k) * 2568 + 1024 + j]; return; }
    if (it < WC_R2) { const long i = it - WC_R1; const int n = (int)(i / DM), k = (int)(i % DM); ((bf16_t*)(P.ws + WS_WOUT))[i] = f2bf(P.w_out[((size_t)l * DM + k) * DM + n]); return; }
    if (it < WC_R3) { const long i = it - WC_R2; const int n = (int)(i / DM), k = (int)(i % DM); ((bf16_t*)(P.ws + WS_WF1))[i] = f2bf(P.w_ffn1[((size_t)l * DM + k) * FF + n]); return; }
    { const long i = it - WC_R3; const int n = (int)(i / FF), k = (int)(i % FF); ((bf16_t*)(P.ws + WS_WF2))[i] = f2bf(P.w_ffn2[((size_t)l * FF + k) * DM + n]); }
}
DEV void st_norm(const Params& P, long it, int l, int which) {
    const int r = (int)it; const float* xr = which == 0 ? xin_row(P, l, r) : resid_row(P, r); const float* md = mod_row(P, l, r);
    const float* g = (which == 0 ? P.g_mix : P.g_ffn) + (size_t)l * DM; const float* sh = md + (which == 0 ? 0 : 3072); const float* sc = sh + 1024;
    float ss = 0.f; for (int k = 0; k < DM; ++k) ss += xr[k] * xr[k];
    const float rs = 1.0f / sqrtf(ss * (1.0f / DM) + EPS);
    bf16_t* o = (bf16_t*)(P.ws + WS_XN) + (size_t)r * DM; const float* wdt = (const float*)(P.ws + WS_WDT);
    float dt[8]; for (int j = 0; j < 8; ++j) dt[j] = 0.f;
    for (int k = 0; k < DM; ++k) { const float v = (xr[k] * rs * g[k]) * (1.f + sc[k]) + sh[k]; o[k] = f2bf(v);
        if (which == 0) { for (int j = 0; j < 8; ++j) dt[j] += v * wdt[j * DM + k]; } }
    if (which == 0) { float* d = (float*)(P.ws + WS_DTP) + (size_t)r * 8; for (int j = 0; j < 8; ++j) d[j] = dt[j]; }
}
template <class Epi> DEV void st_gemm(long it, const bf16_t* A, int lda, const bf16_t* Bt, int N, int K, const Epi& E) {
    const int ntn = N / 4; const int r0 = (int)(it / ntn) * 8, n0 = (int)(it % ntn) * 4;
    float acc[8][4];
#pragma unroll
    for (int i = 0; i < 8; ++i)
#pragma unroll
        for (int j = 0; j < 4; ++j) acc[i][j] = 0.f;
#pragma unroll 1
    for (int k = 0; k < K; k += 4) {
        U2 a[8], b[4];
#pragma unroll
        for (int i = 0; i < 8; ++i) a[i] = *(const U2*)(A + (size_t)(r0 + i) * lda + k);
#pragma unroll
        for (int j = 0; j < 4; ++j) b[j] = *(const U2*)(Bt + (size_t)(n0 + j) * K + k);
#pragma unroll
        for (int kk = 0; kk < 2; ++kk) {
            float al[8], ah[8], bl[4], bh[4];
#pragma unroll
            for (int i = 0; i < 8; ++i) { const uint32_t wa = kk == 0 ? a[i].x : a[i].y; al[i] = bflo(wa); ah[i] = bfhi(wa); }
#pragma unroll
            for (int j = 0; j < 4; ++j) { const uint32_t wb = kk == 0 ? b[j].x : b[j].y; bl[j] = bflo(wb); bh[j] = bfhi(wb); }
#pragma unroll
            for (int i = 0; i < 8; ++i)
#pragma unroll
                for (int j = 0; j < 4; ++j) acc[i][j] += al[i] * bl[j] + ah[i] * bh[j];
        }
    }
    E(r0, n0, acc);
}
struct EpiPL { const Params& P; DEVM void operator()(int r0, int n0, const float (&acc)[8][4]) const { bf16_t* pl = (bf16_t*)(P.ws + WS_PL);
#pragma unroll
    for (int i = 0; i < 8; ++i)
#pragma unroll
        for (int j = 0; j < 4; ++j) pl[(size_t)(r0 + i) * NPL + n0 + j] = f2bf(acc[i][j]); } };
struct EpiOut { const Params& P; int l; DEVM void operator()(int r0, int n0, const float (&acc)[8][4]) const {
#pragma unroll
    for (int i = 0; i < 8; ++i) { const int r = r0 + i; const float* md = mod_row(P, l, r) + 2048; const float* xi = xin_row(P, l, r); float* xo = resid_row(P, r);
#pragma unroll
        for (int j = 0; j < 4; ++j) xo[n0 + j] = xi[n0 + j] + md[n0 + j] * acc[i][j]; } } };
struct EpiF1 { const Params& P; DEVM void operator()(int r0, int n0, const float (&acc)[8][4]) const { bf16_t* h = (bf16_t*)(P.ws + WS_H);
#pragma unroll
    for (int i = 0; i < 8; ++i)
#pragma unroll
        for (int j = 0; j < 4; ++j) { const float v = fmaxf(acc[i][j], 0.f); h[(size_t)(r0 + i) * FF + n0 + j] = f2bf(v * v); } } };
struct EpiF2 { const Params& P; int l; DEVM void operator()(int r0, int n0, const float (&acc)[8][4]) const {
#pragma unroll
    for (int i = 0; i < 8; ++i) { const int r = r0 + i; const float* md = mod_row(P, l, r) + 5120; float* xo = resid_row(P, r);
#pragma unroll
        for (int j = 0; j < 4; ++j) xo[n0 + j] = xo[n0 + j] + md[n0 + j] * acc[i][j]; } } };

DEV void st_prep(const Params& P, long it, int l) {
    const int r = (int)(it / 1280), c = (int)(it % 1280); const int b = r / SB, s = r % SB; const int lo = s < CTX ? 0 : CTX, hi = s < CTX ? CTX : SB;
    const bf16_t* pl = (const bf16_t*)(P.ws + WS_PL); const size_t tro = ((size_t)(b * NCH + s / CHK) * 256) * CHK + (s % CHK);
    if (c < 768) { float acc = P.ssd_conv_b[l * 768 + c];
        for (int t = 0; t < 4; ++t) { const int ss = s + t - 2; if (ss >= lo && ss < hi) acc += P.ssd_conv_w[(l * 4 + t) * 768 + c] * bf2f(pl[(size_t)(b * SB + ss) * NPL + PL_XBC + c]); }
        const bf16_t v = f2bf(silu_f(acc)); if (c >= 256) ((bf16_t*)(P.ws + WS_XBC))[(size_t)r * XBP + c - 256] = v;
        if (c < 256) ((bf16_t*)(P.ws + WS_XT))[tro + (size_t)c * CHK] = v; else if (c < 512) ((bf16_t*)(P.ws + WS_BT))[tro + (size_t)(c - 256) * CHK] = v; }
    else if (c < 1024) { const int ch = c - 768; float acc = P.lru_conv_b[l * 256 + ch];
        for (int t = 0; t < 4; ++t) { const int ss = s + t - 2; if (ss >= lo && ss < hi) acc += P.lru_conv_w[(l * 4 + t) * 256 + ch] * bf2f(pl[(size_t)(b * SB + ss) * NPL + PL_LX + ch]); }
        ((bf16_t*)(P.ws + WS_XLC))[(size_t)r * 256 + ch] = f2bf(acc); }
    else { const int ch = c - 1024; ((bf16_t*)(P.ws + WS_ZT))[tro + (size_t)ch * CHK] = pl[(size_t)r * NPL + PL_Z + ch]; }
}
DEV void st_qk(const Params& P, long it, int l) {
    const int r = (int)(it / 12), slot = (int)(it % 12); const int t = slot / 6, hs = slot % 6; const int s = r % SB;
    const int col = (t ? PL_D : PL_C) + (hs < 4 ? hs * 64 : 256 + (hs - 4) * 64);
    const float *g0 = P.gqa_q_norm, *g1 = P.swa_q_norm, *g2 = P.gqa_k_norm, *g3 = P.swa_k_norm;
#ifndef CPU_EMU
    asm volatile("" : "+s"(g0), "+s"(g1), "+s"(g2), "+s"(g3));
#endif
    const float* g = (hs < 4 ? (t ? g1 : g0) : (t ? g3 : g2)) + l * 64;
    bf16_t* p = (bf16_t*)(P.ws + WS_PL) + (size_t)r * NPL + col;
    float ss = 0.f;
    for (int d = 0; d < 64; ++d) { const float v = bf2f(p[d]); ss += v * v; }
    const float rs = 1.0f / sqrtf(ss * (1.0f / 64) + EPS); const float qs = hs < 4 ? QSCALE : 1.f;
    const bool lat = s >= CTX; const int pos = s - CTX; const float pr = (float)(pos / GRIDW), pc = (float)(pos % GRIDW);
#pragma unroll 1
    for (int pi = 0; pi < 32; ++pi) { const int a = pi >> 4, i = pi & 15; const int d1 = a * 32 + i, d2 = d1 + 16;
        const float x1 = bf2f(p[d1]) * rs * g[d1], x2 = bf2f(p[d2]) * rs * g[d2]; float cs = 1.f, sn = 0.f;
        if (lat) { const float inv = expf(-(float)i * (9.210340371976184f / 16.f)); const float ang = (a ? pc : pr) * inv; cs = cosf(ang); sn = sinf(ang); }
        p[d1] = f2bf((x1 * cs - x2 * sn) * qs); p[d2] = f2bf((x2 * cs + x1 * sn) * qs); }
}
DEV void st_lru_gate(const Params& P, long it, int l) {
    const int r = (int)(it >> 8), ch = (int)(it & 255); const int k = ch >> 6, j = ch & 63;
    const bf16_t* xr = (const bf16_t*)(P.ws + WS_XLC) + (size_t)r * 256 + k * 64; uint32_t* lab = (uint32_t*)(P.ws + WS_LAB);
    for (int dir = 0; dir < 2; ++dir) {
        const float* wa = P.lru_w_a + ((((size_t)l * 2 + dir) * 4 + k) * 64) * 64 + j; const float* wi = P.lru_w_i + ((((size_t)l * 2 + dir) * 4 + k) * 64) * 64 + j;
        float da = P.lru_b_a[(l * 2 + dir) * 256 + ch], di = P.lru_b_i[(l * 2 + dir) * 256 + ch];
        for (int i = 0; i < 64; ++i) { const float xv = bf2f(xr[i]); da += xv * wa[i * 64]; di += xv * wi[i * 64]; }
        const float sp = softplus_f(-P.lru_lambda[(l * 2 + dir) * 256 + ch]);
        const float la = -8.0f * sigmoid_f(da) * sp; const float bb = sqrtf(-expm1f(2.f * la)) * (sigmoid_f(di) * bf2f(xr[j]));
        lab[((size_t)dir * MT + r) * 256 + ch] = (uint32_t)f2bf(la * LOG2E) | ((uint32_t)f2bf(bb) << 16); }
}
DEV void st_lru_local(const Params& P, long it) {
    const int ch = (int)(it & 255), dir = (int)((it >> 8) & 1); const int bc = (int)(it >> 9); const int c = bc % NCH, b = bc / NCH;
    const uint32_t* lab = (const uint32_t*)(P.ws + WS_LAB) + ((size_t)dir * MT + (size_t)b * SB + c * CHK) * 256 + ch;
    float h = 0.f, cp = 1.f;
#pragma unroll 16
    for (int i = 0; i < CHK; ++i) { const uint32_t w = lab[(size_t)(dir ? CHK - 1 - i : i) * 256]; const float a = exp2f(bflo(w)); h = a * h + bfhi(w); cp *= a; }
    ((float*)(P.ws + WS_LHE))[it] = h; ((float*)(P.ws + WS_LCP))[it] = cp;
}
DEV void st_lru_carry(const Params& P, long it) {
    const int ch = (int)(it & 255), dir = (int)((it >> 8) & 1), b = (int)(it >> 9);
    const float* he = (const float*)(P.ws + WS_LHE); const float* cpv = (const float*)(P.ws + WS_LCP); float* ci = (float*)(P.ws + WS_LCI);
    float hv[NCH], cv[NCH];
#pragma unroll
    for (int k = 0; k < NCH; ++k) { const size_t idx = (((size_t)b * NCH + chunk_at(dir, k)) * 2 + dir) * 256 + ch; hv[k] = he[idx]; cv[k] = cpv[idx]; }
    float carry = 0.f;
#pragma unroll
    for (int k = 0; k < NCH; ++k) { const size_t idx = (((size_t)b * NCH + chunk_at(dir, k)) * 2 + dir) * 256 + ch; ci[idx] = carry; carry = carry * cv[k] + hv[k]; }
}
DEV void st_lru_final(const Params& P, long it, int l, int dir) {
    const int ch = (int)(it & 255); const int bc = (int)(it >> 8); const int c = bc % NCH, b = bc / NCH; const size_t r0 = (size_t)b * SB + c * CHK;
    const uint32_t* lab = (const uint32_t*)(P.ws + WS_LAB) + ((size_t)dir * MT + r0) * 256 + ch;
    bf16_t* mix = (bf16_t*)(P.ws + WS_XN) + r0 * DM + MIX_B + ch; const bf16_t* pl = (const bf16_t*)(P.ws + WS_PL) + r0 * NPL + PL_LG + ch;
    float h = ((const float*)(P.ws + WS_LCI))[(((size_t)b * NCH + c) * 2 + dir) * 256 + ch];
#pragma unroll 8
    for (int i = 0; i < CHK; ++i) { const int ii = dir ? CHK - 1 - i : i; const uint32_t w = lab[(size_t)ii * 256]; h = exp2f(bflo(w)) * h + bfhi(w);
        if (dir == 0) mix[(size_t)ii * DM] = f2bf(h);
        else mix[(size_t)ii * DM] = f2bf((bf2f(mix[(size_t)ii * DM]) + h) * gelu_tanh_f(bf2f(pl[(size_t)ii * NPL]))); }
}
DEV void st_ssd_dt(const Params& P, long it, int l) {
    const int dir = (int)(it & 1), hd = (int)((it >> 1) & 3); const int bc = (int)(it >> 3);
    const float a2 = -expf(P.ssd_a_log[(l * 2 + dir) * 4 + hd]) * LOG2E, dtb = P.ssd_dt_bias[(l * 2 + dir) * 4 + hd];
    const float* dtp = (const float*)(P.ws + WS_DTP); float* sc4 = (float*)(P.ws + WS_SC4);
    float acc = 0.f;
    for (int k = 0; k < CHK; ++k) { const size_t r = (size_t)bc * CHK + (dir ? CHK - 1 - k : k); const float dt = softplus_f(dtp[r * 8 + dir * 4 + hd] + dtb); acc += dt * a2;
        sc4[(r * 4 + hd) * 4 + dir * 2] = acc; sc4[(r * 4 + hd) * 4 + dir * 2 + 1] = dt; }
    ((float*)(P.ws + WS_DEC))[it] = exp2f(acc);
}
DEV void st_ssd_state(const Params& P, long it) {
    const int n = (int)(it & 127), p = (int)((it >> 7) & 63), dir = (int)((it >> 13) & 1), hd = (int)((it >> 14) & 3); const int bc = (int)(it >> 16);
    const float* sc4 = (const float*)(P.ws + WS_SC4); const size_t r0 = (size_t)bc * CHK;
    const bf16_t* xt = (const bf16_t*)(P.ws + WS_XT) + ((size_t)bc * 256 + hd * 64 + p) * CHK; const bf16_t* bt = (const bf16_t*)(P.ws + WS_BT) + ((size_t)bc * 256 + (hd >> 1) * 128 + n) * CHK;
    const float aend = sc4[((r0 + (dir ? 0 : CHK - 1)) * 4 + hd) * 4 + dir * 2];
    float acc = 0.f;
    for (int j = 0; j < CHK; ++j) { const float* sj = sc4 + ((r0 + j) * 4 + hd) * 4 + dir * 2; acc += exp2f(aend - sj[0]) * sj[1] * bf2f(xt[j]) * bf2f(bt[j]); }
    ((bf16_t*)(P.ws + WS_SST))[it] = f2bf(acc);
}
DEV void st_ssd_carry(const Params& P, long it) {
    const int pn = (int)(it & 8191), dir = (int)((it >> 13) & 1), hd = (int)((it >> 14) & 3), b = (int)(it >> 16);
    bf16_t* sst = (bf16_t*)(P.ws + WS_SST); const float* dec = (const float*)(P.ws + WS_DEC);
    bf16_t sv[NCH]; float dv[NCH];
#pragma unroll
    for (int k = 0; k < NCH; ++k) { const size_t cd = (((size_t)b * NCH + chunk_at(dir, k)) * 4 + hd) * 2 + dir; sv[k] = sst[cd * 8192 + pn]; dv[k] = dec[cd]; }
    float run = 0.f;
#pragma unroll
    for (int k = 0; k < NCH; ++k) { const size_t cd = (((size_t)b * NCH + chunk_at(dir, k)) * 4 + hd) * 2 + dir; sst[cd * 8192 + pn] = f2bf(run); run = run * dv[k] + bf2f(sv[k]); }
}
DEV void st_ssd_g(const Params& P, long it) {
    const int j = (int)(it & 127), i = (int)((it >> 7) & 127), g = (int)((it >> 14) & 1); const int bc = (int)(it >> 15);
    const bf16_t* xbc = (const bf16_t*)(P.ws + WS_XBC); const bf16_t* cp = xbc + ((size_t)bc * CHK + i) * XBP + 256 + g * 128; const bf16_t* bp = xbc + ((size_t)bc * CHK + j) * XBP + g * 128;
    float acc = 0.f;
    for (int n8 = 0; n8 < 16; ++n8) { const U4 cw = *(const U4*)(cp + n8 * 8), bw = *(const U4*)(bp + n8 * 8);
        acc += bflo(cw.x) * bflo(bw.x) + bfhi(cw.x) * bfhi(bw.x) + bflo(cw.y) * bflo(bw.y) + bfhi(cw.y) * bfhi(bw.y) + bflo(cw.z) * bflo(bw.z) + bfhi(cw.z) * bfhi(bw.z) + bflo(cw.w) * bflo(bw.w) + bfhi(cw.w) * bfhi(bw.w); }
    ((bf16_t*)(P.ws + WS_GB))[it] = f2bf(acc);
}
DEV void st_ssd_y(const Params& P, long it, int l) {
    const int p = (int)(it & 63), i = (int)((it >> 6) & 127), hd = (int)((it >> 13) & 3); const int bc = (int)(it >> 15); const size_t r0 = (size_t)bc * CHK, r = r0 + i;
    const float* sc4 = (const float*)(P.ws + WS_SC4); const float acf = sc4[(r * 4 + hd) * 4], acb = sc4[(r * 4 + hd) * 4 + 2];
    const bf16_t* gb = (const bf16_t*)(P.ws + WS_GB) + (((size_t)bc * 2 + (hd >> 1)) * 128 + i) * 128; const bf16_t* xt = (const bf16_t*)(P.ws + WS_XT) + ((size_t)bc * 256 + hd * 64 + p) * CHK;
    float y = 0.f;
    for (int j = 0; j < CHK; ++j) { const float* sj = sc4 + ((r0 + j) * 4 + hd) * 4; float w = 0.f;
        if (j <= i) w += exp2f(acf - sj[0]) * sj[1];
        if (j >= i) w += exp2f(acb - sj[2]) * sj[3];
        y += bf2f(gb[j]) * w * bf2f(xt[j]); }
    const bf16_t* cp = (const bf16_t*)(P.ws + WS_XBC) + r * XBP + 256 + (hd >> 1) * 128;
    for (int dir = 0; dir < 2; ++dir) { const bf16_t* hs = (const bf16_t*)(P.ws + WS_SST) + ((((size_t)bc * 4 + hd) * 2 + dir) * 64 + p) * 128; float t = 0.f;
        for (int n = 0; n < 128; ++n) t += bf2f(cp[n]) * bf2f(hs[n]);
        y += exp2f(dir ? acb : acf) * t; }
    const float xv = bf2f(xt[i]), zv = bf2f(((const bf16_t*)(P.ws + WS_ZT))[((size_t)bc * 256 + hd * 64 + p) * CHK + i]);
    ((float*)(P.ws + WS_YG))[r * 256 + hd * 64 + p] = (y + P.ssd_d[l * 4 + hd] * xv) * silu_f(zv);
}
DEV void st_ssd_norm(const Params& P, long it, int l) {
    const int r = (int)it; const float* yg = (const float*)(P.ws + WS_YG) + (size_t)r * 256; bf16_t* mix = (bf16_t*)(P.ws + WS_XN) + (size_t)r * DM + MIX_A;
    float ss = 0.f;
    for (int c = 0; c < 256; ++c) ss += yg[c] * yg[c];
    const float rs = 1.0f / sqrtf(ss * (1.0f / 256) + EPS);
    for (int c = 0; c < 256; ++c) mix[c] = f2bf(yg[c] * rs * P.ssd_norm_g[l * 256 + c]);
}
DEV void st_attn(const Params& P, long it, int l, int type) {
    const int hq = (int)(it / MT), r = (int)(it % MT); const int b = r / SB, s = r % SB; const bool isctx = s < CTX;
    if (isctx && l == NL - 1) return;
    const bf16_t* pl = (const bf16_t*)(P.ws + WS_PL); const int cb = type ? PL_D : PL_C; const int kcol = cb + 256 + (hq >> 1) * 64, vcol = kcol + 128;
    float q[64], o[64];
#pragma unroll
    for (int d = 0; d < 64; ++d) { q[d] = bf2f(pl[(size_t)r * NPL + cb + hq * 64 + d]); o[d] = 0.f; }
    float m = -INFINITY, ls = 0.f;
    for (int seg = 0; seg < 2; ++seg) {
        int lo, hi;
        if (seg == 0) { lo = 0; hi = CTX; }
        else { if (isctx) break; if (type == 0) { lo = CTX; hi = SB; } else { lo = s - 128 < CTX ? CTX : s - 128; hi = s + 129 > SB ? SB : s + 129; } }
        for (int sk = lo; sk < hi; ++sk) { const bf16_t* kp = pl + (size_t)(b * SB + sk) * NPL + kcol; const bf16_t* vp = pl + (size_t)(b * SB + sk) * NPL + vcol;
            float sc = 0.f;
#pragma unroll
            for (int d8 = 0; d8 < 8; ++d8) { const U4 w = *(const U4*)(kp + d8 * 8);
                sc += q[d8 * 8 + 0] * bflo(w.x) + q[d8 * 8 + 1] * bfhi(w.x) + q[d8 * 8 + 2] * bflo(w.y) + q[d8 * 8 + 3] * bfhi(w.y) + q[d8 * 8 + 4] * bflo(w.z) + q[d8 * 8 + 5] * bfhi(w.z) + q[d8 * 8 + 6] * bflo(w.w) + q[d8 * 8 + 7] * bfhi(w.w); }
            const float mn = fmaxf(m, sc); const float al = exp2f(m - mn), pe = exp2f(sc - mn); m = mn; ls = ls * al + pe;
#pragma unroll
            for (int d8 = 0; d8 < 8; ++d8) { const U4 w = *(const U4*)(vp + d8 * 8);
                o[d8 * 8 + 0] = o[d8 * 8 + 0] * al + pe * bflo(w.x); o[d8 * 8 + 1] = o[d8 * 8 + 1] * al + pe * bfhi(w.x); o[d8 * 8 + 2] = o[d8 * 8 + 2] * al + pe * bflo(w.y); o[d8 * 8 + 3] = o[d8 * 8 + 3] * al + pe * bfhi(w.y);
                o[d8 * 8 + 4] = o[d8 * 8 + 4] * al + pe * bflo(w.z); o[d8 * 8 + 5] = o[d8 * 8 + 5] * al + pe * bfhi(w.z); o[d8 * 8 + 6] = o[d8 * 8 + 6] * al + pe * bflo(w.w); o[d8 * 8 + 7] = o[d8 * 8 + 7] * al + pe * bfhi(w.w); } }
    }
    if (type == 1) { const float sk = P.swa_sink[l * 4 + hq] * LOG2E; const float mn = fmaxf(m, sk); const float al = exp2f(m - mn); ls = ls * al + exp2f(sk - mn);
#pragma unroll
        for (int d = 0; d < 64; ++d) o[d] *= al; }
    const float inv = 1.0f / ls; bf16_t* mix = (bf16_t*)(P.ws + WS_XN) + (size_t)r * DM + (type ? MIX_D : MIX_C) + hq * 64;
#pragma unroll
    for (int d = 0; d < 64; ++d) mix[d] = f2bf(o[d] * inv);
}

#ifndef CPU_EMU
__device__ __forceinline__ int tid_from_wave(int wave_s) { int z = 0; asm volatile("" : "+v"(z)); return (wave_s << 6) | (int)__builtin_amdgcn_mbcnt_hi(~0u, __builtin_amdgcn_mbcnt_lo(~0u, (unsigned)z)); }
namespace pg8 {
#define PG8_LAS __attribute__((address_space(3)))
typedef unsigned short bf16_t;
typedef short bf16x8 __attribute__((ext_vector_type(8)));
typedef float f32x4 __attribute__((ext_vector_type(4)));
typedef unsigned u32x4 __attribute__((ext_vector_type(4)));
constexpr int BM = 256, BK = 64, HALF = 128, HTB = HALF * BK * 2  , STAGE_BYTES = 8 * HTB, NXCD = 8, WGM = 4;

__host__ __device__ __forceinline__ int lds_byte(int r, int c) { const int st = (r >> 4) * 2 + (c >> 5), rr = r & 15, cc = c & 31, ob = rr * 64 + cc * 2; return st * 1024 + (ob ^ (((ob >> 9) & 1) << 5)); }
__host__ __device__ __forceinline__ void stage_rc(int b, int& R, int& C) { const int st = b / 1024, sb = b % 1024, swz = sb ^ (((sb >> 9) & 1) << 5); R = (st >> 1) * 16 + swz / 64; C = (st & 1) * 32 + (swz % 64) / 2; }
__host__ __device__ __forceinline__ int perm32(int rho) { const int n = rho >> 4, i = rho & 15; return 8 * (i >> 2) + 4 * n + (i & 3); }

struct Unit { int pm, pn, ko; };
struct Gemm { const bf16_t* A; const bf16_t* Bt; int M, N, K, ldk; };

struct StaticOrder {
    int nM, nN, nwg, G, c;
    __host__ __device__ void init(int M, int N, int G_, int c_) { nM = M / BM; nN = N / BM; nwg = nM * nN; G = G_; c = c_; }
    __host__ __device__ bool next(int i, Unit& u) const {
        const long L = (long)i * G + c; if (L >= nwg) return false;
        int wgid = (int)L; { const int q = nwg / NXCD, r = nwg % NXCD, xcd = wgid % NXCD, off = wgid / NXCD; wgid = (xcd < r ? xcd * (q + 1) : r * (q + 1) + (xcd - r) * q) + off; }
        const int nig = WGM * nN, gid = wgid / nig, fm = gid * WGM, gsz = (nM - fm) < WGM ? (nM - fm) : WGM;
        u.pm = fm + ((wgid % nig) % gsz); u.pn = (wgid % nig) / gsz; u.ko = 0; return true;
    }
    __device__ __forceinline__ void a_ready(const Unit&) const {}
    __device__ __forceinline__ void done(const Unit&) const {}
};

__device__ __forceinline__ unsigned cvt_pk_bf16(float lo, float hi) { unsigned r; asm volatile("v_cvt_pk_bf16_f32 %0, %1, %2" : "=v"(r) : "v"(lo), "v"(hi)); return r; }
typedef float f32x2 __attribute__((ext_vector_type(2)));

typedef unsigned u32x4 __attribute__((ext_vector_type(4)));
template <int ACT> struct EpiBf16A {
    static constexpr bool PERM = true, AFTER_DRAIN = false;
    bf16_t* O; int ldc; const float* rsq; const float* bias; float* dtp; int bpitch;
    __device__ __forceinline__ void operator()(const f32x4 (&acc)[2][2][4][2], const Unit& u, int wr, int wc, int fr_, int fq_) const {
        int fr = fr_, fq = fq_; asm volatile("" : "+v"(fr), "+v"(fq));
        const int row0 = u.pm * BM + wr * 64 + fr; const int col0 = u.pn * BM + wc * 32 + 8 * fq;
        if (dtp && u.pn * BM >= ldc) {
            if (wc == 0 && fq == 0) { f32x4 b0 = {0.f, 0.f, 0.f, 0.f}, b1 = b0;
                if (rsq) { constexpr int PPB = SB / 256; const float* bp_ = bias + (size_t)((u.pm % PPB) == 0 ? NB : u.pm / PPB) * bpitch + col0; b0 = *(const f32x4*)bp_; b1 = *(const f32x4*)(bp_ + 4); }
#pragma unroll
                for (int ai = 0; ai < 2; ++ai)
#pragma unroll
                    for (int m = 0; m < 4; ++m) { float* d = dtp + (size_t)(row0 + ai * HALF + m * 16) * 8; const float rsv = rsq ? __builtin_amdgcn_rsqf(rsq[row0 + ai * HALF + m * 16] * (1.0f / DM) + EPS) : 1.f;
                        *(f32x4*)d = acc[ai][0][m][0] * rsv + b0; *(f32x4*)(d + 4) = acc[ai][0][m][1] * rsv + b1; } }
            return; }
        f32x4 bv[2][2];
        if (rsq) { constexpr int PPB = SB / 256; const float* bp_ = bias + (size_t)((u.pm % PPB) == 0 ? NB : u.pm / PPB) * bpitch + col0;
#pragma unroll
            for (int bj = 0; bj < 2; ++bj) { bv[bj][0] = *(const f32x4*)(bp_ + bj * HALF); bv[bj][1] = *(const f32x4*)(bp_ + bj * HALF + 4); } }
#pragma unroll
        for (int ai = 0; ai < 2; ++ai)
#pragma unroll
            for (int m = 0; m < 4; ++m) { bf16_t* rowp = O + (size_t)(row0 + ai * HALF + m * 16) * ldc + col0;
                float rsv = 1.f; if (rsq) rsv = __builtin_amdgcn_rsqf(rsq[row0 + ai * HALF + m * 16] * (1.0f / DM) + EPS);
#pragma unroll
                for (int bj = 0; bj < 2; ++bj) { f32x4 v0 = acc[ai][bj][m][0], v1 = acc[ai][bj][m][1];
                    if (rsq) { v0 = v0 * rsv + bv[bj][0]; v1 = v1 * rsv + bv[bj][1]; }
                    if (ACT == 2) {
#pragma unroll
                        for (int e = 0; e < 4; ++e) { const float a = fmaxf(v0[e], 0.f), b = fmaxf(v1[e], 0.f); v0[e] = a * a; v1[e] = b * b; } }
                    u32x4 w; w.x = cvt_pk_bf16(v0[0], v0[1]); w.y = cvt_pk_bf16(v0[2], v0[3]); w.z = cvt_pk_bf16(v1[0], v1[1]); w.w = cvt_pk_bf16(v1[2], v1[3]);
                    *(u32x4*)(rowp + bj * HALF) = w; } }
    }
};
struct EpiResid {
    static constexpr bool PERM = true, AFTER_DRAIN = false;
    const void* in_lat; void* out_lat; int in_bf, out_bf; const float* mod; int goff; int kslice; float* slab; bf16_t* xa; const float* gn; const float* modn; int scoff; float* rsq;
    __device__ __forceinline__ void operator()(const f32x4 (&acc)[2][2][4][2], const Unit& u, int wr, int wc, int fr_, int fq_) const {
        int fr = fr_, fq = fq_; asm volatile("" : "+v"(fr), "+v"(fq) :: "memory");
        constexpr int PPB = SB / 256; const int b = u.pm / PPB, j = u.pm % PPB;
        const size_t lrow = ((size_t)b * SEQ + (size_t)(j - 1) * 256) * DM;
        const float* g = mod + (size_t)(j == 0 ? NB : b) * NMOD + goff;
        const int col0 = u.pn * BM + wc * 32 + 8 * fq;
        f32x4 gv[2][2], Gn[2][2];
#pragma unroll
        for (int bj = 0; bj < 2; ++bj)
#pragma unroll
            for (int n = 0; n < 2; ++n) { gv[bj][n] = *(const f32x4*)(g + col0 + bj * HALF + n * 4);
                if (xa) Gn[bj][n] = *(const f32x4*)(gn + col0 + bj * HALF + n * 4) * (1.f + *(const f32x4*)(modn + (size_t)(j == 0 ? NB : b) * NMOD + scoff + col0 + bj * HALF + n * 4)); }
        const int lane_ = fq * 16 + fr;
        u32x4 xr[2][4][2];
#define XR_LOAD(ai_) do { if (!kslice && in_bf) { _Pragma("unroll") for (int m_ = 0; m_ < 4; ++m_) _Pragma("unroll") for (int bj_ = 0; bj_ < 2; ++bj_) \
            xr[ai_][m_][bj_] = *(const u32x4*)((const bf16_t*)in_lat + lrow + (size_t)((ai_) * HALF + wr * 64 + m_ * 16 + fr) * DM + col0 + bj_ * HALF); } } while (0)
        XR_LOAD(0);
#pragma unroll
        for (int ai = 0; ai < 2; ++ai)
#pragma unroll
            for (int m = 0; m < 4; ++m) { const int rl = ai * HALF + wr * 64 + m * 16 + fr; const size_t off = (size_t)rl * DM + col0; float sq = 0.f;
                if (ai == 0 && m == 2) XR_LOAD(1);
#pragma unroll
                for (int bj = 0; bj < 2; ++bj) { const f32x4 t0 = gv[bj][0] * acc[ai][bj][m][0], t1 = gv[bj][1] * acc[ai][bj][m][1];
                    if (kslice) { float* sp = slab + ((size_t)(u.ko / kslice) * NB + b) * CTX * DM + off + bj * HALF; *(f32x4*)sp = t0; *(f32x4*)(sp + 4) = t1; }
                    else { f32x4 x0, x1;
                        if (in_bf) { const u32x4 w = xr[ai][m][bj];
                            x0 = f32x4{__uint_as_float(w.x << 16), __uint_as_float(w.x & 0xffff0000u), __uint_as_float(w.y << 16), __uint_as_float(w.y & 0xffff0000u)}; x1 = f32x4{__uint_as_float(w.z << 16), __uint_as_float(w.z & 0xffff0000u), __uint_as_float(w.w << 16), __uint_as_float(w.w & 0xffff0000u)}; }
                        else { x0 = *(const f32x4*)((const float*)in_lat + lrow + off + bj * HALF); x1 = *(const f32x4*)((const float*)in_lat + lrow + off + bj * HALF + 4); }
                        x0 += t0; x1 += t1;
                        if (out_bf) { u32x4 w; w.x = cvt_pk_bf16(x0[0], x0[1]); w.y = cvt_pk_bf16(x0[2], x0[3]); w.z = cvt_pk_bf16(x1[0], x1[1]); w.w = cvt_pk_bf16(x1[2], x1[3]); *(u32x4*)((bf16_t*)out_lat + lrow + off + bj * HALF) = w; }
                        else { *(f32x4*)((float*)out_lat + lrow + off + bj * HALF) = x0; *(f32x4*)((float*)out_lat + lrow + off + bj * HALF + 4) = x1; }
                        if (xa) { const f32x4 a0 = x0 * Gn[bj][0], a1 = x1 * Gn[bj][1]; u32x4 w; w.x = cvt_pk_bf16(a0[0], a0[1]); w.y = cvt_pk_bf16(a0[2], a0[3]); w.z = cvt_pk_bf16(a1[0], a1[1]); w.w = cvt_pk_bf16(a1[2], a1[3]);
                            *(u32x4*)(xa + ((size_t)u.pm * BM + rl) * DM + col0 + bj * HALF) = w;
                            sq += ((x0[0] * x0[0] + x0[1] * x0[1]) + (x0[2] * x0[2] + x0[3] * x0[3])) + ((x1[0] * x1[0] + x1[1] * x1[1]) + (x1[2] * x1[2] + x1[3] * x1[3])); } } }
                if (xa && !kslice) { sq += __int_as_float(__builtin_amdgcn_ds_bpermute((lane_ ^ 16) << 2, __float_as_int(sq))); sq += __int_as_float(__builtin_amdgcn_ds_bpermute((lane_ ^ 32) << 2, __float_as_int(sq)));
                    if (fq == 0) atomicAdd(rsq + (size_t)u.pm * BM + rl, sq); }
                if (m & 1) asm volatile("" ::: "memory"); }
#undef XR_LOAD
    }
};
struct RowOrder {
    static constexpr int KSPLIT = 4;
    StaticOrder S; int mode, nN, G, c, kslice;
    __device__ void init(int N, int G_, int c_, int mode_, int kslice_ = 0) { mode = mode_; nN = N / BM; G = G_; c = c_; kslice = kslice_; S.init(mode_ == 1 ? NB * SEQ : MT, N, G_, c_); }
    __device__ bool next(int i, Unit& u) const {
        if (mode == 2) { const int Lx = i * G + c; if (Lx >= NB * nN * KSPLIT) return false; const int ks = Lx % KSPLIT, t = Lx / KSPLIT; u.pn = t % nN; u.pm = (t / nN) * (SB / 256); u.ko = ks * kslice; return true; }
        if (!S.next(i, u)) return false; if (mode == 1) u.pm = u.pm + u.pm / (SEQ / 256) + 1; return true; }
    __device__ __forceinline__ void a_ready(const Unit&) const {}
    __device__ __forceinline__ void done(const Unit&) const {}
};
template <class Epi, class Sched, bool ALIGN_EPI = false, bool SP2 = false>
__device__ __forceinline__ void gemm_phase(PG8_LAS unsigned char* lds, const Gemm g, const Sched& S, const Epi& E, int wave_s) {
    const int tid = tid_from_wave(wave_s);
    const int wid = __builtin_amdgcn_readfirstlane(tid >> 6), lane = tid & 63, wr = wid >> 2, wc = wid & 3, fr = lane & 15, fq = lane >> 4;
    const int K = g.ldk, nt = g.K / BK;
    unsigned voffA[2], voffB[2];
#pragma unroll
    for (int i = 0; i < 2; ++i) { int R, C; stage_rc(tid * 16 + i * 8192, R, C); const int Rb = Epi::PERM ? ((R & ~31) + perm32(R & 31)) : R;
        voffA[i] = (unsigned)(R * K + C) * 2u; voffB[i] = (unsigned)(Rb * K + C) * 2u; }
    const size_t kstep = (size_t)(BK * 2);
    const size_t hstep = (size_t)HALF * K * 2;
    const size_t tstep = 2 * hstep;
    const unsigned ldsw = (unsigned)wid * 1024u;
    const int aoff = lds_byte(wr * 64 + fr, fq * 8), boff = lds_byte(wc * 32 + fr, fq * 8);
#define PG8_SA(b, h) (((b) * 2 + (h)) * HTB)
#define PG8_SB(b, h) ((4 + (b) * 2 + (h)) * HTB)
#define PG8_STAGE(bufoff, gbase, voff) do { _Pragma("unroll") for (int _i = 0; _i < 2; ++_i) \
        __builtin_amdgcn_global_load_lds((const unsigned*)((const char*)(gbase) + (voff)[_i]), (PG8_LAS unsigned*)(lds + (bufoff) + ldsw + _i * 8192), 16, 0, 0); } while (0)
#define PG8_LDA(dst, b, h) do { _Pragma("unroll") for (int m = 0; m < 4; ++m) _Pragma("unroll") for (int k = 0; k < 2; ++k) dst[m][k] = *(const PG8_LAS bf16x8*)(lds + PG8_SA(b, h) + aoff + m * 2048 + k * 1024); } while (0)
#define PG8_LDB(dst, b, h) do { _Pragma("unroll") for (int n = 0; n < 2; ++n) _Pragma("unroll") for (int k = 0; k < 2; ++k) dst[n][k] = *(const PG8_LAS bf16x8*)(lds + PG8_SB(b, h) + boff + n * 2048 + k * 1024); } while (0)
#define PG8_MMA(ai, bj, At, Bt) do { __builtin_amdgcn_s_setprio(1); _Pragma("unroll") for (int m = 0; m < 4; ++m) _Pragma("unroll") for (int n = 0; n < 2; ++n) _Pragma("unroll") for (int k = 0; k < 2; ++k) \
        acc[ai][bj][m][n] = __builtin_amdgcn_mfma_f32_16x16x32_bf16(Bt[n][k], At[m][k], acc[ai][bj][m][n], 0, 0, 0); __builtin_amdgcn_s_setprio(0); } while (0)
#define PG8_WAIT_V(n) asm volatile("s_waitcnt vmcnt(" #n ")" ::: "memory")
#define PG8_WAIT_L(n) asm volatile("s_waitcnt lgkmcnt(" #n ")" ::: "memory")
#define PG8_BAR __builtin_amdgcn_s_barrier()
#define PG8_SCHED __builtin_amdgcn_sched_barrier(0)
    Unit cur, nxt; int ui = 0;
    if (!S.next(0, cur)) return;
    f32x4 acc[2][2][4][2];
#pragma unroll
    for (int a = 0; a < 2; ++a)
#pragma unroll
        for (int b = 0; b < 2; ++b)
#pragma unroll
            for (int m = 0; m < 4; ++m)
#pragma unroll
                for (int n = 0; n < 2; ++n) acc[a][b][m][n] = (f32x4){0.f, 0.f, 0.f, 0.f};
    bf16x8 At[4][2], B0[2][2], B1[2][2];
    const char* cA = (const char*)g.A + (size_t)cur.pm * tstep + (size_t)cur.ko * 2; const char* cB = (const char*)g.Bt + (size_t)cur.pn * tstep + (size_t)cur.ko * 2;
    S.a_ready(cur);
    if constexpr (SP2) {
        PG8_STAGE(PG8_SB(0, 0), cB, voffB); PG8_STAGE(PG8_SB(0, 1), cB + hstep, voffB); PG8_STAGE(PG8_SA(0, 0), cA, voffA); PG8_STAGE(PG8_SA(0, 1), cA + hstep, voffA);
        if (wr == 1) PG8_BAR;
        PG8_WAIT_V(2); PG8_BAR;
        PG8_STAGE(PG8_SB(1, 0), cB + kstep, voffB); PG8_STAGE(PG8_SA(1, 0), cA + kstep, voffA); PG8_STAGE(PG8_SB(1, 1), cB + hstep + kstep, voffB);
        PG8_WAIT_V(6); PG8_BAR;
    } else {
        PG8_STAGE(PG8_SB(0, 0), cB, voffB); PG8_STAGE(PG8_SA(0, 0), cA, voffA); PG8_STAGE(PG8_SB(0, 1), cB + hstep, voffB); PG8_STAGE(PG8_SA(0, 1), cA + hstep, voffA);
        if (wr == 1) PG8_BAR;
        PG8_WAIT_V(4); PG8_BAR;
        PG8_STAGE(PG8_SB(1, 0), cB + kstep, voffB); PG8_STAGE(PG8_SA(1, 0), cA + kstep, voffA); PG8_STAGE(PG8_SB(1, 1), cB + hstep + kstep, voffB);
        PG8_WAIT_V(6); PG8_BAR;
    }
    for (;;) {
        const bool has_next = S.next(ui + 1, nxt);
        const char* nA = has_next ? (const char*)g.A + (size_t)nxt.pm * tstep + (size_t)nxt.ko * 2 : cA; const char* nB = has_next ? (const char*)g.Bt + (size_t)nxt.pn * tstep + (size_t)nxt.ko * 2 : cB;
        for (int t = 0; t < nt; t += 2) {
            const bool last = (t == nt - 2);
            const char* a1 = cA + (size_t)(t + 1) * kstep;
            const char* a2 = last ? nA : cA + (size_t)(t + 2) * kstep; const char* b2 = last ? nB : cB + (size_t)(t + 2) * kstep;
            const char* a3 = a2 + kstep; const char* b3 = b2 + kstep;
            if (last && has_next) S.a_ready(nxt);
            if constexpr (SP2) {
            PG8_LDB(B0, 0, 0); PG8_LDB(B1, 0, 1); PG8_SCHED; PG8_LDA(At, 0, 0); PG8_STAGE(PG8_SA(1, 1), a1 + hstep, voffA);
            PG8_WAIT_V(8); PG8_WAIT_L(0); PG8_BAR; PG8_MMA(0, 0, At, B0); PG8_MMA(0, 1, At, B1); PG8_BAR; PG8_SCHED;
            PG8_LDA(At, 0, 1); PG8_STAGE(PG8_SB(0, 0), b2, voffB); PG8_STAGE(PG8_SB(0, 1), b2 + hstep, voffB); PG8_STAGE(PG8_SA(0, 0), a2, voffA);
            PG8_WAIT_V(8); PG8_WAIT_L(0); PG8_BAR; PG8_MMA(1, 0, At, B0); PG8_MMA(1, 1, At, B1); PG8_BAR; PG8_SCHED;
            PG8_LDB(B0, 1, 0); PG8_LDB(B1, 1, 1); PG8_SCHED; PG8_LDA(At, 1, 0); PG8_STAGE(PG8_SA(0, 1), a2 + hstep, voffA);
            PG8_WAIT_V(8); PG8_WAIT_L(0); PG8_BAR; PG8_MMA(0, 0, At, B0); PG8_MMA(0, 1, At, B1); PG8_BAR; PG8_SCHED;
            PG8_LDA(At, 1, 1); PG8_STAGE(PG8_SB(1, 0), b3, voffB); PG8_STAGE(PG8_SB(1, 1), b3 + hstep, voffB); PG8_STAGE(PG8_SA(1, 0), a3, voffA);
            PG8_WAIT_V(8); PG8_WAIT_L(0); PG8_BAR; PG8_MMA(1, 0, At, B0); PG8_MMA(1, 1, At, B1); PG8_BAR; PG8_SCHED;
            } else {
            PG8_LDB(B0, 0, 0); PG8_SCHED; PG8_LDA(At, 0, 0); PG8_STAGE(PG8_SA(1, 1), a1 + hstep, voffA);
            PG8_WAIT_L(8); PG8_BAR; PG8_WAIT_L(0); PG8_MMA(0, 0, At, B0); PG8_BAR; PG8_SCHED;
            PG8_LDB(B1, 0, 1); PG8_STAGE(PG8_SB(0, 0), b2, voffB);
            PG8_BAR; PG8_WAIT_L(0); PG8_MMA(0, 1, At, B1); PG8_BAR;
            PG8_LDA(At, 0, 1); PG8_STAGE(PG8_SA(0, 0), a2, voffA);
            PG8_BAR; PG8_WAIT_L(0); PG8_MMA(1, 0, At, B0); PG8_BAR; PG8_SCHED;
            PG8_STAGE(PG8_SB(0, 1), b2 + hstep, voffB);
            PG8_WAIT_V(6); PG8_BAR; PG8_MMA(1, 1, At, B1); PG8_BAR;
            PG8_LDB(B0, 1, 0); PG8_SCHED; PG8_LDA(At, 1, 0); PG8_STAGE(PG8_SA(0, 1), a2 + hstep, voffA);
            PG8_WAIT_L(8); PG8_BAR; PG8_WAIT_L(0); PG8_MMA(0, 0, At, B0); PG8_BAR; PG8_SCHED;
            PG8_LDB(B1, 1, 1); PG8_STAGE(PG8_SB(1, 0), b3, voffB);
            PG8_BAR; PG8_WAIT_L(0); PG8_MMA(0, 1, At, B1); PG8_BAR;
            PG8_LDA(At, 1, 1); PG8_STAGE(PG8_SA(1, 0), a3, voffA);
            PG8_BAR; PG8_WAIT_L(0); PG8_MMA(1, 0, At, B0); PG8_BAR; PG8_SCHED;
            PG8_STAGE(PG8_SB(1, 1), b3 + hstep, voffB);
            PG8_WAIT_V(6); PG8_BAR; PG8_MMA(1, 1, At, B1); PG8_BAR;
            }
        }
        if constexpr (ALIGN_EPI) { if (wr == 0) PG8_BAR; }
        if constexpr (!Epi::AFTER_DRAIN) { E(acc, cur, wr, wc, fr, fq); S.done(cur); }
        if (!has_next) break;
#pragma unroll
        for (int a = 0; a < 2; ++a)
#pragma unroll
            for (int b = 0; b < 2; ++b)
#pragma unroll
                for (int m = 0; m < 4; ++m)
#pragma unroll
                    for (int n = 0; n < 2; ++n) acc[a][b][m][n] = (f32x4){0.f, 0.f, 0.f, 0.f};
        cur = nxt; cA = nA; cB = nB; ++ui;
        if constexpr (ALIGN_EPI) { if (wr == 1) PG8_BAR; }
    }
    PG8_WAIT_V(0);
    if constexpr (!ALIGN_EPI) { if (wr == 0) PG8_BAR; }
    PG8_BAR;
    if constexpr (Epi::AFTER_DRAIN) { E.fused(acc, cur, wr, wc, fr, fq, lds, wid, lane); S.done(cur); }
#undef PG8_SA
#undef PG8_SB
#undef PG8_STAGE
#undef PG8_LDA
#undef PG8_LDB
#undef PG8_MMA
#undef PG8_WAIT_V
#undef PG8_WAIT_L
#undef PG8_BAR
#undef PG8_SCHED
}
}

#include <hip/hip_bf16.h>
#include <cmath>
namespace attn_body {
using bf16=__hip_bfloat16;
using bf16x8=__attribute__((ext_vector_type(8)))short;
using s16x4=__attribute__((ext_vector_type(4)))short;
using f32x16=__attribute__((ext_vector_type(16)))float;
using u32x4=__attribute__((ext_vector_type(4)))unsigned;
constexpr int D=64,PP=NPL,OP=::DM;
constexpr int NW=8,QBLK=32,QB=QBLK*NW,KVBLK=64;
__device__ __forceinline__ int crow(int r,int hi){return (r&3)+8*(r>>2)+4*hi;}
#define SBAR() __builtin_amdgcn_sched_barrier(0)
__device__ __forceinline__ void wmask(f32x16&p0,f32x16&p1,int dk,int hi){
  const float NEG=-INFINITY; const int kb=dk+4*hi;
  #pragma unroll
  for(int r=0;r<16;++r){const int d=kb+(r&3)+8*(r>>2); if(d>128||d<-128)p0[r]=NEG; if(d+32>128||d+32<-128)p1[r]=NEG;}
}
struct AttnDesc { int qrow,qcol,kcol,vcol,ocol,rowA,rowB,NT,masked,qpos0,kpos4,has_sink; float sinkl2; const float* qg; int rope; };

constexpr int NSLOT=3, SLOTB=8192;
constexpr int LDS_K=0, LDS_V=NSLOT*SLOTB, LDS_WS=2*NSLOT*SLOTB, LDS_OST=LDS_WS+NW*64*4, LDS_BYTES=LDS_OST+NW*4096;
constexpr float C2=0.125f*1.4426950408889634f;
__device__ __forceinline__ void glds16(const void*gsrc,unsigned lds_dst){unsigned keep;
  asm volatile("s_mov_b32 %0, m0\n\ts_mov_b32 m0, %2\n\ts_nop 0\n\tglobal_load_lds_dwordx4 %1, off\n\ts_mov_b32 m0, %0":"=&s"(keep):"v"(gsrc),"s"(lds_dst):"memory");}
__device__ __forceinline__ float max3f(float a,float b,float c){float r;asm("v_max3_f32 %0, %1, %2, %3":"=v"(r):"v"(a),"v"(b),"v"(c));return r;}
__device__ __forceinline__ float max2f(float a,float b){float r;asm("v_max_f32_e32 %0, %1, %2":"=v"(r):"v"(a),"v"(b));return r;}
__device__ __forceinline__ float fadd_s(float a,float b){float r;asm("v_add_f32_e32 %0, %1, %2":"=v"(r):"v"(a),"v"(b));return r;}
__device__ __forceinline__ float fsub_s(float a,float b){float r;asm("v_sub_f32_e32 %0, %1, %2":"=v"(r):"v"(a),"v"(b));return r;}
typedef float f32x2_t __attribute__((ext_vector_type(2))); typedef __bf16 bf16x2_t __attribute__((ext_vector_type(2)));
__device__ __forceinline__ unsigned cvtpk_s(float lo,float hi){f32x2_t v={lo,hi};bf16x2_t b=__builtin_convertvector(v,bf16x2_t);return __builtin_bit_cast(unsigned,b);}
#define WAIT_BAR(N) asm volatile("s_waitcnt vmcnt(" #N ") lgkmcnt(0)\n\ts_barrier":::"memory")

__device__ __forceinline__ void qkt(f32x16&p0,f32x16&p1,const char*Kslot,const bf16x8*qr,const f32x16&negm,int r32,int hi){
  const char*kb=Kslot+hi*1024+r32*16;
  #pragma unroll
  for(int d0=0;d0<4;++d0){
    const bf16x8 b0=*reinterpret_cast<const bf16x8*>(kb+d0*2048);
    const bf16x8 b1=*reinterpret_cast<const bf16x8*>(kb+d0*2048+512);
    if(d0==0){p0=__builtin_amdgcn_mfma_f32_32x32x16_bf16(b0,qr[0],negm,0,0,0);p1=__builtin_amdgcn_mfma_f32_32x32x16_bf16(b1,qr[0],negm,0,0,0);}
    else{p0=__builtin_amdgcn_mfma_f32_32x32x16_bf16(b0,qr[d0],p0,0,0,0);p1=__builtin_amdgcn_mfma_f32_32x32x16_bf16(b1,qr[d0],p1,0,0,0);}}
}
typedef __attribute__((address_space(3))) const char* lds_cptr;
typedef short v4i16_t __attribute__((ext_vector_type(4)));
__device__ __forceinline__ void kload8(bf16x8*kf,lds_cptr kp){
  kf[0]=*(const __attribute__((address_space(3))) bf16x8*)(kp);      kf[1]=*(const __attribute__((address_space(3))) bf16x8*)(kp+512);
  kf[2]=*(const __attribute__((address_space(3))) bf16x8*)(kp+2048); kf[3]=*(const __attribute__((address_space(3))) bf16x8*)(kp+2560);
  kf[4]=*(const __attribute__((address_space(3))) bf16x8*)(kp+4096); kf[5]=*(const __attribute__((address_space(3))) bf16x8*)(kp+4608);
  kf[6]=*(const __attribute__((address_space(3))) bf16x8*)(kp+6144); kf[7]=*(const __attribute__((address_space(3))) bf16x8*)(kp+6656);
}
__device__ __forceinline__ void kload2(bf16x8*kf,lds_cptr kp,int j){ kf[2*j]=*(const __attribute__((address_space(3))) bf16x8*)(kp+j*2048); kf[2*j+1]=*(const __attribute__((address_space(3))) bf16x8*)(kp+j*2048+512); }
__device__ __forceinline__ s16x4 vtr(lds_cptr p){ return __builtin_bit_cast(s16x4,__builtin_amdgcn_ds_read_tr16_b64_v4i16((__attribute__((address_space(3))) v4i16_t*)p)); }
__device__ __forceinline__ float rowmax(const f32x16&p0,const f32x16&p1){
  float a=max3f(p0[0],p0[1],p1[0]),b=max3f(p0[2],p0[3],p1[1]);a=max3f(a,p1[2],p1[3]);
  #pragma unroll
  for(int r=4;r<16;r+=4){a=max3f(a,p0[r],p0[r+1]);b=max3f(b,p0[r+2],p0[r+3]);a=max3f(a,p1[r],p1[r+1]);b=max3f(b,p1[r+2],p1[r+3]);}
  const float m=max2f(a,b);
  auto rr=__builtin_amdgcn_permlane32_swap(__float_as_uint(m),__float_as_uint(m),false,false);
  return max2f(__uint_as_float(rr[0]),__uint_as_float(rr[1]));
}
__device__ __forceinline__ void pv(f32x16*o,int vb,bf16x8 pa0,bf16x8 pa1,bf16x8 pa2,bf16x8 pa3){
  #pragma unroll
  for(int d0=0;d0<2;++d0){s16x4 lo[4],hi[4];
    #pragma unroll
    for(int ks=0;ks<4;++ks){
      asm volatile("ds_read_b64_tr_b16 %0,%1 offset:%c2":"=&v"(lo[ks]):"v"(vb),"i"(d0*4096+ks*1024):"memory");
      asm volatile("ds_read_b64_tr_b16 %0,%1 offset:%c2":"=&v"(hi[ks]):"v"(vb),"i"(d0*4096+ks*1024+512):"memory");}
    asm volatile("s_waitcnt lgkmcnt(0)":::"memory");SBAR();
    #define PK(k) (bf16x8){lo[k][0],lo[k][1],lo[k][2],lo[k][3],hi[k][0],hi[k][1],hi[k][2],hi[k][3]}
    o[d0]=__builtin_amdgcn_mfma_f32_32x32x16_bf16(pa0,PK(0),o[d0],0,0,0);
    o[d0]=__builtin_amdgcn_mfma_f32_32x32x16_bf16(pa1,PK(1),o[d0],0,0,0);
    o[d0]=__builtin_amdgcn_mfma_f32_32x32x16_bf16(pa2,PK(2),o[d0],0,0,0);
    o[d0]=__builtin_amdgcn_mfma_f32_32x32x16_bf16(pa3,PK(3),o[d0],0,0,0);
    #undef PK
  }
}

#ifndef ATTN_STORE16
#define ATTN_STORE16(p,v) (*(u32x4*)(p)=(v))
#endif
template<int THRL> __device__ __forceinline__ void attn_unit(const AttnDesc u,const bf16*__restrict__ PLb,bf16*__restrict__ MIXb,char*shm,int wave_s){
  const int tid=tid_from_wave(wave_s);
  const int lane=tid&63,r32=lane&31,hi=lane>>5; const int wid=__builtin_amdgcn_readfirstlane(tid>>6);
  const bf16*Qw=PLb+(long)(u.qrow+wid*QBLK)*PP+u.qcol;
  const bf16*Kh=PLb+u.kcol,*Vh=PLb+u.vcol;
  const unsigned lds0=(unsigned)(uintptr_t)shm;
  float*wsf=(float*)(shm+LDS_WS)+wid*64;
  const bf16*ksrc=Kh+(long)lane*PP+wid*8;
  const bf16*vsrc=Vh+(long)(16*(wid&3)+(lane>>2))*PP+(wid>>2)*32+(lane&3)*8;
  #define TROW(t) ((t)<4 ? u.rowA+64*(t) : u.rowB+64*((t)-4))
  const unsigned kdst=lds0+LDS_K+wid*1024, vdst=lds0+LDS_V+wid*1024;
  #define DMA_K(t,slot) glds16(ksrc+(long)TROW(t)*PP,(unsigned)__builtin_amdgcn_readfirstlane(kdst+(slot)))
  #define DMA_V(t,slot) glds16(vsrc+(long)TROW(t)*PP,(unsigned)__builtin_amdgcn_readfirstlane(vdst+(slot)))
  const int vb0=(int)(lds0+LDS_V)+((lane>>4)&1)*32+(lane&3)*8+(4*hi+((lane&15)>>2))*64;
  const char*Kbase=shm+LDS_K; bf16x8 kf[8];
  const lds_cptr shm3=(lds_cptr)shm; const lds_cptr kp0=shm3+LDS_K+hi*1024+r32*16; const lds_cptr vp0=shm3+LDS_V+((lane>>4)&1)*32+(lane&3)*8+(4*hi+((lane&15)>>2))*64;
  const int NT=u.NT;
  typedef float f32x4a __attribute__((ext_vector_type(4))); u32x4 qv[4]; f32x4a gq_[8];
  { const bf16*qp_=&Qw[(long)r32*PP+hi*8]; const float*gp_=u.qg+8*hi;
    #pragma unroll
    for(int d0=0;d0<4;++d0){ const bf16*a_=qp_+d0*16; asm volatile("global_load_dwordx4 %0, %1, off":"=&v"(qv[d0]):"v"(a_):"memory"); }
    #pragma unroll
    for(int k=0;k<8;++k){ const float*a_=gp_+16*(k>>1)+4*(k&1); asm volatile("global_load_dwordx4 %0, %1, off":"=&v"(gq_[k]):"v"(a_):"memory"); } }
  DMA_K(0,0);DMA_V(0,0);DMA_K(1,SLOTB);DMA_K(2,2*SLOTB);
  asm volatile("s_waitcnt vmcnt(4)":"+v"(qv[0]),"+v"(qv[1]),"+v"(qv[2]),"+v"(qv[3]),"+v"(gq_[0]),"+v"(gq_[1]),"+v"(gq_[2]),"+v"(gq_[3]),"+v"(gq_[4]),"+v"(gq_[5]),"+v"(gq_[6]),"+v"(gq_[7])::"memory");
  bf16x8 qr[4];
  { float xq[4][8]; float ss=0.f;
    #pragma unroll
    for(int d0=0;d0<4;++d0)
      #pragma unroll
      for(int e=0;e<8;++e){ const unsigned w_=qv[d0][e>>1]; xq[d0][e]=__uint_as_float((e&1)?(w_&0xffff0000u):(w_<<16)); ss+=xq[d0][e]*xq[d0][e]; }
    { auto rr=__builtin_amdgcn_permlane32_swap(__float_as_uint(ss),__float_as_uint(ss),false,false); ss=__uint_as_float(rr[0])+__uint_as_float(rr[1]); }
    const float rsn=__builtin_amdgcn_rsqf(ss*(1.0f/64)+EPS)*C2;
    const int qp=u.qpos0+wid*QBLK+r32; const float pr=(float)(qp/GRIDW),pc=(float)(qp%GRIDW);
    #pragma unroll
    for(int e=0;e<8;++e){ const float invr=expf(-(float)(8*hi+e)*(9.210340371976184f/16.f))*0.15915494309189535f;
      #pragma unroll
      for(int a=0;a<2;++a){ float cs=1.f,sn=0.f; if(u.rope){ const float rev=(a?pc:pr)*invr; cs=__builtin_amdgcn_cosf(rev); sn=__builtin_amdgcn_sinf(rev); }
        const float x1=xq[2*a][e]*rsn*gq_[2*(2*a)+(e>>2)][e&3], x2=xq[2*a+1][e]*rsn*gq_[2*(2*a+1)+(e>>2)][e&3];
        xq[2*a][e]=x1*cs-x2*sn; xq[2*a+1][e]=x2*cs+x1*sn; } }
    #pragma unroll
    for(int d0=0;d0<4;++d0){ u32x4 w; w[0]=cvtpk_s(xq[d0][0],xq[d0][1]); w[1]=cvtpk_s(xq[d0][2],xq[d0][3]); w[2]=cvtpk_s(xq[d0][4],xq[d0][5]); w[3]=cvtpk_s(xq[d0][6],xq[d0][7]); qr[d0]=__builtin_bit_cast(bf16x8,w); } }
  float mhat=0.f,l_reg=0.f;f32x16 o[2];o[0]=f32x16{};o[1]=f32x16{};f32x16 negm=f32x16{};asm volatile("":"+v"(negm));
  const int qpos=u.qpos0+wid*QBLK+r32;
  #define CMASK(P0,P1,t) do{ if(u.masked && (t)>=4) wmask(P0,P1,u.kpos4+64*((t)-4)-qpos,hi); }while(0)
  bool resc=false;
  #define START(P0,P1) do{ const float rm=rowmax(P0,P1); resc=false; \
    { const float dl=rm; mhat=fadd_s(mhat,dl); \
      _Pragma("unroll") for(int r=0;r<16;++r){P0[r]=fsub_s(P0[r],dl);P1[r]=fsub_s(P1[r],dl);} \
      _Pragma("unroll") for(int r=0;r<16;++r)negm[r]=-mhat; asm volatile("":"+v"(negm)); } \
    _Pragma("unroll") for(int r=0;r<16;++r)P0[r]=__builtin_amdgcn_exp2f(P0[r]); }while(0)
  #define RESC() do{ if(resc){ asm volatile("s_waitcnt lgkmcnt(0)":::"memory"); \
      _Pragma("unroll") for(int d_=0;d_<2;++d_) _Pragma("unroll") for(int r=0;r<16;++r)o[d_][r]*=wsf[crow(r,hi)]; } }while(0)
  f32x16 pA0,pA1,pB0,pB1;
  int sl_prev=0,sl_cur=0,sl_next=SLOTB;
  #define ROT() do{sl_prev=sl_cur;sl_cur=sl_next;sl_next=(sl_next==(NSLOT-1)*SLOTB)?0:sl_next+SLOTB;}while(0)
  WAIT_BAR(3);
  qkt(pA0,pA1,Kbase,qr,negm,r32,hi);asm volatile("s_nop 15\n\ts_nop 7":"+v"(pA0),"+v"(pA1));CMASK(pA0,pA1,0);
  START(pA0,pA1);
  _Pragma("unroll") for(int r=0;r<16;++r)pA1[r]=__builtin_amdgcn_exp2f(pA1[r]);
  WAIT_BAR(0);
  DMA_K(3,0);DMA_V(1,SLOTB);
  ROT();
  kload8(kf,kp0+sl_cur);
  WAIT_BAR(2);
  s16x4 vlo[8],vhi[8]; u32x4 pw0,pw1,pw2,pw3;
  #define PKW(P,B) cvtpk_s(P[B],P[B+1])
  #define PAF(k) __builtin_bit_cast(bf16x8,pw##k)
  #define VFR(i) (bf16x8){vlo[i][0],vlo[i][1],vlo[i][2],vlo[i][3],vhi[i][0],vhi[i][1],vhi[i][2],vhi[i][3]}
  #define PIN(x) asm volatile("":"+v"(x))
  #define MX3(a,b,c) __builtin_fmaxf(__builtin_fmaxf((a),(b)),(c))
  #define GAPA(MF,A0,A1,A2,A3,W0,W1,PW) do{ MF; sacc+=A0; sacc+=A1; sacc+=A2; sacc+=A3; PIN(sacc); W0; W1; PIN(PW); SBAR(); }while(0)
  #define EX(v) __builtin_amdgcn_exp2f(v)
  #define GAPB(MF,X,B) do{ MF; X[B]=EX(X[B]); X[B+1]=EX(X[B+1]); X[B+2]=EX(X[B+2]); X[B+3]=EX(X[B+3]); PIN(X); SBAR(); }while(0)
  #define VRD(i) do{ vlo[i]=vtr(vp_+(((i)>>2)*4096+((i)&3)*1024)); vhi[i]=vtr(vp_+(((i)>>2)*4096+((i)&3)*1024+512)); }while(0)
  #define KRD(G,j) do{ if(G){ kload2(kf,kp0+sl_next,j); SBAR(); } }while(0)
  #define STEP(C0,C1,P0,P1,t,GK,GV,GL) do{ SBAR(); \
    const lds_cptr vp_=vp0+sl_prev; \
    VRD(0); SBAR(); float sacc=(P0[0]+P0[1]); \
    GAPA(C0=__builtin_amdgcn_mfma_f32_32x32x16_bf16(kf[0],qr[0],negm,0,0,0), P0[2],P0[3],P0[4],P0[5],     pw0[0]=PKW(P0,0), pw0[1]=PKW(P0,2), pw0); \
    VRD(4); SBAR(); GAPA(C1=__builtin_amdgcn_mfma_f32_32x32x16_bf16(kf[1],qr[0],negm,0,0,0), P0[6],P0[7],P0[8],P0[9],     pw0[2]=PKW(P0,4), pw0[3]=PKW(P0,6), pw0); \
    VRD(1); SBAR(); GAPA(C0=__builtin_amdgcn_mfma_f32_32x32x16_bf16(kf[2],qr[1],C0,0,0,0),   P0[10],P0[11],P0[12],P0[13], pw1[0]=PKW(P0,8), pw1[1]=PKW(P0,10), pw1); \
    VRD(5); SBAR(); GAPA(C1=__builtin_amdgcn_mfma_f32_32x32x16_bf16(kf[3],qr[1],C1,0,0,0),   P0[14],P0[15],P1[0],P1[1],   pw1[2]=PKW(P0,12),pw1[3]=PKW(P0,14), pw1); \
    VRD(2); SBAR(); GAPA(C0=__builtin_amdgcn_mfma_f32_32x32x16_bf16(kf[4],qr[2],C0,0,0,0),   P1[2],P1[3],P1[4],P1[5],     pw2[0]=PKW(P1,0), pw2[1]=PKW(P1,2), pw2); \
    VRD(6); SBAR(); GAPA(C1=__builtin_amdgcn_mfma_f32_32x32x16_bf16(kf[5],qr[2],C1,0,0,0),   P1[6],P1[7],P1[8],P1[9],     pw2[2]=PKW(P1,4), pw2[3]=PKW(P1,6), pw2); \
    VRD(3); SBAR(); GAPA(C0=__builtin_amdgcn_mfma_f32_32x32x16_bf16(kf[6],qr[3],C0,0,0,0),   P1[10],P1[11],P1[12],P1[13], pw3[0]=PKW(P1,8), pw3[1]=PKW(P1,10), pw3); \
    VRD(7); SBAR(); GAPA(C1=__builtin_amdgcn_mfma_f32_32x32x16_bf16(kf[7],qr[3],C1,0,0,0),   P1[14],P1[15],0.f,0.f,       pw3[2]=PKW(P1,12),pw3[3]=PKW(P1,14), pw3); \
    l_reg+=sacc; \
    if(GK){DMA_K((t)+3,sl_cur);} if(GV){DMA_V((t)+1,sl_next);} \
    CMASK(C0,C1,t); \
    { float a=MX3(C0[0],C0[1],C1[0]),b=MX3(C0[2],C0[3],C1[1]); a=MX3(a,C1[2],C1[3]); \
      _Pragma("unroll") for(int r=4;r<16;r+=4){a=MX3(a,C0[r],C0[r+1]);b=MX3(b,C0[r+2],C0[r+3]);a=MX3(a,C1[r],C1[r+1]);b=MX3(b,C1[r+2],C1[r+3]);} \
      float rm=__builtin_fmaxf(a,b); { auto rr=__builtin_amdgcn_permlane32_swap(__float_as_uint(rm),__float_as_uint(rm),false,false); rm=__builtin_fmaxf(__uint_as_float(rr[0]),__uint_as_float(rr[1])); } \
      resc=false; \
      if(__builtin_expect(__any(rm>(float)THRL),0)){ const float dl=__builtin_fmaxf(rm,0.f); mhat+=dl; \
        _Pragma("unroll") for(int r=0;r<16;++r){C0[r]-=dl;C1[r]-=dl;} \
        _Pragma("unroll") for(int r=0;r<16;++r)negm[r]=-mhat; asm volatile("":"+v"(negm)); \
        const float f=__builtin_amdgcn_exp2f(-dl); l_reg*=f; if(hi==0)wsf[r32]=f; resc=true; } } \
    SBAR(); \
    GAPB(o[0]=__builtin_amdgcn_mfma_f32_32x32x16_bf16(PAF(0),VFR(0),o[0],0,0,0), C0,0); \
    GAPB(o[1]=__builtin_amdgcn_mfma_f32_32x32x16_bf16(PAF(0),VFR(4),o[1],0,0,0), C0,4); \
    KRD(GL,0); GAPB(o[0]=__builtin_amdgcn_mfma_f32_32x32x16_bf16(PAF(1),VFR(1),o[0],0,0,0), C0,8); \
    KRD(GL,1); GAPB(o[1]=__builtin_amdgcn_mfma_f32_32x32x16_bf16(PAF(1),VFR(5),o[1],0,0,0), C0,12); \
    KRD(GL,2); GAPB(o[0]=__builtin_amdgcn_mfma_f32_32x32x16_bf16(PAF(2),VFR(2),o[0],0,0,0), C1,0); \
    KRD(GL,3); GAPB(o[1]=__builtin_amdgcn_mfma_f32_32x32x16_bf16(PAF(2),VFR(6),o[1],0,0,0), C1,4); \
    GAPB(o[0]=__builtin_amdgcn_mfma_f32_32x32x16_bf16(PAF(3),VFR(3),o[0],0,0,0), C1,8); \
    GAPB(o[1]=__builtin_amdgcn_mfma_f32_32x32x16_bf16(PAF(3),VFR(7),o[1],0,0,0), C1,12); \
    }while(0)
  int t=1;
  for(;t+5<NT;t+=2){
    STEP(pB0,pB1,pA0,pA1,t,true,true,true);     WAIT_BAR(2); RESC(); ROT();
    STEP(pA0,pA1,pB0,pB1,t+1,true,true,true);   WAIT_BAR(2); RESC(); ROT();
  }
  #define ENDW(tt) do{ if((tt)+3<NT){WAIT_BAR(2);} else if((tt)+2<NT){WAIT_BAR(1);} else {WAIT_BAR(0);} }while(0)
  for(;t+1<NT;t+=2){
    STEP(pB0,pB1,pA0,pA1,t,(t+3<NT),(t+1<NT),(t+1<NT));       ENDW(t);   RESC(); ROT();
    STEP(pA0,pA1,pB0,pB1,t+1,(t+4<NT),(t+2<NT),(t+2<NT));     ENDW(t+1); RESC(); ROT();
  }
  STEP(pB0,pB1,pA0,pA1,NT-1,false,false,false); RESC();
  { float sacc=pB0[0]+pB0[1]; _Pragma("unroll") for(int r=2;r<16;++r)sacc+=pB0[r]; _Pragma("unroll") for(int r=0;r<16;++r)sacc+=pB1[r]; l_reg+=sacc;
    pw0=(u32x4){PKW(pB0,0),PKW(pB0,2),PKW(pB0,4),PKW(pB0,6)};pw1=(u32x4){PKW(pB0,8),PKW(pB0,10),PKW(pB0,12),PKW(pB0,14)};pw2=(u32x4){PKW(pB1,0),PKW(pB1,2),PKW(pB1,4),PKW(pB1,6)};pw3=(u32x4){PKW(pB1,8),PKW(pB1,10),PKW(pB1,12),PKW(pB1,14)};
    SBAR(); pv(o,vb0+sl_cur,PAF(0),PAF(1),PAF(2),PAF(3)); }
  #undef PKW
  #undef PAF
  #undef VFR
  #undef PIN
  #undef MX3
  #undef GAPA
  #undef GAPB
  #undef EX
  #undef VRD
  #undef KRD
  #undef STEP
  #undef ENDW
  {auto rr=__builtin_amdgcn_permlane32_swap(__float_as_uint(l_reg),__float_as_uint(l_reg),false,false);l_reg=__uint_as_float(rr[0])+__uint_as_float(rr[1]);}
  if(u.has_sink)l_reg+=__builtin_amdgcn_exp2f(u.sinkl2-mhat);
  if(hi==0)wsf[32+r32]=l_reg;asm volatile("s_waitcnt lgkmcnt(0)":::"memory");
  float rli[16];
  #pragma unroll
  for(int r=0;r<16;++r)rli[r]=__builtin_amdgcn_rcpf(wsf[32+crow(r,hi)]);
  bf16*Ow=MIXb+(long)(u.qrow+wid*QBLK)*OP+u.ocol;
  { bf16*stg=(bf16*)(shm+LDS_OST)+wid*2048;
    #pragma unroll
    for(int r=0;r<16;++r){const int orow=crow(r,hi);
      #pragma unroll
      for(int d0=0;d0<2;++d0)stg[orow*64+d0*32+r32]=__float2bfloat16(o[d0][r]*rli[r]);}
    asm volatile("s_waitcnt lgkmcnt(0)":::"memory");
    #pragma unroll
    for(int i=0;i<4;++i){const int row=i*8+(lane>>3),ch=lane&7; const u32x4 v=*(const u32x4*)(stg+row*64+ch*8); ATTN_STORE16(Ow+(long)row*OP+ch*8,v);} }
  asm volatile("s_waitcnt lgkmcnt(0)\n\ts_barrier":::"memory");
  #undef TROW
  #undef DMA_K
  #undef DMA_V
  #undef CMASK
  #undef START
  #undef RESC
  #undef ROT
}
constexpr int ATTN_LDS_BYTES=LDS_BYTES;
#undef SBAR
#undef WAIT_BAR
}

__device__ __forceinline__ void attention_phase(const Params& P, int l, char* lds, int G, int bx, int wave_s) {
    using namespace attn_body;
    const int vcu = (G % 8 == 0) ? (bx % 8) * (G / 8) + bx / 8 : bx;
    const bf16* PLb = (const bf16*)(P.ws + WS_PL); bf16* MIXb = (bf16*)(P.ws + WS_XN);
    constexpr int NQB = SEQ / 256, NU = NB * 4 * NQB; const int ntot = 2 * NU + (l < NL - 1 ? NB * 8 : 0);
    for (int idx = vcu; idx < ntot; idx += G) {
        AttnDesc d; int type, b, hq, kvh;
        if (idx < 2 * NU) { type = idx >= NU ? 1 : 0; const int u = idx - type * NU; const int bk = u / (2 * NQB), g = (u / NQB) & 1, qb = u % NQB; b = bk >> 1; kvh = bk & 1; hq = kvh * 2 + g;
            d.qrow = b * SB + CTX + qb * 256; d.qpos0 = qb * 256; d.rowA = b * SB;
            if (type == 0) { d.rowB = b * SB + CTX; d.NT = SB / 64; d.masked = 0; d.kpos4 = 0; }
            else { const int lat0 = qb * 256 - 128 < 0 ? 0 : qb * 256 - 128, lat1 = qb * 256 + 384 > SEQ ? SEQ : qb * 256 + 384; d.rowB = b * SB + CTX + lat0; d.NT = 4 + (lat1 - lat0) / 64; d.masked = 1; d.kpos4 = lat0; } }
        else { const int u = idx - 2 * NU; type = u & 1; hq = (u >> 1) & 3; kvh = hq >> 1; b = u >> 3; d.qrow = b * SB; d.qpos0 = 0; d.rowA = b * SB; d.rowB = b * SB; d.NT = 4; d.masked = 0; d.kpos4 = 0; }
        const int cb = type ? PL_D : PL_C;
        d.qcol = cb + hq * 64; d.kcol = cb + 256 + kvh * 64; d.vcol = cb + 384 + kvh * 64; d.ocol = (type ? MIX_D : MIX_C) + hq * 64;
        d.has_sink = type; d.sinkl2 = type ? P.swa_sink[l * 4 + hq] * LOG2E : 0.f;
        { const float* g0 = P.gqa_q_norm; const float* g1 = P.swa_q_norm; asm volatile("" : "+s"(g0), "+s"(g1)); d.qg = (type ? g1 : g0) + l * 64; }
        d.rope = idx < 2 * NU;
        attn_unit<8>(d, PLb, MIXb, lds, wave_s);
    }
}

#define GAS __attribute__((address_space(1)))
#define LAS __attribute__((address_space(3)))
typedef unsigned short bf16;
typedef unsigned v4u __attribute__((ext_vector_type(4)));
typedef float f32x4 __attribute__((ext_vector_type(4)));
typedef short bf16x8 __attribute__((ext_vector_type(8)));
typedef GAS unsigned gu32;
typedef GAS unsigned long long gu64;
#define RLX_AGENT __ATOMIC_RELAXED, __HIP_MEMORY_SCOPE_AGENT
#define LDS_WAIT() asm volatile("s_waitcnt lgkmcnt(0)" ::: "memory")
#define VM_WAIT() asm volatile("s_waitcnt vmcnt(0)" ::: "memory")
__device__ __forceinline__ unsigned long long rt() { return __builtin_amdgcn_s_memrealtime(); }
__device__ __forceinline__ unsigned pk2(float lo, float hi) { return (unsigned)f2bf(lo) | ((unsigned)f2bf(hi) << 16); }

#define XB_TMO      128
#define XB_XCNT(j)  (256  + 64 * (j))
#define XB_XSUB(j)  (1280 + 64 * (j))
#define XB_XGEN(j)  (2304 + 64 * (j))
#define XB_TOP      3328
#define XB_TOPGEN   3392
#define XCD_BAR_WORDS 3456
#define XB_SPIN_CAP (1u << 27)

__device__ __forceinline__ unsigned xb_ld(unsigned* p)              { return __hip_atomic_load(p, __ATOMIC_RELAXED, __HIP_MEMORY_SCOPE_AGENT); }
__device__ __forceinline__ unsigned xb_add(unsigned* p, unsigned v) { return __hip_atomic_fetch_add(p, v, __ATOMIC_RELAXED, __HIP_MEMORY_SCOPE_AGENT); }
__device__ __forceinline__ unsigned xb_xcc_id() { return (unsigned)__builtin_amdgcn_s_getreg((3 << 11) | 20) & 0xFu; }
#define XB_SPIN(cond, bar) do { unsigned _sp = 0; while (cond) { __builtin_amdgcn_s_sleep(1); \
    if ((++_sp & 255u) == 0u) { if (xb_ld(&(bar)[XB_TMO])) break; if (_sp > XB_SPIN_CAP) { atomicAdd(&(bar)[XB_TMO], 1u); break; } } } } while (0)

struct XcdBarrier {
    unsigned* bar; unsigned x;
    volatile LAS unsigned* st;
};

__device__ __forceinline__ XcdBarrier xcd_barrier_post(unsigned* bar, volatile LAS unsigned* st) {
    XcdBarrier b; b.bar = bar; b.x = xb_xcc_id(); b.st = st;
    if (threadIdx.x == 0) (void)xb_add(&bar[XB_XCNT(b.x)], 1u);
    return b;
}
__device__ __forceinline__ void xcd_barrier_complete(unsigned* bar, unsigned x, unsigned& nloc, unsigned& nx) {
    const unsigned G = gridDim.x * gridDim.y * gridDim.z;
    unsigned sum, cnt, mine, sp = 0u;
    for (;;) {
        sum = 0u; cnt = 0u; mine = 0u;
#pragma unroll
        for (unsigned j = 0; j < 16; ++j) { const unsigned c = xb_ld(&bar[XB_XCNT(j)]); sum += c; cnt += (c > 0u) ? 1u : 0u; mine = (j == x) ? c : mine; }
        if (sum == G) break;
        __builtin_amdgcn_s_sleep(1);
        if ((++sp & 255u) == 0u) { if (xb_ld(&bar[XB_TMO])) break; if (sp > XB_SPIN_CAP) { atomicAdd(&bar[XB_TMO], 1u); break; } }
    }
    nloc = mine > 0u ? mine : 1u; nx = cnt > 0u ? cnt : 1u;
}

__device__ __forceinline__ void xcd_barrier(const XcdBarrier& b, int wave_s) {
    asm volatile("s_waitcnt vmcnt(0)" ::: "memory");
    __syncthreads();
    if (tid_from_wave(wave_s) == 0) {
        unsigned* bar = b.bar; unsigned bx = b.x; asm volatile("" : "+s"(bar), "+s"(bx));
        __builtin_amdgcn_s_waitcnt(0);
        unsigned nloc = b.st[0], nx = b.st[1];
        if (nloc == 0u) { xcd_barrier_complete(bar, bx, nloc, nx); b.st[0] = nloc; b.st[1] = nx; }
        const unsigned old = xb_add(&bar[XB_XSUB(bx)], 1u);
        const unsigned gen = old / nloc;
        if (old + 1u == (gen + 1u) * nloc) {
            __builtin_amdgcn_fence(__ATOMIC_RELEASE, "agent");
            asm volatile("s_waitcnt vmcnt(0)" ::: "memory");
            const unsigned og = xb_add(&bar[XB_TOP], 1u);
            const unsigned tg = og / nx;
            if (og + 1u == (tg + 1u) * nx) xb_add(&bar[XB_TOPGEN], 1u);
            else XB_SPIN(xb_ld(&bar[XB_TOPGEN]) == tg, bar);
            __builtin_amdgcn_fence(__ATOMIC_ACQUIRE, "agent");
            xb_add(&bar[XB_XGEN(bx)], 1u);
            asm volatile("s_waitcnt vmcnt(0)" ::: "memory");
        } else {
            XB_SPIN(xb_ld(&bar[XB_XGEN(bx)]) == gen, bar);
            __builtin_amdgcn_fence(__ATOMIC_ACQUIRE, "agent");
            asm volatile("s_waitcnt vmcnt(0)" ::: "memory");
        }
    }
    __syncthreads();
}

__device__ __forceinline__ float frcp(float x) { return __builtin_amdgcn_rcpf(x); }
__device__ __forceinline__ float frsq(float x) { return __builtin_amdgcn_rsqf(x); }
__device__ __forceinline__ float fsqrt(float x) { return __builtin_amdgcn_sqrtf(x); }
__device__ __forceinline__ float shfl_idx_l(float v, int src) { return __int_as_float(__builtin_amdgcn_ds_bpermute(src << 2, __float_as_int(v))); }
__device__ __forceinline__ float shfl_xor_l(float v, int m, int lane) { return shfl_idx_l(v, lane ^ m); }
__device__ __forceinline__ float wave_sum(float v, int lane) {
#pragma unroll
    for (int o = 1; o < 64; o <<= 1) v += shfl_xor_l(v, o, lane);
    return v;
}
__device__ __forceinline__ void transpose_item(const float* W, int ldw, int K, bf16_t* WT, int k0, int ns, int nd, LAS float* scr, int lane) {
    const float* wp_ = W + (size_t)(k0 + (lane >> 5)) * ldw + ns + (lane & 31);
    float wv_[32];
#pragma unroll
    for (int i = 0; i < 32; ++i) { wv_[i] = *wp_; wp_ += 2 * (size_t)ldw; }
#pragma unroll
    for (int i = 0; i < 32; ++i) scr[(2 * i + (lane >> 5)) * 33 + (lane & 31)] = wv_[i];
    LDS_WAIT(); asm volatile("" ::: "memory");
    const int c = lane & 7;
#pragma unroll
    for (int j = 0; j < 4; ++j) { const int n = (lane >> 3) + 8 * j; const LAS float* s = scr + (8 * c) * 33 + n;
        v4u o; o.x = pk2(s[0 * 33], s[1 * 33]); o.y = pk2(s[2 * 33], s[3 * 33]); o.z = pk2(s[4 * 33], s[5 * 33]); o.w = pk2(s[6 * 33], s[7 * 33]);
        *(GAS v4u*)(WT + (size_t)(nd + n) * K + k0 + 8 * c) = o; }
    LDS_WAIT(); asm volatile("" ::: "memory");
}
__device__ __forceinline__ void wconv_phase(const Params& P, int l, int parts, LAS unsigned char* L, int wave, int lane, int gw, int NGW) {
    LAS float* scr = (LAS float*)(L + wave * 16384);
    constexpr int I_IN = (DM / 64) * (NPL / 32), I_OUT = (DM / 64) * (DM / 32), I_F1 = (DM / 64) * (FF / 32), I_F2 = (FF / 64) * (DM / 32);
    if (parts & 1) { for (int r = gw; r < I_IN; r += NGW) { const int nb = r % (NPL / 32), kb = r / (NPL / 32); const int nd = 32 * nb; transpose_item(P.w_in + (size_t)l * DM * 2568, 2568, DM, (bf16_t*)(P.ws + WS_WIN), 64 * kb, nd < 1024 ? nd : nd + 8, nd, scr, lane); }
        for (int i = gw * 64 + lane; i < 256 * DM / 2; i += NGW * 64) { const int j = i / (DM / 2), kx = 2 * (i % (DM / 2));
            ((uint32_t*)(P.ws + WS_WIN))[(size_t)NPL * DM / 2 + i] = j < 8 ? pk2(P.w_in[((size_t)l * DM + kx) * 2568 + 1024 + j], P.w_in[((size_t)l * DM + kx + 1) * 2568 + 1024 + j]) : 0u; } }
    if (parts & 2) for (int r = gw; r < I_OUT; r += NGW) { const int nb = r % (DM / 32), kb = r / (DM / 32); transpose_item(P.w_out + (size_t)l * DM * DM, DM, DM, (bf16_t*)(P.ws + WS_WOUT), 64 * kb, 32 * nb, 32 * nb, scr, lane); }
    if (parts & 4) for (int r = gw; r < I_F1; r += NGW) { const int nb = r % (FF / 32), kb = r / (FF / 32); transpose_item(P.w_ffn1 + (size_t)l * DM * FF, FF, DM, (bf16_t*)(P.ws + WS_WF1), 64 * kb, 32 * nb, 32 * nb, scr, lane); }
    if (parts & 8) for (int r = gw; r < I_F2; r += NGW) { const int nb = r % (DM / 32), kb = r / (DM / 32); transpose_item(P.w_ffn2 + (size_t)l * FF * DM, DM, FF, (bf16_t*)(P.ws + WS_WF2), 64 * kb, 32 * nb, 32 * nb, scr, lane); }
    if (parts & 16) { bf16_t* lwt = (bf16_t*)(P.ws + WS_LWT);
        for (int idx = gw * 64 + lane; idx < 32768; idx += NGW * 64) { const int i = idx & 63, j = (idx >> 6) & 63, kb = (idx >> 12) & 3, dir = idx >> 14; const size_t src = ((((size_t)l * 2 + dir) * 4 + kb) * 64 + i) * 64 + j;
            lwt[(size_t)(((dir * 2 + 0) * 4 + kb) * 64 + j) * 64 + i] = f2bf(P.lru_w_a[src]); lwt[(size_t)(((dir * 2 + 1) * 4 + kb) * 64 + j) * 64 + i] = f2bf(P.lru_w_i[src]); } }
}
__device__ __forceinline__ void norm_phase(const Params& P, int l, int which, int slabs, int fmt, int lane, int gw, int NGW) {
    const float* g = (which == 0 ? P.g_mix : P.g_ffn) + (size_t)l * DM; const float* wdt = (const float*)(P.ws + WS_WDT);
    for (int rb = gw; rb < MT; rb += 2 * NGW) {
        f32x4 v[2][4]; bool act[2]; int rr[2];
#pragma unroll
        for (int h = 0; h < 2; ++h) { const int r = rb + h * NGW; rr[h] = r;
            if (which == 0 && fmt == 1 && r < MT && (r % SB) >= CTX && lane == 0) ((float*)(P.ws + WS_RS2))[r] = 0.f;
            act[h] = r < MT && !(which == 1 && l == NL - 1 && (r % SB) < CTX) && !(fmt == 1 && (r % SB) >= CTX);
            if (act[h]) { const float* xr = (which == 0 || l == 0) ? xin_row(P, l, r) : resid_row(P, r);
#pragma unroll
                for (int j = 0; j < 4; ++j) v[h][j] = *(const f32x4*)(xr + 4 * lane + 256 * j);
                if (slabs && (r % SB) < CTX) {
                    const size_t cro = ((size_t)(r / SB) * CTX + (r % SB)) * DM;
#pragma unroll
                    for (int ks = 0; ks < 4; ++ks)
#pragma unroll
                        for (int j = 0; j < 4; ++j) v[h][j] += *(const f32x4*)((const float*)(P.ws + WS_SLAB) + (size_t)ks * NB * CTX * DM + cro + 4 * lane + 256 * j);
#pragma unroll
                    for (int j = 0; j < 4; ++j) *(f32x4*)((float*)(P.ws + WS_XRC) + cro + 4 * lane + 256 * j) = v[h][j]; } } }
#pragma unroll
        for (int h = 0; h < 2; ++h) if (act[h]) { const int r = rr[h]; const float* md = mod_row(P, l, r); const float* sh = md + (which == 0 ? 0 : 3072); const float* sc = sh + 1024;
            float s = 0.f;
#pragma unroll
            for (int j = 0; j < 4; ++j) s += (v[h][j].x * v[h][j].x + v[h][j].y * v[h][j].y) + (v[h][j].z * v[h][j].z + v[h][j].w * v[h][j].w);
            const float ssum = wave_sum(s, lane); const float rs = fmt == 1 ? 1.f : frsq(ssum * (1.0f / DM) + EPS);
            if (fmt == 1 && lane == 0) ((float*)(P.ws + (which == 0 ? WS_RS1 : WS_RS2)))[r] = ssum;
            float dt[8];
#pragma unroll
            for (int jj = 0; jj < 8; ++jj) dt[jj] = 0.f;
#pragma unroll
            for (int j = 0; j < 4; ++j) { const int idx = 4 * lane + 256 * j; const f32x4 gv = *(const f32x4*)(g + idx), sv = *(const f32x4*)(sc + idx), hv = *(const f32x4*)(sh + idx);
                const f32x4 o = fmt == 1 ? (v[h][j] * gv) * (1.f + sv) : (v[h][j] * rs * gv) * (1.f + sv) + hv;
                *(unsigned long long*)((bf16_t*)(P.ws + (fmt == 1 && which == 1 ? WS_XA2 : WS_XN)) + (size_t)r * DM + idx) = (unsigned long long)pk2(o.x, o.y) | ((unsigned long long)pk2(o.z, o.w) << 32);
                if (which == 0 && fmt != 1) {
#pragma unroll
                    for (int jj = 0; jj < 8; ++jj) { const f32x4 w = *(const f32x4*)(wdt + jj * DM + idx); dt[jj] += (o.x * w.x + o.y * w.y) + (o.z * w.z + o.w * w.w); } } }
            if (which == 0 && fmt != 1) {
#pragma unroll
                for (int jj = 0; jj < 8; ++jj) dt[jj] = wave_sum(dt[jj], lane);
                if (lane == 0) { ((float*)(P.ws + WS_RS2))[r] = 0.f;
                    float* d = (float*)(P.ws + WS_DTP) + (size_t)r * 8;
#pragma unroll
                    for (int jj = 0; jj < 8; ++jj) d[jj] = dt[jj]; } } }
    }
}
__device__ __forceinline__ void norm1_phase(const Params& P, int l, int slabs, LAS unsigned char* L, int tid, int lane, int gw, int NGW) {
    LAS float* scl = (LAS float*)(L + 32768); LAS float* shl = (LAS float*)(L + 32768 + (NB + 1) * DM * 4); LAS float* gl = (LAS float*)(L + 32768 + 2 * (NB + 1) * DM * 4);
    __syncthreads();
    for (int i = tid; i < DM; i += 512) gl[i] = P.g_mix[(size_t)l * DM + i];
    for (int i = tid; i < (NB + 1) * DM; i += 512) { const float* md = (const float*)(P.ws + WS_MOD) + ((size_t)l * (NB + 1) + i / DM) * NMOD + (i % DM); shl[i] = md[0]; scl[i] = md[1024]; }
    __syncthreads();
    f32x4 vn[2][4];
#define N1_LOAD(dst, rb_) do { _Pragma("unroll") for (int h_ = 0; h_ < 2; ++h_) { const int r_ = (rb_) + h_ * NGW; if (r_ < MT) { \
        if (l > 0 && (r_ % SB) >= CTX) { const bf16_t* xb_ = (const bf16_t*)P.out + ((size_t)(r_ / SB) * SEQ + (r_ % SB - CTX)) * DM; \
            _Pragma("unroll") for (int j_ = 0; j_ < 4; ++j_) { const U2 w_ = *(const U2*)(xb_ + 4 * lane + 256 * j_); dst[h_][j_].x = __uint_as_float(w_.x); dst[h_][j_].y = __uint_as_float(w_.y); } } \
        else { const float* xr_ = xin_row(P, l, r_); \
            _Pragma("unroll") for (int j_ = 0; j_ < 4; ++j_) dst[h_][j_] = *(const f32x4*)(xr_ + 4 * lane + 256 * j_); } } } } while (0)
    N1_LOAD(vn, gw);
    for (int rb = gw; rb < MT; rb += 2 * NGW) {
        f32x4 v[2][4];
#pragma unroll
        for (int h = 0; h < 2; ++h)
#pragma unroll
            for (int j = 0; j < 4; ++j) v[h][j] = vn[h][j];
        if (rb + 2 * NGW < MT) N1_LOAD(vn, rb + 2 * NGW);
#pragma unroll
        for (int h = 0; h < 2; ++h) { const int r = rb + h * NGW; if (r < MT) { const int b_ = r / SB, s_ = r % SB; const int bm = s_ < CTX ? NB : b_;
            if (l > 0 && s_ >= CTX) {
#pragma unroll
                for (int j = 0; j < 4; ++j) { const unsigned w0 = __float_as_uint(v[h][j].x), w1 = __float_as_uint(v[h][j].y); v[h][j] = f32x4{__uint_as_float(w0 << 16), __uint_as_float(w0 & 0xffff0000u), __uint_as_float(w1 << 16), __uint_as_float(w1 & 0xffff0000u)}; } }
            if (slabs && s_ < CTX) {
                const size_t cro = ((size_t)b_ * CTX + s_) * DM;
#pragma unroll
                for (int ks = 0; ks < 4; ++ks)
#pragma unroll
                    for (int j = 0; j < 4; ++j) v[h][j] += *(const f32x4*)((const float*)(P.ws + WS_SLAB) + (size_t)ks * NB * CTX * DM + cro + 4 * lane + 256 * j);
#pragma unroll
                for (int j = 0; j < 4; ++j) *(f32x4*)((float*)(P.ws + WS_XRC) + cro + 4 * lane + 256 * j) = v[h][j]; }
            float sq = 0.f;
#pragma unroll
            for (int j = 0; j < 4; ++j) sq += (v[h][j].x * v[h][j].x + v[h][j].y * v[h][j].y) + (v[h][j].z * v[h][j].z + v[h][j].w * v[h][j].w);
            const float rs = frsq(wave_sum(sq, lane) * (1.0f / DM) + EPS);
#pragma unroll
            for (int j = 0; j < 4; ++j) { const int idx = 4 * lane + 256 * j; const f32x4 sv = *(const LAS f32x4*)(scl + bm * DM + idx), hv = *(const LAS f32x4*)(shl + bm * DM + idx);
                const f32x4 o = (v[h][j] * rs * *(const LAS f32x4*)(gl + idx)) * (1.f + sv) + hv;
                *(unsigned long long*)((bf16_t*)(P.ws + WS_XN) + (size_t)r * DM + idx) = (unsigned long long)pk2(o.x, o.y) | ((unsigned long long)pk2(o.z, o.w) << 32);
                __builtin_amdgcn_sched_barrier(0); }
            if (lane == 0) { ((float*)(P.ws + WS_RS2))[r] = 0.f; ((float*)(P.ws + WS_RS1))[r] = 0.f; }
            } }
    }
#undef N1_LOAD
    __syncthreads();
}
__device__ __forceinline__ void qk_phase(const Params& P, int l, int lane, int gw, int NGW, int rA, int rB) {
    const int l16 = lane & 15, ax = l16 >> 3, second = (l16 >> 2) & 1, tk = lane >> 5;
    f32x4 gC, inv;
    { const float* gk0 = P.gqa_k_norm + l * 64 + 4 * l16; const float* gk1 = P.swa_k_norm + l * 64 + 4 * l16; const f32x4 k0 = *(const f32x4*)gk0, k1 = *(const f32x4*)gk1; gC = tk ? k1 : k0;
#pragma unroll
        for (int e = 0; e < 4; ++e) inv[e] = expf(-(float)(4 * (l16 & 3) + e) * (9.210340371976184f / 16.f)) * 0.15915494309189535f; }
    const int offC = (tk ? PL_D : PL_C) + 256 + 4 * (lane & 31);
    constexpr int QR = 4;
    U2 wn[QR];
#define QK_LOAD(dst, rb_) do { _Pragma("unroll") for (int h_ = 0; h_ < QR; ++h_) { const int r_ = (rb_) + h_ * NGW; if (r_ < rB) dst[h_] = *(const U2*)((const bf16_t*)(P.ws + WS_PL) + (size_t)r_ * NPL + offC); } } while (0)
    QK_LOAD(wn, rA + gw);
    for (int rb = rA + gw; rb < rB; rb += QR * NGW) {
        U2 w[QR];
#pragma unroll
        for (int h = 0; h < QR; ++h) w[h] = wn[h];
        if (rb + QR * NGW < rB) QK_LOAD(wn, rb + QR * NGW);
#pragma unroll
        for (int h = 0; h < QR; ++h) { const int r = rb + h * NGW; if (r < rB) { const int s = r % SB; bf16_t* p = (bf16_t*)(P.ws + WS_PL) + (size_t)r * NPL;
            f32x4 cs = {1.f, 1.f, 1.f, 1.f}, sn = {0.f, 0.f, 0.f, 0.f};
            if (s >= CTX) { const int pos = s - CTX; const float pc = (float)(ax ? pos % GRIDW : pos / GRIDW);
#pragma unroll
                for (int e = 0; e < 4; ++e) { const float rev = pc * inv[e]; cs[e] = __builtin_amdgcn_cosf(rev); sn[e] = __builtin_amdgcn_sinf(rev); } }
            if (!second) sn = -sn;
            f32x4 x = {__uint_as_float(w[h].x << 16), __uint_as_float(w[h].x & 0xffff0000u), __uint_as_float(w[h].y << 16), __uint_as_float(w[h].y & 0xffff0000u)};
            float ss = (x.x * x.x + x.y * x.y) + (x.z * x.z + x.w * x.w);
#pragma unroll
            for (int o = 1; o < 16; o <<= 1) ss += shfl_xor_l(ss, o, lane);
            const float rs = frsq(ss * (1.0f / 64) + EPS);
            x = x * rs * gC;
            f32x4 pt; pt.x = shfl_xor_l(x.x, 4, lane); pt.y = shfl_xor_l(x.y, 4, lane); pt.z = shfl_xor_l(x.z, 4, lane); pt.w = shfl_xor_l(x.w, 4, lane);
            x = x * cs + pt * sn;
            U2 o2; o2.x = pk2(x.x, x.y); o2.y = pk2(x.z, x.w);
            *(U2*)(p + offC) = o2; } }
    }
#undef QK_LOAD
}
__device__ __forceinline__ void prep_phase(const Params& P, int l, LAS unsigned char* L, int tid, int vcu, int G) {
    constexpr int TP = 136;
    LAS bf16_t* OT = (LAS bf16_t*)L;
    const int cp = tid & 127, tq = tid >> 7;
    for (int u = vcu; u < NB * NCH * 3; u += G) {
        const int bc = u / 3, part = (u % 3) == 2 ? 3 : (u % 3); const int b = bc / NCH, c = bc % NCH; const int s0 = c * CHK; const int lo = s0 < CTX ? 0 : CTX, hi = s0 < CTX ? CTX : SB;
        const bf16_t* pl = (const bf16_t*)(P.ws + WS_PL) + (size_t)b * SB * NPL + (part < 3 ? PL_XBC + 256 * part : part == 3 ? PL_LX : PL_Z) + 2 * cp;
        float w0[4], w1[4], b0 = 0.f, b1 = 0.f;
#pragma unroll
        for (int t = 0; t < 4; ++t) { w0[t] = 0.f; w1[t] = 0.f; }
        if (part < 3) { const int ch = 256 * part + 2 * cp;
#pragma unroll
            for (int t = 0; t < 4; ++t) { w0[t] = P.ssd_conv_w[(l * 4 + t) * 768 + ch]; w1[t] = P.ssd_conv_w[(l * 4 + t) * 768 + ch + 1]; }
            b0 = P.ssd_conv_b[l * 768 + ch]; b1 = P.ssd_conv_b[l * 768 + ch + 1]; }
        else if (part == 3) {
#pragma unroll
            for (int t = 0; t < 4; ++t) { w0[t] = P.lru_conv_w[(l * 4 + t) * 256 + 2 * cp]; w1[t] = P.lru_conv_w[(l * 4 + t) * 256 + 2 * cp + 1]; }
            b0 = P.lru_conv_b[l * 256 + 2 * cp]; b1 = P.lru_conv_b[l * 256 + 2 * cp + 1]; }
        else { w0[2] = 1.f; w1[2] = 1.f; }
        const int sA = s0 + 32 * tq;
        auto ldrow = [&](int ss) -> unsigned { return (ss >= lo && ss < hi) ? *(const unsigned*)(pl + (size_t)ss * NPL) : 0u; };
        unsigned xr[35];
#pragma unroll
        for (int i = 0; i < 35; ++i) xr[i] = ldrow(sA - 2 + i);
        const bool tr = (part == 0 || part == 1 || part == 4);
#pragma unroll
        for (int i = 0; i < 32; ++i) { const int ss = sA + i; const unsigned xm2 = xr[i], xm1 = xr[i + 1], x0 = xr[i + 2], xp1 = xr[i + 3];
            float a0 = b0 + w0[0] * bflo(xm2) + w0[1] * bflo(xm1) + w0[2] * bflo(x0) + w0[3] * bflo(xp1);
            float a1 = b1 + w1[0] * bfhi(xm2) + w1[1] * bfhi(xm1) + w1[2] * bfhi(x0) + w1[3] * bfhi(xp1);
            if (part < 3) { a0 = a0 * frcp(1.f + __expf(-a0)); a1 = a1 * frcp(1.f + __expf(-a1)); }
            const unsigned o = part == 4 ? x0 : pk2(a0, a1); const size_t r = (size_t)b * SB + ss;
            if (part == 1 || part == 2) *(unsigned*)((bf16_t*)(P.ws + WS_XBC) + r * XBP + 256 * (part - 1) + 2 * cp) = o;
            else if (part == 3) *(unsigned*)((bf16_t*)(P.ws + WS_XLC) + r * 256 + 2 * cp) = o;
            if (tr) { OT[(2 * cp) * TP + 32 * tq + i] = (bf16_t)(o & 0xffffu); OT[(2 * cp + 1) * TP + 32 * tq + i] = (bf16_t)(o >> 16); } }
        if (tr) { __syncthreads();
            bf16_t* dst = (bf16_t*)(P.ws + (part == 0 ? WS_XT : part == 1 ? WS_BT : WS_ZT)) + (size_t)bc * 256 * CHK;
#pragma unroll
            for (int k = 0; k < 8; ++k) { const int piece = tid + 512 * k; const int ch = piece >> 4, q = piece & 15; *(GAS v4u*)(dst + (size_t)ch * CHK + 8 * q) = *(const LAS v4u*)(OT + ch * TP + 8 * q); }
            __syncthreads(); }
    }
}

namespace ssdk {
typedef short bf16x8 __attribute__((ext_vector_type(8)));
typedef float f32x16 __attribute__((ext_vector_type(16)));
typedef float f32x2_t __attribute__((ext_vector_type(2))); typedef __bf16 bf16x2_t __attribute__((ext_vector_type(2)));
typedef unsigned u32x2 __attribute__((ext_vector_type(2)));
__device__ __forceinline__ unsigned cvtpk(float lo, float hi) { f32x2_t v = {lo, hi}; bf16x2_t b = __builtin_convertvector(v, bf16x2_t); return __builtin_bit_cast(unsigned, b); }
#define SSD_MFMA(a, b, c) __builtin_amdgcn_mfma_f32_32x32x16_bf16(a, b, c, 0, 0, 0)
__device__ __forceinline__ int drow(int q, int hh) { return (q & 3) + 8 * (q >> 2) + 4 * hh; }

__device__ __forceinline__ void ssd_state_item(const Params& P, int l, LAS unsigned char* L, int tid, int bc, int hd, int dir) {
    const int lane = tid & 63, wid = __builtin_amdgcn_readfirstlane(tid >> 6), r32 = lane & 31, hh = lane >> 5;
    LAS float* wl = (LAS float*)(L + wid * 512);
    float* sc4w = (float*)(P.ws + WS_SC4); const float* dtp = (const float*)(P.ws + WS_DTP);
    const float a2 = -expf(P.ssd_a_log[(l * 2 + dir) * 4 + hd]) * LOG2E, dtb = P.ssd_dt_bias[(l * 2 + dir) * 4 + hd];
    {
        const size_t r0 = (size_t)bc * CHK;
        const bf16_t* xt = (const bf16_t*)(P.ws + WS_XT) + ((size_t)bc * 256 + hd * 64 + r32) * CHK + 8 * hh;
        const bf16_t* bt = (const bf16_t*)(P.ws + WS_BT) + ((size_t)bc * 256 + (hd >> 1) * 128 + r32) * CHK + 8 * hh;
        v4u xq[8][2]; bf16x8 bq[8][2];
        float dtv[2], cum[2]; int tk[2]; float carry = 0.f;
#pragma unroll
        for (int jj = 0; jj < 2; ++jj) { const int idx = lane + 64 * jj; tk[jj] = dir ? CHK - 1 - idx : idx; dtv[jj] = dtp[(r0 + tk[jj]) * 8 + dir * 4 + hd]; }
#pragma unroll
        for (int s = 0; s < 8; ++s) {
#pragma unroll
            for (int pt = 0; pt < 2; ++pt) xq[s][pt] = *(const GAS v4u*)(xt + (size_t)pt * 32 * CHK + 16 * s);
#pragma unroll
            for (int nt = 0; nt < 2; ++nt) bq[s][nt] = *(const GAS bf16x8*)(bt + (size_t)nt * 32 * CHK + 16 * s); }
#pragma unroll
        for (int jj = 0; jj < 2; ++jj) { dtv[jj] = softplus_f(dtv[jj] + dtb); float v = dtv[jj] * a2;
#pragma unroll
            for (int o = 1; o < 64; o <<= 1) { const float t = shfl_idx_l(v, (lane - o) & 63); if (lane >= o) v += t; }
            cum[jj] = v + carry; carry = shfl_idx_l(cum[jj], 63); }
        const float aend = carry;
#pragma unroll
        for (int jj = 0; jj < 2; ++jj) { float* so4 = sc4w + ((r0 + tk[jj]) * 4 + hd) * 4 + dir * 2; so4[0] = cum[jj]; so4[1] = dtv[jj]; wl[tk[jj]] = __builtin_amdgcn_exp2f(aend - cum[jj]) * dtv[jj]; }
        if (lane == 0) ((float*)(P.ws + WS_DEC))[((size_t)bc * 4 + hd) * 2 + dir] = __builtin_amdgcn_exp2f(aend);
        LDS_WAIT(); asm volatile("" ::: "memory");
        bf16_t* so = (bf16_t*)(P.ws + WS_SST) + (((size_t)bc * 4 + hd) * 2 + dir) * 8192 + (size_t)r32 * 128 + 4 * hh;
#pragma unroll
        for (int pass = 0; pass < 2; ++pass) {
            f32x16 acc[2][2];
#pragma unroll
            for (int a = 0; a < 2; ++a)
#pragma unroll
                for (int b = 0; b < 2; ++b) acc[a][b] = f32x16{};
#pragma unroll
            for (int s = 0; s < 8; ++s) {
                if (pass == 0) { const f32x4 w0 = *(const LAS f32x4*)(wl + 16 * s + 8 * hh), w1 = *(const LAS f32x4*)(wl + 16 * s + 8 * hh + 4);
#pragma unroll
                    for (int pt = 0; pt < 2; ++pt) { const v4u raw = xq[s][pt];
                        v4u o; o.x = cvtpk(bflo(raw.x) * w0.x, bfhi(raw.x) * w0.y); o.y = cvtpk(bflo(raw.y) * w0.z, bfhi(raw.y) * w0.w); o.z = cvtpk(bflo(raw.z) * w1.x, bfhi(raw.z) * w1.y); o.w = cvtpk(bflo(raw.w) * w1.z, bfhi(raw.w) * w1.w);
                        xq[s][pt] = o; } }
#pragma unroll
                for (int pt = 0; pt < 2; ++pt)
#pragma unroll
                    for (int nt = 0; nt < 2; ++nt) acc[pt][nt] = SSD_MFMA(bq[s][nt], __builtin_bit_cast(bf16x8, xq[s][pt]), acc[pt][nt]);
                __builtin_amdgcn_sched_barrier(0);
                if (pass == 0) {
#pragma unroll
                    for (int nt = 0; nt < 2; ++nt) bq[s][nt] = *(const GAS bf16x8*)(bt + (size_t)(2 + nt) * 32 * CHK + 16 * s); }
                __builtin_amdgcn_sched_barrier(0);
            }
#pragma unroll
            for (int pt = 0; pt < 2; ++pt)
#pragma unroll
                for (int nt = 0; nt < 2; ++nt)
#pragma unroll
                    for (int gq = 0; gq < 4; ++gq) { U2 w; w.x = cvtpk(acc[pt][nt][4 * gq], acc[pt][nt][4 * gq + 1]); w.y = cvtpk(acc[pt][nt][4 * gq + 2], acc[pt][nt][4 * gq + 3]);
                        *(U2*)(so + (size_t)(32 * pt) * 128 + 64 * pass + 32 * nt + 8 * gq) = w; }
        }
        LDS_WAIT(); asm volatile("" ::: "memory");
    }
}
template <int ABL = 0> __device__ __forceinline__ void ssd_out_phase(const Params& P, int l, LAS unsigned char* L, int wave_s, int vcu, int nssd) {
    const int wid = wave_s; const int hd = wid & 3, hb = wid >> 2, g = hd >> 1;
    LAS f32x4* sc = (LAS f32x4*)(L + hb * 8192);
    LAS float* SS = (LAS float*)(L + 16384 + hb * 512);
    constexpr int OP_ = 72;
    LAS bf16_t* OST = (LAS bf16_t*)(L + 32768 + wid * (32 * OP_ * 2));
    constexpr int CTP = 264;
    LAS bf16_t* CT = (LAS bf16_t*)(L + 73728 + hb * (32 * CTP * 2));
    const float dsk = P.ssd_d[l * 4 + hd];
    const float* sc4 = (const float*)(P.ws + WS_SC4); const bf16_t* xbc = (const bf16_t*)(P.ws + WS_XBC);
    const int nlat = l == NL - 1;
    const int ntile = nlat ? NB * (NCH - NCC) * 4 : NB * NCH * 4;
    const int extra = ntile - 2 * nssd; const bool paired = extra > 0 && (extra & 1) == 0 && (extra >> 1) <= nssd && 4 * (extra >> 1) + 2 * (nssd - (extra >> 1)) == ntile; const int nd = extra >> 1;
    const int ntl = vcu >= nssd ? 0 : (paired ? (vcu < nd ? 2 : 1) : (ntile - (2 * vcu + hb) + 2 * nssd - 1) / (2 * nssd));
    for (int it = 0; it < ntl; ++it) {
        int cq, ti;
        if (paired) { if (vcu < nd) { cq = vcu; ti = 2 * hb + it; } else { const int Tr = 2 * (vcu - nd) + hb; cq = nd + (Tr >> 2); ti = Tr & 3; } }
        else { const int T = 2 * vcu + hb + it * 2 * nssd; cq = T >> 2; ti = T & 3; }
        const int bc = nlat ? cq + NCC * (cq / (NCH - NCC) + 1) : cq; const size_t r0 = (size_t)bc * CHK;
        const int tid = tid_from_wave(wave_s); const int lane = tid & 63, r32 = lane & 31, hh = lane >> 5, th = tid & 255;
        __syncthreads();
#pragma unroll
        for (int k2 = 0; k2 < 2; ++k2) { const int e = th + 256 * k2; sc[(e & 3) * 128 + (e >> 2)] = *(const GAS f32x4*)(sc4 + ((r0 + (e >> 2)) * 4 + (e & 3)) * 4); }
#pragma unroll
        for (int k4 = 0; k4 < 0; ++k4) {}
        {
            const int cg = (th & 31) * 8; const int b_ = bc / NCH, c_ = bc % NCH; const int s0 = c_ * CHK; const int lo = s0 < CTX ? 0 : CTX, hi = s0 < CTX ? CTX : SB;
            const bf16_t* plc = (const bf16_t*)(P.ws + WS_PL) + (size_t)b_ * SB * NPL + PL_XBC + 512 + cg;
            v4u raw[4][4];
#pragma unroll
            for (int k4 = 0; k4 < 4; ++k4)
#pragma unroll
                for (int t = 0; t < 4; ++t) { const int ss = s0 + 32 * ti + (th >> 5) + 8 * k4 + t - 2; raw[k4][t] = (ss >= lo && ss < hi) ? *(const GAS v4u*)(plc + (size_t)ss * NPL) : v4u{0u, 0u, 0u, 0u}; }
            f32x4 wt[4][2], bb[2];
#pragma unroll
            for (int t = 0; t < 4; ++t) { wt[t][0] = *(const f32x4*)(P.ssd_conv_w + (l * 4 + t) * 768 + 512 + cg); wt[t][1] = *(const f32x4*)(P.ssd_conv_w + (l * 4 + t) * 768 + 512 + cg + 4); }
            bb[0] = *(const f32x4*)(P.ssd_conv_b + l * 768 + 512 + cg); bb[1] = *(const f32x4*)(P.ssd_conv_b + l * 768 + 512 + cg + 4);
#pragma unroll
            for (int k4 = 0; k4 < 4; ++k4) { f32x4 a0 = bb[0], a1 = bb[1];
#pragma unroll
                for (int t = 0; t < 4; ++t) { const v4u r_ = raw[k4][t];
                    a0 += wt[t][0] * f32x4{bflo(r_.x), bfhi(r_.x), bflo(r_.y), bfhi(r_.y)}; a1 += wt[t][1] * f32x4{bflo(r_.z), bfhi(r_.z), bflo(r_.w), bfhi(r_.w)}; }
                v4u o;
#pragma unroll
                for (int e = 0; e < 4; ++e) { a0[e] = a0[e] * frcp(1.f + __expf(-a0[e])); a1[e] = a1[e] * frcp(1.f + __expf(-a1[e])); }
                o.x = pk2(a0[0], a0[1]); o.y = pk2(a0[2], a0[3]); o.z = pk2(a1[0], a1[1]); o.w = pk2(a1[2], a1[3]);
                *(LAS v4u*)(CT + ((th >> 5) + 8 * k4) * CTP + cg) = o; } }
        __syncthreads();
        f32x16 val[2];
        {
            {
            const int il = 32 * ti + r32; const f32x4 sci = sc[hd * 128 + il]; const float acf = sci.x, acb = sci.z;
            const LAS bf16_t* cfp = CT + r32 * CTP + g * 128 + 8 * hh;
            const bf16_t* xt = (const bf16_t*)(P.ws + WS_XT) + ((size_t)bc * 256 + hd * 64 + r32) * CHK + 4 * hh;
            const bf16_t* bp0 = xbc + (r0 + r32) * XBP + g * 128 + 8 * hh;
#define SSD_CF(s_) (*(const LAS bf16x8*)(cfp + 16 * (s_)))
            bf16x8 bcur[8];
#pragma unroll
            for (int s = 0; s < 8; ++s) bcur[s] = *(const GAS bf16x8*)(bp0 + 16 * s);
            f32x16 yt[2]; yt[0] = f32x16{}; yt[1] = f32x16{};
            if (!(ABL & 1)) { bf16x8 hf[2][2][4]; f32x16 tt[2];
#define HF_LOAD(buf_, g_) do { const bf16_t* hs_ = (const bf16_t*)(P.ws + WS_SST) + ((((size_t)bc * 4 + hd) * 2 + ((g_) >> 1)) * 64 + r32) * 128 + 8 * hh; \
                _Pragma("unroll") for (int s_ = 0; s_ < 4; ++s_) _Pragma("unroll") for (int pt_ = 0; pt_ < 2; ++pt_) hf[buf_][pt_][s_] = *(const GAS bf16x8*)(hs_ + (size_t)pt_ * 32 * 128 + 16 * (4 * ((g_) & 1) + s_)); } while (0)
                HF_LOAD(0, 0); HF_LOAD(1, 1);
#pragma unroll
                for (int g4 = 0; g4 < 4; ++g4) { const int dir = g4 >> 1, sh = g4 & 1;
                    if (sh == 0) { tt[0] = f32x16{}; tt[1] = f32x16{}; }
#pragma unroll
                    for (int s = 0; s < 4; ++s)
#pragma unroll
                        for (int pt = 0; pt < 2; ++pt) tt[pt] = SSD_MFMA(hf[g4 & 1][pt][s], SSD_CF(4 * sh + s), tt[pt]);
                    __builtin_amdgcn_sched_barrier(0);
                    if (g4 + 2 < 4) HF_LOAD(g4 & 1, g4 + 2);
                    if (sh == 1) { const float e = __builtin_amdgcn_exp2f(dir ? acb : acf); yt[0] += tt[0] * e; yt[1] += tt[1] * e; }
                    __builtin_amdgcn_sched_barrier(0); }
#undef HF_LOAD
            }
#pragma unroll
            for (int jt = 0; jt < ((ABL & 2) ? 0 : 4); ++jt) {
                bf16x8 bnxt[8]; u32x2 xcur[8];
#pragma unroll
                for (int e = 0; e < 8; ++e) xcur[e] = *(const GAS u32x2*)(xt + (size_t)(e >> 2) * 32 * CHK + 32 * jt + 16 * ((e >> 1) & 1) + 8 * (e & 1));
                if (jt < 3) {
#pragma unroll
                    for (int s = 0; s < 8; ++s) bnxt[s] = *(const GAS bf16x8*)(bp0 + (size_t)(32 * (jt + 1)) * XBP + 16 * s); }
                f32x16 gt = f32x16{};
#pragma unroll
                for (int s = 0; s < 8; ++s) gt = SSD_MFMA(bcur[s], SSD_CF(s), gt);
#pragma unroll
                for (int q4 = 0; q4 < 4; ++q4) {
#pragma unroll
                    for (int e = 0; e < 4; ++e) { const int q = 4 * q4 + e; const int j = 32 * jt + drow(q, hh); const f32x4 sj = sc[hd * 128 + j];
                        const float af_ = j <= il ? acf - sj.x : -INFINITY, ab_ = j >= il ? acb - sj.z : -INFINITY;
                        gt[q] *= __builtin_amdgcn_exp2f(af_) * sj.y + __builtin_amdgcn_exp2f(ab_) * sj.w; }
                    __builtin_amdgcn_sched_barrier(0); }
#pragma unroll
                for (int sp = 0; sp < 2; ++sp) { v4u o; o.x = cvtpk(gt[8 * sp + 0], gt[8 * sp + 1]); o.y = cvtpk(gt[8 * sp + 2], gt[8 * sp + 3]); o.z = cvtpk(gt[8 * sp + 4], gt[8 * sp + 5]); o.w = cvtpk(gt[8 * sp + 6], gt[8 * sp + 7]);
                    const bf16x8 wt = __builtin_bit_cast(bf16x8, o);
#pragma unroll
                    for (int pt = 0; pt < 2; ++pt) { const v4u a4 = {xcur[pt * 4 + sp * 2].x, xcur[pt * 4 + sp * 2].y, xcur[pt * 4 + sp * 2 + 1].x, xcur[pt * 4 + sp * 2 + 1].y}; yt[pt] = SSD_MFMA(__builtin_bit_cast(bf16x8, a4), wt, yt[pt]); } }
                __builtin_amdgcn_sched_barrier(0);
                if (jt < 3) {
#pragma unroll
                    for (int s = 0; s < 8; ++s) bcur[s] = bnxt[s]; }
            }
            float ss = 0.f; const bf16_t* xg = (const bf16_t*)(P.ws + WS_XT) + ((size_t)bc * 256 + hd * 64) * CHK + il;
            const bf16_t* zp = (const bf16_t*)(P.ws + WS_PL) + (r0 + il) * NPL + PL_Z + hd * 64 + 4 * hh;
            U2 zq[2][4];
#pragma unroll
            for (int pt = 0; pt < 2; ++pt)
#pragma unroll
                for (int g4 = 0; g4 < 4; ++g4) zq[pt][g4] = *(const U2*)(zp + 32 * pt + 8 * g4);
#pragma unroll
            for (int pt = 0; pt < 2; ++pt)
#pragma unroll
                for (int q = 0; q < 16; ++q) { const int p = 32 * pt + drow(q, hh); const uint32_t zw = (q & 2) ? zq[pt][q >> 2].y : zq[pt][q >> 2].x;
                    const float xv = (ABL & 4) ? 1.f : bf2f(xg[(size_t)p * CHK]), zv = (ABL & 4) ? 1.f : ((q & 1) ? bfhi(zw) : bflo(zw));
                    const float v = (yt[pt][q] + dsk * xv) * (zv * frcp(1.f + __expf(-zv))); val[pt][q] = v; ss += v * v; }
            ss += shfl_xor_l(ss, 32, lane);
            if (hh == 0) SS[hd * 32 + r32] = ss;
            __syncthreads();
            }
            {
            const int tid = tid_from_wave(wave_s); const int lane = tid & 63, r32 = lane & 31, hh = lane >> 5;
            const float tot = (SS[r32] + SS[32 + r32]) + (SS[64 + r32] + SS[96 + r32]); const float rs = frsq(tot * (1.0f / 256) + EPS);
#pragma unroll
            for (int pt = 0; pt < 2; ++pt)
#pragma unroll
                for (int q4 = 0; q4 < 4; ++q4) { const int p0 = 32 * pt + 8 * q4 + 4 * hh; const f32x4 gn = *(const f32x4*)(P.ssd_norm_g + l * 256 + hd * 64 + p0);
                    u32x2 o; o.x = cvtpk(val[pt][4 * q4 + 0] * rs * gn.x, val[pt][4 * q4 + 1] * rs * gn.y); o.y = cvtpk(val[pt][4 * q4 + 2] * rs * gn.z, val[pt][4 * q4 + 3] * rs * gn.w);
                    *(LAS u32x2*)(OST + r32 * OP_ + p0) = o; }
            LDS_WAIT(); asm volatile("" ::: "memory");
            bf16_t* mixo = (bf16_t*)(P.ws + WS_XN) + (r0 + 32 * ti) * DM + MIX_A + hd * 64;
#pragma unroll
            for (int k = 0; k < 4; ++k) { const int piece = lane + 64 * k; const int tok = piece >> 3, q8 = piece & 7; *(GAS v4u*)(mixo + (size_t)tok * DM + q8 * 8) = *(const LAS v4u*)(OST + tok * OP_ + q8 * 8); }
            LDS_WAIT(); asm volatile("" ::: "memory");
            }
            __syncthreads();
        }
    }
}
}

namespace lruk {
using ssdk::bf16x8; using ssdk::f32x16; using ssdk::drow;
__device__ __forceinline__ void lru_gate_half(const Params& P, int l, int tid, int bc, int k, int dir, int ct) {
    const int lane = tid & 63, r32 = lane & 31, hh = lane >> 5;
    const bf16_t* lwt = (const bf16_t*)(P.ws + WS_LWT); const bf16_t* xlc = (const bf16_t*)(P.ws + WS_XLC); uint32_t* lab = (uint32_t*)(P.ws + WS_LAB);
    const int ch = k * 64 + 32 * ct + r32;
    const float ba = -LOG2E * P.lru_b_a[(l * 2 + dir) * 256 + ch], bi = -LOG2E * P.lru_b_i[(l * 2 + dir) * 256 + ch], c8 = -8.0f * LOG2E * softplus_f(-P.lru_lambda[(l * 2 + dir) * 256 + ch]);
    bf16x8 bw[2][4];
#pragma unroll
    for (int gate = 0; gate < 2; ++gate)
#pragma unroll
        for (int s = 0; s < 4; ++s) bw[gate][s] = *(const GAS bf16x8*)(lwt + ((size_t)(((dir * 2 + gate) * 4 + k) * 64 + 32 * ct + r32)) * 64 + 16 * s + 8 * hh);
    {
        const size_t r0 = (size_t)bc * CHK; float hrun = 0.f, cprun = 1.f;
        bf16x8 ax[4], axn[4]; uint32_t xq[16], xqn[16];
#define LRU_LOADA(AX, rt_) do { _Pragma("unroll") for (int s_ = 0; s_ < 4; ++s_) AX[s_] = *(const GAS bf16x8*)(xlc + (r0 + 32 * (rt_) + r32) * 256 + k * 64 + 16 * s_ + 8 * hh); } while (0)
#define LRU_LOADX(XQ, rt_) do { _Pragma("unroll") for (int q_ = 0; q_ < 16; ++q_) XQ[q_] = xlc[(r0 + 32 * (rt_) + 8 * (q_ >> 2) + 4 * hh + (q_ & 3)) * 256 + ch]; } while (0)
        LRU_LOADA(ax, dir ? 3 : 0); LRU_LOADX(xq, dir ? 3 : 0);
#pragma unroll
        for (int s = 0; s < 4; ++s) asm volatile("" : "+v"(ax[s]));
#pragma unroll
        for (int q = 0; q < 16; ++q) asm volatile("" : "+v"(xq[q]));
#pragma unroll 1
        for (int kk = 0; kk < 4; ++kk) { const int rt = dir ? 3 - kk : kk;
            f32x16 acc[2];
#pragma unroll
            for (int gate = 0; gate < 2; ++gate) { acc[gate] = f32x16{};
#pragma unroll
                for (int s = 0; s < 4; ++s) acc[gate] = SSD_MFMA(ax[s], bw[gate][s], acc[gate]); }
            if (kk < 3) { LRU_LOADA(axn, dir ? 2 - kk : kk + 1); LRU_LOADX(xqn, dir ? 2 - kk : kk + 1); }
            { float Ag[4], Bg[4];
#pragma unroll
                for (int m = 0; m < 4; ++m) { float a_[4], b_[4]; uint32_t* lrow = lab + ((size_t)dir * MT + r0 + 32 * rt + 8 * m + 4 * hh) * 256 + ch;
#pragma unroll
                    for (int e = 0; e < 4; ++e) { const int q = 4 * m + e;
                        const float sa = frcp(1.f + __builtin_amdgcn_exp2f(__builtin_fmaf(acc[0][q], -LOG2E, ba))), si = frcp(1.f + __builtin_amdgcn_exp2f(__builtin_fmaf(acc[1][q], -LOG2E, bi)));
                        const float la2 = c8 * sa, av = __builtin_amdgcn_exp2f(la2);
                        const float bb = fsqrt(__builtin_fmaxf(__builtin_fmaf(-av, av, 1.f), 0.f)) * (si * __uint_as_float(xq[q] << 16));
                        lrow[e * 256] = ssdk::cvtpk(la2, bb);
                        a_[e] = av; b_[e] = bb; }
                    Ag[m] = (a_[0] * a_[1]) * (a_[2] * a_[3]);
                    Bg[m] = dir ? ((b_[3] * a_[2] + b_[2]) * a_[1] + b_[1]) * a_[0] + b_[0] : ((b_[0] * a_[1] + b_[1]) * a_[2] + b_[2]) * a_[3] + b_[3]; }
                if (dir) { float t_; t_ = Ag[0]; Ag[0] = Ag[3]; Ag[3] = t_; t_ = Ag[1]; Ag[1] = Ag[2]; Ag[2] = t_; t_ = Bg[0]; Bg[0] = Bg[3]; Bg[3] = t_; t_ = Bg[1]; Bg[1] = Bg[2]; Bg[2] = t_; }
#pragma unroll
                for (int gs = 0; gs < 8; ++gs) { const int m = gs >> 1; const bool own = ((gs & 1) ^ dir) == hh;
                    const float Ap = shfl_xor_l(Ag[m], 32, lane), Bp = shfl_xor_l(Bg[m], 32, lane); const float A = own ? Ag[m] : Ap, B = own ? Bg[m] : Bp;
                    hrun = A * hrun + B; cprun *= A; } }
            if (kk < 3) {
#pragma unroll
                for (int s = 0; s < 4; ++s) ax[s] = axn[s];
#pragma unroll
                for (int q = 0; q < 16; ++q) xq[q] = xqn[q]; }
        }
#undef LRU_LOADA
#undef LRU_LOADX
        if (hh == 0) { const size_t idx = ((size_t)bc * 2 + dir) * 256 + ch; ((float*)(P.ws + WS_LHE))[idx] = hrun; ((float*)(P.ws + WS_LCP))[idx] = cprun; }
    }
}
__device__ __forceinline__ void lru_final_phase(const Params& P, LAS unsigned char* L, int tid, int u0, int ustep, int skip_ctx) {
    LAS bf16_t* HL = (LAS bf16_t*)L; const int ch = tid & 255, dir = tid >> 8;
    for (int bc = u0; bc < NB * NCH; bc += ustep) {
        if (skip_ctx && (bc % NCH) < NCC) continue;
        const size_t r0 = (size_t)bc * CHK; const uint32_t* lab = (const uint32_t*)(P.ws + WS_LAB) + ((size_t)dir * MT + r0) * 256 + ch;
        float h = ((const float*)(P.ws + WS_LCI))[((size_t)bc * 2 + dir) * 256 + ch];
        __syncthreads();
#pragma unroll 1
        for (int ib = 0; ib < CHK; ib += 32) { uint32_t wv[32];
#pragma unroll
            for (int k = 0; k < 32; ++k) wv[k] = lab[(size_t)(dir ? CHK - 1 - (ib + k) : ib + k) * 256];
#pragma unroll
            for (int k = 0; k < 32; ++k) { const int tok = dir ? CHK - 1 - (ib + k) : ib + k; h = __builtin_amdgcn_exp2f(bflo(wv[k])) * h + bfhi(wv[k]); HL[(dir * CHK + tok) * 256 + ch] = (bf16_t)ssdk::cvtpk(h, h); } }
        __syncthreads();
#pragma unroll
        for (int kq = 0; kq < 8; ++kq) { const int piece = tid + 512 * kq; const int tok = piece >> 5, q = piece & 31;
            const v4u hf = *(const LAS v4u*)(HL + tok * 256 + 8 * q), hb = *(const LAS v4u*)(HL + (CHK + tok) * 256 + 8 * q);
            const v4u gv = *(const GAS v4u*)((const bf16_t*)(P.ws + WS_PL) + (r0 + tok) * NPL + PL_LG + 8 * q);
            v4u o; const unsigned hfw[4] = {hf.x, hf.y, hf.z, hf.w}, hbw[4] = {hb.x, hb.y, hb.z, hb.w}, gw_[4] = {gv.x, gv.y, gv.z, gv.w}; unsigned ow[4];
#pragma unroll
            for (int e = 0; e < 4; ++e) { const float g0 = bflo(gw_[e]), g1 = bfhi(gw_[e]);
                const float t0 = 0.7978845608028654f * (g0 + 0.044715f * g0 * g0 * g0), t1 = 0.7978845608028654f * (g1 + 0.044715f * g1 * g1 * g1);
                const float ge0 = g0 * frcp(1.f + __expf(-2.f * t0)), ge1 = g1 * frcp(1.f + __expf(-2.f * t1));
                ow[e] = pk2((bflo(hfw[e]) + bflo(hbw[e])) * ge0, (bfhi(hfw[e]) + bfhi(hbw[e])) * ge1); }
            o.x = ow[0]; o.y = ow[1]; o.z = ow[2]; o.w = ow[3];
            *(GAS v4u*)((bf16_t*)(P.ws + WS_XN) + (r0 + tok) * DM + MIX_B + 8 * q) = o; }
    }
}
}
__device__ __forceinline__ void bias_phase(const Params& P, LAS unsigned char* L, int tid, int vcu, int G) {
    LAS float* SH = (LAS float*)L; LAS float* RED = (LAS float*)(L + 32768); const int lane = tid & 63, wid = tid >> 6;
    for (int u = vcu; u < NL * (FF / 64); u += G) { const int l = u / (FF / 64), n0 = (u % (FF / 64)) * 64;
        __syncthreads();
        for (int i = tid; i < (NB + 1) * DM; i += 512) SH[i] = ((const float*)(P.ws + WS_MOD))[((size_t)l * (NB + 1) + i / DM) * NMOD + 3072 + (i % DM)];
        __syncthreads();
        float acc[NB + 1];
#pragma unroll
        for (int r = 0; r <= NB; ++r) acc[r] = 0.f;
        const float* wp = P.w_ffn1 + ((size_t)l * DM + 128 * wid) * FF + n0 + lane;
#pragma unroll 1
        for (int kb = 0; kb < 128; kb += 32) { float wv[32];
#pragma unroll
            for (int kx = 0; kx < 32; ++kx) wv[kx] = wp[(size_t)(kb + kx) * FF];
#pragma unroll
            for (int kx = 0; kx < 32; ++kx)
#pragma unroll
                for (int r = 0; r <= NB; ++r) acc[r] += SH[r * DM + 128 * wid + kb + kx] * wv[kx]; }
#pragma unroll
        for (int r = 0; r <= NB; ++r) RED[(wid * (NB + 1) + r) * 64 + lane] = acc[r];
        __syncthreads();
        if (tid < (NB + 1) * 64) { const int r = tid >> 6; float sv = 0.f;
#pragma unroll
            for (int w = 0; w < 8; ++w) sv += RED[(w * (NB + 1) + r) * 64 + lane];
            ((float*)(P.ws + WS_BF1))[((size_t)l * (NB + 1) + r) * FF + n0 + lane] = sv; }
    }
    __syncthreads();
}
__device__ __forceinline__ void bin_phase(const Params& P, int l, LAS unsigned char* L, int tid, int vcu, int G) {
    LAS float* SH = (LAS float*)L; LAS float* RED = (LAS float*)(L + 32768); const int lane = tid & 63, wid = tid >> 6;
    for (int u = vcu; u < NPL / 64 + 1; u += G) { const int n0 = u * 64; const int n = n0 + lane; const bool ok = n < NPL + 8; const int col = n < 1024 ? n : (n < NPL ? n + 8 : 1024 + (n - NPL));
        __syncthreads();
        for (int i = tid; i < (NB + 1) * DM; i += 512) SH[i] = ((const float*)(P.ws + WS_MOD))[((size_t)l * (NB + 1) + i / DM) * NMOD + (i % DM)];
        __syncthreads();
        float acc[NB + 1];
#pragma unroll
        for (int r = 0; r <= NB; ++r) acc[r] = 0.f;
        const float* wp = P.w_in + ((size_t)l * DM + 128 * wid) * 2568 + (ok ? col : 0);
#pragma unroll 1
        for (int kb = 0; kb < 128; kb += 32) { float wv[32];
#pragma unroll
            for (int kx = 0; kx < 32; ++kx) wv[kx] = wp[(size_t)(kb + kx) * 2568];
#pragma unroll
            for (int kx = 0; kx < 32; ++kx)
#pragma unroll
                for (int r = 0; r <= NB; ++r) acc[r] += SH[r * DM + 128 * wid + kb + kx] * wv[kx]; }
#pragma unroll
        for (int r = 0; r <= NB; ++r) RED[(wid * (NB + 1) + r) * 64 + lane] = acc[r];
        __syncthreads();
        if (tid < (NB + 1) * 64) { const int r = tid >> 6; float sv = 0.f;
#pragma unroll
            for (int w = 0; w < 8; ++w) sv += RED[(w * (NB + 1) + r) * 64 + lane];
            ((float*)(P.ws + WS_BIN))[(size_t)r * (NPL + 256) + n0 + lane] = ok ? sv : 0.f; }
    }
    __syncthreads();
}
__device__ __forceinline__ void mod_phase(const Params& P, LAS unsigned char* L, int tid, int vcu, int G) {
    LAS float* SL = (LAS float*)L; LAS float* RED = (LAS float*)(L + 32768); const int lane = tid & 63, wid = tid >> 6;
    for (int i = tid; i < (NB + 1) * DM; i += 512) { const int r = i / DM, kx = i % DM; const float cv = r < NB ? P.c[(size_t)r * DM + kx] : P.c_ctx[kx]; SL[i] = cv * frcp(1.f + __expf(-cv)); }
    __syncthreads();
    for (int u = vcu; u < NL * (NMOD / 64); u += G) { const int l = u / (NMOD / 64), n0 = (u % (NMOD / 64)) * 64;
        float acc[NB + 1];
#pragma unroll
        for (int r = 0; r <= NB; ++r) acc[r] = 0.f;
        const float* wp = P.w_mod + ((size_t)l * DM + 128 * wid) * NMOD + n0 + lane;
#pragma unroll 1
        for (int kb = 0; kb < 128; kb += 32) { float wv[32];
#pragma unroll
            for (int kx = 0; kx < 32; ++kx) wv[kx] = wp[(size_t)(kb + kx) * NMOD];
#pragma unroll
            for (int kx = 0; kx < 32; ++kx)
#pragma unroll
                for (int r = 0; r <= NB; ++r) acc[r] += SL[r * DM + 128 * wid + kb + kx] * wv[kx]; }
#pragma unroll
        for (int r = 0; r <= NB; ++r) RED[(wid * (NB + 1) + r) * 64 + lane] = acc[r];
        __syncthreads();
        if (tid < (NB + 1) * 64) { const int r = tid >> 6; float sv = P.b_mod[(size_t)l * NMOD + n0 + lane];
#pragma unroll
            for (int w = 0; w < 8; ++w) sv += RED[(w * (NB + 1) + r) * 64 + lane];
            ((float*)(P.ws + WS_MOD))[((size_t)l * (NB + 1) + r) * NMOD + n0 + lane] = sv; }
        __syncthreads();
    }
}

#endif

#ifndef STAGE_MASK
#define STAGE_MASK 0xffff
#endif
#define SM(b) if (STAGE_MASK & (1 << (b)))
#ifndef REP_MASK
#define REP_MASK 0
#endif
#ifndef ABL_SSD
#define ABL_SSD 0
#endif
#define REP(b, X) do { X; if (REP_MASK & (1 << (b))) { SYNC(); X; } } while (0)
#define FORWARD_PROGRAM() do { \
    SM(0) REP(0, RUN(0, (long)NL * (NB + 1) * NMOD, st_mod(P, it))); \
    _Pragma("unroll 1") for (int l = 0; l < NL; ++l) { \
        SM(1) REP(9, WCONV_PHASE(l)); SYNC(); \
        SM(2) REP(10, NORM_PHASE(l, 0)); SYNC(); \
        SM(3) REP(6, GEMM_INPROJ(l)); SYNC(); \
        SM(4) REP(8, PREP_PHASE(l)); SM(5) QK_PHASE(l); SM(7) REP(1, RUN(0, (long)NB * NCH * 8, st_ssd_dt(P, it, l))); SYNC(); \
        SM(6) REP(2, RUN(0, (long)MT * 256, st_lru_gate(P, it, l))); SM(8) REP(5, ATTN_PHASE(l)); SYNC(); \
        SM(6) REP(3, RUN(0, (long)NB * NCH * 512, st_lru_local(P, it))); SYNC(); \
        SM(6) REP(3, RUN(0, (long)NB * 512, st_lru_carry(P, it))); SYNC(); \
        SM(6) REP(3, RUN(0, (long)NB * NCH * 256, st_lru_final(P, it, l, 0))); SYNC(); \
        SM(6) RUN(0, (long)NB * NCH * 256, st_lru_final(P, it, l, 1)); SYNC(); \
        SM(7) REP(4, SSD_STATE_PHASE(l)); SYNC(); \
        SM(7) RUN(0, (long)NB * 65536, st_ssd_carry(P, it)); SYNC(); \
        SM(10) REP(4, SSD_OUT_PHASE(l)); SYNC(); \
        SM(11) GEMM_OUT(l); SYNC(); \
        SM(2) NORM_PHASE(l, 1); SYNC(); \
        SM(12) REP(7, GEMM_F1(l)); SYNC(); \
        SM(13) GEMM_F2(l); SYNC(); \
    } } while (0)

#ifdef CPU_EMU
#define RUN(off, n, CALL) do { const long _n = (n); _Pragma("omp parallel for schedule(dynamic, 16)") for (long it = 0; it < _n; ++it) { CALL; } } while (0)
#define SYNC() do {} while (0)
#define SSD_STATE_PHASE(l) do { RUN(0, (long)NB * NCH * 65536, st_ssd_state(P, it)); RUN(0, (long)NB * NCH * 32768, st_ssd_g(P, it)); } while (0)
#define SSD_OUT_PHASE(l) do { RUN(0, (long)NB * NCH * 32768, st_ssd_y(P, it, l)); RUN(0, MT, st_ssd_norm(P, it, l)); } while (0)
#define WCONV_PHASE(l) RUN(960, WC_R4, st_wconv(P, it, l))
#define NORM_PHASE(l, w) RUN(0, MT, st_norm(P, it, l, w))
#define PREP_PHASE(l) RUN(0, (long)MT * 1280, st_prep(P, it, l))
#define QK_PHASE(l) RUN(0, (long)MT * 12, st_qk(P, it, l))
#define ATTN_PHASE(l) do { RUN(0, (long)MT * 4, st_attn(P, it, l, 0)); RUN(0, (long)MT * 4, st_attn(P, it, l, 1)); } while (0)
#define GEMM_INPROJ(l) RUN(0, (long)(MT / 8) * (NPL / 4), st_gemm(it, (const bf16_t*)(P.ws + WS_XN), DM, (const bf16_t*)(P.ws + WS_WIN), NPL, DM, EpiPL{P}))
#define GEMM_OUT(l) RUN(0, (long)(MT / 8) * (DM / 4), st_gemm(it, (const bf16_t*)(P.ws + WS_XN), DM, (const bf16_t*)(P.ws + WS_WOUT), DM, DM, EpiOut{P, l}))
#define GEMM_F1(l) RUN(0, (long)(MT / 8) * (FF / 4), st_gemm(it, (const bf16_t*)(P.ws + WS_XN), DM, (const bf16_t*)(P.ws + WS_WF1), FF, DM, EpiF1{P}))
#define GEMM_F2(l) RUN(0, (long)(MT / 8) * (DM / 4), st_gemm(it, (const bf16_t*)(P.ws + WS_H), FF, (const bf16_t*)(P.ws + WS_WF2), DM, FF, EpiF2{P, l}))
static void forward_emu(const Params& P) { FORWARD_PROGRAM(); }
#else
typedef const __attribute__((address_space(4))) unsigned long long* karg_u64p;
__device__ __forceinline__ Params load_params(const __attribute__((address_space(4))) Params* kp) { Params P; const karg_u64p q = (karg_u64p)kp;
    P.x = (const float*)(GAS const float*)q[0];    P.c = (const float*)(GAS const float*)q[1];    P.ctx = (const float*)(GAS const float*)q[2];    P.c_ctx = (const float*)(GAS const float*)q[3];    P.w_mod = (const float*)(GAS const float*)q[4];    P.b_mod = (const float*)(GAS const float*)q[5];
    P.g_mix = (const float*)(GAS const float*)q[6];    P.w_in = (const float*)(GAS const float*)q[7];    P.ssd_conv_w = (const float*)(GAS const float*)q[8];    P.ssd_conv_b = (const float*)(GAS const float*)q[9];    P.ssd_a_log = (const float*)(GAS const float*)q[10];    P.ssd_dt_bias = (const float*)(GAS const float*)q[11];
    P.ssd_d = (const float*)(GAS const float*)q[12];    P.ssd_norm_g = (const float*)(GAS const float*)q[13];    P.lru_conv_w = (const float*)(GAS const float*)q[14];    P.lru_conv_b = (const float*)(GAS const float*)q[15];    P.lru_lambda = (const float*)(GAS const float*)q[16];    P.lru_w_a = (const float*)(GAS const float*)q[17];
    P.lru_b_a = (const float*)(GAS const float*)q[18];    P.lru_w_i = (const float*)(GAS const float*)q[19];    P.lru_b_i = (const float*)(GAS const float*)q[20];    P.gqa_q_norm = (const float*)(GAS const float*)q[21];    P.gqa_k_norm = (const float*)(GAS const float*)q[22];    P.swa_q_norm = (const float*)(GAS const float*)q[23];
    P.swa_k_norm = (const float*)(GAS const float*)q[24];    P.swa_sink = (const float*)(GAS const float*)q[25];    P.w_out = (const float*)(GAS const float*)q[26];    P.g_ffn = (const float*)(GAS const float*)q[27];    P.w_ffn1 = (const float*)(GAS const float*)q[28];    P.w_ffn2 = (const float*)(GAS const float*)q[29];

    P.out = (float*)(GAS float*)q[30]; P.ws = (unsigned char*)(GAS unsigned char*)q[31];
    return P; }
constexpr int NTHREADS = 512;
constexpr int RING_BYTES = 131072, LDSCTL_OFF = RING_BYTES, MISC_OFF = LDSCTL_OFF + 320, LDS_BYTES = 147456;
constexpr int CW_BAR = 4096;
constexpr size_t CTL_ZERO_BYTES = 64 * 1024;
#define PHASE_LOCALS const __attribute__((address_space(4))) Params* kp_ = (const __attribute__((address_space(4))) Params*)__builtin_amdgcn_kernarg_segment_ptr(); asm volatile("" : "+s"(kp_)); \
    const Params P = load_params(kp_);     \
    const int tid_ = tid_from_wave(wave_s); \
    const int lane = tid_ & 63, wave = tid_ >> 6; const int G = (int)gridDim.x; int bx_ = (int)blockIdx.x; asm volatile("" : "+s"(bx_)); const int gw = wave * G + bx_, NGW = 8 * G; (void)lane; (void)gw; (void)NGW;
#define RUN(off, n, CALL) do { PHASE_LOCALS const int _n = (int)(n); for (int _iw = gw; _iw * 64 < _n; _iw += NGW) { const long it = _iw * 64 + lane; if (it < _n) { CALL; } } } while (0)
#ifndef PROF_A
#define PROF_A (-1)
#endif
#ifndef PROF_B
#define PROF_B (-1)
#endif
#define SYNC() do { xcd_barrier(bar, wave_s); if (PROF_A >= 0 && blockIdx.x == 0 && tid_from_wave(wave_s) == 0) { LAS unsigned long long* ts_ = (LAS unsigned long long*)(L + LDSCTL_OFF); const unsigned n_ = (unsigned)ts_[39]; if (n_ < 38) ts_[n_] = __builtin_amdgcn_s_memrealtime(); ts_[39] = n_ + 1; } } while (0)
#define VCU_ ((G % 8 == 0) ? (bx_ % 8) * (G / 8) + bx_ / 8 : bx_)
#define PREP_PHASE(l) do { PHASE_LOCALS prep_phase(P, (l), L, tid_, (G % 8 == 0) ? (bx_ % 8) * (G / 8) + bx_ / 8 : bx_, G); } while (0)
#define QK_PHASE(l) do { PHASE_LOCALS constexpr int NPU_ = NB * NCH * 3; const int rem_ = NPU_ % G, vc_ = VCU_; const int RA_ = rem_ > 0 ? ((G - rem_) * 192 < MT ? (G - rem_) * 192 : MT) : 0;     \
    if (rem_ > 0 && vc_ >= rem_) qk_phase(P, (l), lane, wave * (G - rem_) + (vc_ - rem_), 8 * (G - rem_), 0, RA_); \
    qk_phase(P, (l), lane, gw, NGW, RA_, MT); } while (0)
#define ATTN_PHASE(l) do { PHASE_LOCALS attention_phase(P, (l), (char*)lds, G, bx_, wave_s); } while (0)
#define GEMM_INPROJ(l) do { PHASE_LOCALS pg8::Gemm g{(const pg8::bf16_t*)(P.ws + WS_XN), (const pg8::bf16_t*)(P.ws + WS_WIN), MT, NPL + 256, DM, DM}; pg8::RowOrder S; S.init(NPL + 256, G, bx_, 0); \
    pg8::EpiBf16A<0> E{(pg8::bf16_t*)(P.ws + WS_PL), NPL, (l) > 0 ? (const float*)(P.ws + WS_RS1) : nullptr, (const float*)(P.ws + WS_BIN), (float*)(P.ws + WS_DTP), NPL + 256};     pg8::gemm_phase<pg8::EpiBf16A<0>, pg8::RowOrder, true, true>(L, g, S, E, wave_s); } while (0)
#define GEMM_F1(l) do { PHASE_LOCALS pg8::Gemm g{(const pg8::bf16_t*)(P.ws + ws_xa2(l)), (const pg8::bf16_t*)(P.ws + WS_WF1), MT, FF, DM, DM}; pg8::RowOrder S; S.init(FF, G, bx_, (l) == NL - 1 ? 1 : 0); \
    pg8::EpiBf16A<2> E{(pg8::bf16_t*)(P.ws + ws_h(l)), FF, (const float*)(P.ws + WS_RS2), (const float*)(P.ws + WS_BF1) + (size_t)(l) * (NB + 1) * FF, nullptr, FF}; pg8::gemm_phase<pg8::EpiBf16A<2>, pg8::RowOrder, true, true>(L, g, S, E, wave_s); } while (0)
#define GEMM_RESID(l, which) do { PHASE_LOCALS const int KF = (which) ? FF : DM; const int npass = (l) == NL - 1 ? 1 : 2; \
    _Pragma("unroll 1") for (int pass = 0; pass < npass; ++pass) { \
        pg8::Gemm g{(const pg8::bf16_t*)(P.ws + ((which) ? ws_h(l) : WS_XN)), (const pg8::bf16_t*)(P.ws + ((which) ? WS_WF2 : WS_WOUT)), MT, DM, pass ? KF / pg8::RowOrder::KSPLIT : KF, KF}; \
        pg8::RowOrder S; S.init(DM, G, bx_, pass ? 2 : 1, KF / pg8::RowOrder::KSPLIT); \
        void* x1b_ = (l) == NL - 1 ? (void*)(P.ws + WS_X1L) : (void*)P.out;     \
        pg8::EpiResid E{(which) ? (const void*)x1b_ : ((l) == 0 ? (const void*)P.x : (const void*)P.out), (which) ? (void*)P.out : x1b_, ((which) || (l) > 0) ? 1 : 0, ((which) && (l) == NL - 1) ? 0 : 1, (const float*)(P.ws + WS_MOD) + (size_t)(l) * (NB + 1) * NMOD, (which) ? 5120 : 2048, pass ? KF / pg8::RowOrder::KSPLIT : 0, (float*)(P.ws + WS_SLAB), \
            (which) == 0 ? (pg8::bf16_t*)(P.ws + ws_xa2(l)) : ((l) + 1 < NL ? (pg8::bf16_t*)(P.ws + WS_XN) : nullptr), (which) == 0 ? P.g_ffn + (size_t)(l) * DM : P.g_mix + (size_t)((l) + 1 < NL ? (l) + 1 : (l)) * DM, \
            (const float*)(P.ws + WS_MOD) + (size_t)((which) == 0 ? (l) : ((l) + 1 < NL ? (l) + 1 : (l))) * (NB + 1) * NMOD, (which) == 0 ? 4096 : 1024, (float*)(P.ws + ((which) == 0 ? WS_RS2 : WS_RS1))};     \
        pg8::gemm_phase<pg8::EpiResid, pg8::RowOrder, true, true>(L, g, S, E, wave_s); } } while (0)
#define GEMM_OUT(l) GEMM_RESID(l, 0)
#define GEMM_F2(l) GEMM_RESID(l, 1)

#define M1_PHASE(l) do { PHASE_LOCALS const int vcu = VCU_; constexpr int NIT_ = NB * NCH * 8; \
      \
    const int NC1_ = 8 * G - NIT_ <= 0 ? 0 : (8 * G - NIT_ < 4 * G ? 8 * G - NIT_ : 4 * G), NX_ = 4 * G - NC1_, N2_ = 8 * G - NC1_; \
    const int t_ = wave_s * G + vcu; const bool c2_ = wave_s >= 4 || t_ < NX_; const int s2_ = wave_s >= 4 ? (wave_s - 4) * G + vcu : 4 * G + t_; \
    if (c2_) { _Pragma("unroll 1") for (int i_ = s2_; i_ < NIT_; i_ += N2_) { const int ti_ = tid_from_wave(wave_s); ssdk::ssd_state_item(P, (l), L, ti_, i_ >> 3, (i_ >> 1) & 3, i_ & 1); } } \
    { int h_, he_, hs_;        \
        if (!c2_) { const int u_ = t_ - NX_; h_ = 2 * u_; he_ = u_ < NIT_ ? 2 * u_ + 2 : 0; hs_ = 1; } \
        else { h_ = 2 * NC1_ + s2_; he_ = 2 * NIT_; hs_ = N2_; } \
        _Pragma("unroll 1") for (; h_ < he_; h_ += hs_) { const int ti_ = tid_from_wave(wave_s); const int u_ = h_ >> 1; lruk::lru_gate_half(P, (l), ti_, u_ >> 3, (u_ >> 1) & 3, u_ & 1, h_ & 1); } } \
    __syncthreads(); attention_phase(P, (l), (char*)lds, G, bx_, wave_s); if (REP_MASK & 4096) attention_phase(P, (l), (char*)lds, G, bx_, wave_s); } while (0)
#define M2_PHASE(l) do { RUN(0, (long)NB * 65536, st_ssd_carry(P, it)); RUN(0, (long)NB * 512, st_lru_carry(P, it)); } while (0)
#define M3_PHASE(l) do { PHASE_LOCALS const int vcu = VCU_; \
    if (REP_MASK & 256) { ssdk::ssd_out_phase<ABL_SSD>(P, (l), L, wave_s, vcu, G); __syncthreads(); } ssdk::ssd_out_phase<0>(P, (l), L, wave_s, vcu, G); \
      \
    { const int ntile_ = (l) == NL - 1 ? NB * (NCH - NCC) * 4 : NB * NCH * 4; const int flo_ = ntile_ > 2 * G ? (ntile_ - 2 * G + 1) / 2 : 0, fhi_ = G - NB * NCH; const int parts_ = (l) == 0 ? 14 : 8; \
      if (fhi_ > flo_) { if (vcu >= flo_ && vcu < fhi_) { __syncthreads(); wconv_phase(P, (l), parts_, L, wave, lane, wave * (fhi_ - flo_) + (vcu - flo_), 8 * (fhi_ - flo_)); } } \
      else { __syncthreads(); wconv_phase(P, (l), parts_, L, wave, lane, gw, NGW); } } \
    lruk::lru_final_phase(P, L, tid_, G - 1 - vcu, G, (l) == NL - 1); if (REP_MASK & 512) { __syncthreads(); lruk::lru_final_phase(P, L, tid_, G - 1 - vcu, G, (l) == NL - 1); } } while (0)
#define FREE_LOCALS const int fo_ = G > 64 ? 64 : 0, nf_ = G - fo_;
#define GPU_PROGRAM() do { \
    REP(0, { PHASE_LOCALS mod_phase(P, L, tid_, VCU_, G); wconv_phase(P, 0, 17, L, wave, lane, gw, NGW); \
        }); SYNC(); \
    _Pragma("unroll 1") for (int l = 0; l < NL; ++l) { \
          \
        if (l == 0) { PHASE_LOCALS norm1_phase(P, l, 0, L, tid_, lane, gw, NGW); } \
        else { PHASE_LOCALS norm_phase(P, l, 0, 1, 1, lane, gw, NGW); } \
        SYNC(); \
        REP(2, GEMM_INPROJ(l)); SYNC(); \
        REP(3, { PREP_PHASE(l); }); QK_PHASE(l); SYNC(); \
        REP(4, M1_PHASE(l)); SYNC(); \
        M2_PHASE(l); SYNC(); \
        REP(5, M3_PHASE(l)); SYNC(); \
          \
        GEMM_OUT(l); if (l == 0 && l + 1 < NL) { PHASE_LOCALS FREE_LOCALS if (bx_ >= fo_) { __syncthreads(); bias_phase(P, L, tid_, bx_ - fo_, nf_); } } else if (l == 0) { PHASE_LOCALS bias_phase(P, L, tid_, VCU_, G); } SYNC(); \
        if (l + 1 < NL) { { PHASE_LOCALS norm_phase(P, l, 1, 1, 1, lane, gw, NGW); } SYNC(); }     \
        REP(7, GEMM_F1(l)); if (l + 1 < NL) { PHASE_LOCALS FREE_LOCALS if (bx_ >= fo_) { __syncthreads(); wconv_phase(P, l + 1, 19, L, wave, lane, wave * nf_ + (bx_ - fo_), 8 * nf_); __syncthreads(); bin_phase(P, l + 1, L, tid_, nf_ - 1 - (bx_ - fo_), nf_); } } SYNC(); \
        GEMM_F2(l); if (l + 1 < NL) { { PHASE_LOCALS FREE_LOCALS if (bx_ >= fo_) { __syncthreads(); wconv_phase(P, l + 1, 4, L, wave, lane, wave * nf_ + (bx_ - fo_), 8 * nf_); } } SYNC(); } \
    } } while (0)

__global__ void __launch_bounds__(NTHREADS, 2) fwd_kernel(Params P0) {
    extern __shared__ __attribute__((aligned(16))) unsigned char lds[];
    LAS unsigned char* L = (LAS unsigned char*)lds;
    const int wave_s = __builtin_amdgcn_readfirstlane((int)(threadIdx.x >> 6));
    for (int u = threadIdx.x; u < (LDS_BYTES - LDSCTL_OFF) / 4; u += NTHREADS) ((LAS unsigned*)(L + LDSCTL_OFF))[u] = 0u;
    __syncthreads();
    XcdBarrier bar = xcd_barrier_post((unsigned*)(P0.ws + WS_CTL) + CW_BAR, (volatile LAS unsigned*)(L + MISC_OFF) + 8);
    GPU_PROGRAM();
    if (PROF_A >= 0) {
        SYNC();
        if (blockIdx.x == 0) { LAS unsigned long long* ts_ = (LAS unsigned long long*)(L + LDSCTL_OFF); __syncthreads();
            const float ta = (float)(ts_[PROF_A + 1] - ts_[PROF_A]) * 0.01f, tb = (float)(ts_[(PROF_B < 0 ? PROF_A : PROF_B) + 1] - ts_[PROF_B < 0 ? PROF_A : PROF_B]) * 0.01f;
            const int t = tid_from_wave(wave_s);
            if (t == 0) P0.out[0] += ta;
            for (int i = t; i < (1 << 20); i += NTHREADS) P0.out[4096 + i] += tb * 0.001f; } }
}

extern "C" void kernel_launch(void* const* d_in, const int* in_sizes, int n_in, void* d_out, int out_size, void* d_ws, size_t ws_size, hipStream_t stream) {
    static int grid_blocks = 0;
    if (!grid_blocks) {
        int dev = 0, cus = 0, per_cu = 0;
        (void)hipGetDevice(&dev); (void)hipDeviceGetAttribute(&cus, hipDeviceAttributeMultiprocessorCount, dev);
        (void)hipFuncSetAttribute((const void*)fwd_kernel, hipFuncAttributeMaxDynamicSharedMemorySize, LDS_BYTES);
        (void)hipOccupancyMaxActiveBlocksPerMultiprocessor(&per_cu, fwd_kernel, NTHREADS, LDS_BYTES);
        if (per_cu < 1) { fprintf(stderr, "kernel_launch: occupancy query reports %d blocks per CU\n", per_cu); per_cu = 1; }
        grid_blocks = cus;
        if (n_in != 30 || out_size != NB * SEQ * DM || ws_size < WS_END) fprintf(stderr, "kernel_launch: unexpected shapes n_in %d out %d ws %zu\n", n_in, out_size, ws_size);
    }
    (void)hipMemsetAsync((char*)d_ws + WS_CTL, 0, CTL_ZERO_BYTES, stream);
    Params p{};
    const float** pp = (const float**)&p;
    for (int i = 0; i < 30; ++i) pp[i] = (const float*)d_in[i];
    p.out = (float*)d_out; p.ws = (unsigned char*)d_ws;
    void* args[] = {&p};
    hipError_t e = hipLaunchCooperativeKernel((void*)fwd_kernel, dim3(grid_blocks), dim3(NTHREADS), args, LDS_BYTES, stream);
    if (e != hipSuccess) fprintf(stderr, "cooperative launch failed: %s (grid %d)\n", hipGetErrorString(e), grid_blocks);
}
#endif
```
